# Optimizing an MI355X kernel written in HIP

```python
import jax, jax.numpy as jnp
from jax import lax
import numpy as np

D_MODEL = 1024
BATCH = 4
SEQ = 4096
DEPTH = 2

N_MIXERS = 2
N_MEM = 256
MIX_WIDTH = 3 * D_MODEL // 4
MEM_HEADS = 4
MEM_HEAD_DIM = D_MODEL // 16
MEM_WIDTH = MEM_HEADS * MEM_HEAD_DIM
CHUNK = 64
GLA_HEADS = 4
GLA_KEY_WIDTH = D_MODEL // 2
GLA_DK = GLA_KEY_WIDTH // GLA_HEADS
GLA_DV = MIX_WIDTH // GLA_HEADS
GLA_GATE_RANK = 16
GLA_GATE_NORMALIZER = 16.0
GLA_IN_WIDTH = 2 * GLA_KEY_WIDTH + 2 * MIX_WIDTH + GLA_GATE_RANK + MEM_WIDTH
HG_EXPAND = 128
HG_HEADS = MIX_WIDTH // HG_EXPAND
HG_DK = HG_EXPAND
HG_DV = MIX_WIDTH // HG_HEADS
HG_IN_WIDTH = 4 * MIX_WIDTH + MEM_WIDTH
N_GROUPS = 4
EXPERTS_PER_GROUP = 4
N_EXPERTS = N_GROUPS * EXPERTS_PER_GROUP
EXPERT_FF = 256
TOP_K_IN_GROUP = 2
NORM_EPS = 1e-6

kernel_name = 'hybrid_gla_hgrn2_memxattn_hmoe'


def rms_norm(x, gain):
    xf = x.astype(jnp.float32)
    y = xf * lax.rsqrt(jnp.mean(xf * xf, axis=-1, keepdims=True) + NORM_EPS)
    return (y * gain.astype(jnp.float32)).astype(x.dtype)


def split_cols(a, sizes):
    offsets, acc = [], 0
    for s in sizes[:-1]:
        acc += s
        offsets.append(acc)
    return jnp.split(a, offsets, axis=-1)


def chunk_gated_linear_attention(q, k, v, log_decay):
    B, T, H, K = q.shape
    V = v.shape[-1]
    n_chunks = T // CHUNK

    def to_chunks(a):
        return a.astype(jnp.float32).reshape(B, n_chunks, CHUNK, H, a.shape[-1]).transpose(1, 0, 3, 2, 4)

    qc, kc, vc, gc = to_chunks(q), to_chunks(k), to_chunks(v), to_chunks(log_decay)
    bc = jnp.cumsum(gc, axis=-2)
    causal = jnp.tril(jnp.ones((CHUNK, CHUNK), dtype=bool))[:, :, None]

    def step(state, inp):
        q_, k_, v_, b_ = inp
        diff = b_[..., :, None, :] - b_[..., None, :, :]
        decay = jnp.exp(jnp.where(causal, diff, -jnp.inf))
        scores = jnp.sum(q_[..., :, None, :] * k_[..., None, :, :] * decay, axis=-1)
        out = scores @ v_ + (q_ * jnp.exp(b_)) @ state
        b_last = b_[..., -1:, :]
        state = state * jnp.exp(b_last).swapaxes(-1, -2) + (k_ * jnp.exp(b_last - b_)).swapaxes(-1, -2) @ v_
        return state, out

    state0 = jnp.zeros((B, H, K, V), jnp.float32)
    _, out = lax.scan(step, state0, (qc, kc, vc, bc))
    return out.transpose(1, 0, 3, 2, 4).reshape(B, T, H, V).astype(v.dtype)


def gla_mixer(u, w_in, w_gate_up, b_gate, out_gain):
    B, T, _ = u.shape
    proj = u @ w_in
    q, k, v, g, r, mq = split_cols(proj, [GLA_KEY_WIDTH, GLA_KEY_WIDTH, MIX_WIDTH, MIX_WIDTH, GLA_GATE_RANK, MEM_WIDTH])
    q = q.reshape(B, T, GLA_HEADS, GLA_DK) * (GLA_DK ** -0.5)
    k = k.reshape(B, T, GLA_HEADS, GLA_DK)
    v = v.reshape(B, T, GLA_HEADS, GLA_DV)
    gate_logit = (r @ w_gate_up + b_gate).astype(jnp.float32)
    log_decay = (jax.nn.log_sigmoid(gate_logit) / GLA_GATE_NORMALIZER).reshape(B, T, GLA_HEADS, GLA_DK)
    o = chunk_gated_linear_attention(q, k, v, log_decay)
    o = rms_norm(o, out_gain) * jax.nn.silu(g.reshape(B, T, GLA_HEADS, GLA_DV))
    return o.reshape(B, T, MIX_WIDTH), mq


def hgrn2_mixer(u, w_in, lower_bound, out_gain):
    B, T, _ = u.shape
    proj = u @ w_in
    q, f, i, g, mq = split_cols(proj, [MIX_WIDTH, MIX_WIDTH, MIX_WIDTH, MIX_WIDTH, MEM_WIDTH])
    q = jax.nn.silu(q).reshape(B, T, HG_HEADS, HG_DK)
    z = f.astype(jnp.float32).reshape(B, T, HG_HEADS, HG_DK)
    lb = lower_bound.reshape(HG_HEADS, HG_DK)
    log_f = jnp.logaddexp(jnp.log(lb), jnp.log1p(-lb) + jax.nn.log_sigmoid(z))
    one_minus_f = (1.0 - lb) * jax.nn.sigmoid(-z)
    i = i.reshape(B, T, HG_HEADS, HG_DV)
    o = chunk_gated_linear_attention(q, one_minus_f, i, log_f)
    o = rms_norm(o, out_gain) * jax.nn.silu(g.reshape(B, T, HG_HEADS, HG_DV))
    return o.reshape(B, T, MIX_WIDTH), mq


def memory_cross_attention(mq, mem_n, w_mem_kv):
    B, T, _ = mq.shape
    kv = mem_n @ w_mem_kv
    k, v = split_cols(kv, [MEM_WIDTH, MEM_WIDTH])
    k = k.reshape(B, N_MEM, MEM_HEADS, MEM_HEAD_DIM)
    v = v.reshape(B, N_MEM, MEM_HEADS, MEM_HEAD_DIM)
    q = mq.reshape(B, T, MEM_HEADS, MEM_HEAD_DIM)
    s = jnp.einsum('bthd,bmhd->bhtm', q, k).astype(jnp.float32) * (MEM_HEAD_DIM ** -0.5)
    p = jax.nn.softmax(s, axis=-1).astype(v.dtype)
    o = jnp.einsum('bhtm,bmhd->bthd', p, v)
    return o.reshape(B, T, MEM_WIDTH)


def hierarchical_moe(u, w_group, b_group, w_router, b_router, w_up, w_down):
    B, T, D = u.shape
    t = u.reshape(B * T, D)
    n_tok = t.shape[0]
    g_logits = (t @ w_group + b_group).astype(jnp.float32)
    g_prob = jax.nn.softmax(g_logits, axis=-1)
    g_idx = jnp.argmax(g_logits, axis=-1)
    g_w = jnp.take_along_axis(g_prob, g_idx[:, None], axis=-1)
    e_logits = (t @ w_router + b_router).astype(jnp.float32).reshape(n_tok, N_GROUPS, EXPERTS_PER_GROUP)
    e_in_group = jnp.take_along_axis(e_logits, g_idx[:, None, None], axis=1)[:, 0]
    top_v, top_i = lax.top_k(e_in_group, TOP_K_IN_GROUP)
    top_w = jax.nn.softmax(top_v, axis=-1) * g_w
    expert_id = g_idx[:, None] * EXPERTS_PER_GROUP + top_i
    gates = jnp.einsum('nk,nke->ne', top_w, jax.nn.one_hot(expert_id, N_EXPERTS, dtype=jnp.float32))
    h = jnp.einsum('nd,edf->nef', t, w_up)
    a, b = split_cols(h, [EXPERT_FF, EXPERT_FF])
    h = jax.nn.silu(a) * b * gates[..., None].astype(h.dtype)
    y = jnp.einsum('nef,efd->nd', h, w_down)
    return y.reshape(B, T, D)


def setup_inputs(seed: int = 0) -> dict:
    key = jax.random.key(seed)
    ks = jax.random.split(key, 24)
    n_gla = (DEPTH + N_MIXERS - 1) // N_MIXERS
    n_hg = DEPTH // N_MIXERS

    def nrm(k, shape, scale):
        return jax.random.normal(k, shape, jnp.float32) * scale

    def gain(k, shape):
        return 1.0 + 0.02 * jax.random.normal(k, shape, jnp.float32)

    return {
        'x': nrm(ks[0], (BATCH, SEQ, D_MODEL), 1.0),
        'mem': nrm(ks[1], (BATCH, N_MEM, D_MODEL), 1.0),
        'mix_norm': gain(ks[2], (DEPTH, D_MODEL)),
        'ffn_norm': gain(ks[3], (DEPTH, D_MODEL)),
        'mem_norm': gain(ks[4], (DEPTH, D_MODEL)),
        'final_norm': gain(ks[5], (D_MODEL,)),
        'gla_w_in': nrm(ks[6], (n_gla, D_MODEL, GLA_IN_WIDTH), D_MODEL ** -0.5),
        'gla_w_gate_up': nrm(ks[7], (n_gla, GLA_GATE_RANK, GLA_KEY_WIDTH), GLA_GATE_RANK ** -0.5),
        'gla_b_gate': nrm(ks[8], (n_gla, GLA_KEY_WIDTH), 0.1),
        'gla_out_norm': gain(ks[9], (n_gla, GLA_DV)),
        'hg_w_in': nrm(ks[10], (n_hg, D_MODEL, HG_IN_WIDTH), D_MODEL ** -0.5),
        'hg_lower_bounds': nrm(ks[11], (DEPTH, MIX_WIDTH), 0.1),
        'hg_out_norm': gain(ks[12], (n_hg, HG_DV)),
        'w_mem_kv': nrm(ks[13], (DEPTH, D_MODEL, 2 * MEM_WIDTH), D_MODEL ** -0.5),
        'w_out': nrm(ks[14], (DEPTH, MIX_WIDTH + MEM_WIDTH, D_MODEL), (MIX_WIDTH + MEM_WIDTH) ** -0.5),
        'w_group': nrm(ks[15], (DEPTH, D_MODEL, N_GROUPS), D_MODEL ** -0.5),
        'b_group': nrm(ks[16], (DEPTH, N_GROUPS), 0.01),
        'w_router': nrm(ks[17], (DEPTH, D_MODEL, N_EXPERTS), D_MODEL ** -0.5),
        'b_router': nrm(ks[18], (DEPTH, N_EXPERTS), 0.01),
        'w_up': nrm(ks[19], (DEPTH, N_EXPERTS, D_MODEL, 2 * EXPERT_FF), D_MODEL ** -0.5),
        'w_down': nrm(ks[20], (DEPTH, N_EXPERTS, EXPERT_FF, D_MODEL), EXPERT_FF ** -0.5),
    }


def reference(x, mem, mix_norm, ffn_norm, mem_norm, final_norm, gla_w_in, gla_w_gate_up, gla_b_gate,
              gla_out_norm, hg_w_in, hg_lower_bounds, hg_out_norm, w_mem_kv, w_out, w_group, b_group,
              w_router, b_router, w_up, w_down):
    lb_prob = jax.nn.softmax(hg_lower_bounds.astype(jnp.float32), axis=0)
    lower_bounds = jnp.cumsum(lb_prob, axis=0) - lb_prob[0]
    h = x
    for layer in range(DEPTH):
        u = rms_norm(h, mix_norm[layer])
        j = layer // N_MIXERS
        if layer % N_MIXERS == 0:
            mix, mq = gla_mixer(u, gla_w_in[j], gla_w_gate_up[j], gla_b_gate[j], gla_out_norm[j])
        else:
            mix, mq = hgrn2_mixer(u, hg_w_in[j], lower_bounds[layer], hg_out_norm[j])
        mem_o = memory_cross_attention(mq, rms_norm(mem, mem_norm[layer]), w_mem_kv[layer])
        h = h + jnp.concatenate([mix, mem_o], axis=-1) @ w_out[layer]
        h = h + hierarchical_moe(rms_norm(h, ffn_norm[layer]), w_group[layer], b_group[layer],
                                 w_router[layer], b_router[layer], w_up[layer], w_down[layer])
    return rms_norm(h, final_norm)
```

```cpp
#include <hip/hip_runtime.h>
#include <cstdio>
#include <cstdint>

namespace gold {
constexpr int D = 1024, BATCH = 4, SEQ = 4096, M = BATCH * SEQ, NMEM = 256;
constexpr int MIXW = 768, MEMW = 256;
constexpr int GLA_H = 4, GLA_KW = 512, GLA_DK = 128, GLA_DV = 192, GLA_IN = 2832, GLA_RANK = 16;
constexpr int HG_H = 6, HG_DK = 128, HG_DV = 128, HG_IN = 3328;
constexpr int NG = 4, EPG = 4, NE = 16, FF = 256;
constexpr float EPS = 1e-6f;

__device__ __forceinline__ float wsum(float v) {
#pragma unroll
    for (int o = 32; o >= 1; o >>= 1) v += __shfl_xor(v, o);
    return v;
}
__device__ __forceinline__ float wmax(float v) {
#pragma unroll
    for (int o = 32; o >= 1; o >>= 1) v = fmaxf(v, __shfl_xor(v, o));
    return v;
}
__device__ __forceinline__ float sigmoidf_(float x) { return 1.f / (1.f + expf(-x)); }
__device__ __forceinline__ float siluf_(float x) { return x / (1.f + expf(-x)); }
__device__ __forceinline__ float logsigmoidf_(float x) { return fminf(x, 0.f) - log1pf(expf(-fabsf(x))); }

__global__ void k_rinv(const float* x, float* rinv, int rows) {
    const int w = (blockIdx.x * blockDim.x + threadIdx.x) >> 6, lane = threadIdx.x & 63;
    if (w >= rows) return;
    const float4* p = (const float4*)(x + (size_t)w * D);
    float s = 0.f;
    for (int j = 0; j < 4; ++j) { float4 v = p[lane + 64 * j]; s += v.x * v.x + v.y * v.y + v.z * v.z + v.w * v.w; }
    s = wsum(s);
    if (lane == 0) rinv[w] = rsqrtf(s * (1.f / D) + EPS);
}

__global__ void __launch_bounds__(256) k_gemm(const float* A, int lda, const float* W, int ldw, float* C, int ldc, int Mm, int N, int K,
                                              const float* rs, const float* cg, const float* R, int ldr) {
    __shared__ float As[8][132], Ws[8][132];
    const int tid = threadIdx.x, tx = tid & 15, ty = tid >> 4;
    const int m0 = blockIdx.y * 128, n0 = blockIdx.x * 128;
    float acc[8][8];
#pragma unroll
    for (int i = 0; i < 8; ++i)
#pragma unroll
        for (int j = 0; j < 8; ++j) acc[i][j] = 0.f;
    const int ar = tid >> 1, ak = (tid & 1) * 4;
    const int wk = tid >> 5, wn = (tid & 31) * 4;
    for (int k0 = 0; k0 < K; k0 += 8) {
        float4 av = *(const float4*)(A + (size_t)(m0 + ar) * lda + k0 + ak);
        if (cg) { const float4 g = *(const float4*)(cg + k0 + ak); av.x *= g.x; av.y *= g.y; av.z *= g.z; av.w *= g.w; }
        float4 wv = make_float4(0.f, 0.f, 0.f, 0.f);
        if (n0 + wn < N) wv = *(const float4*)(W + (size_t)(k0 + wk) * ldw + n0 + wn);
        __syncthreads();
        As[ak + 0][ar] = av.x; As[ak + 1][ar] = av.y; As[ak + 2][ar] = av.z; As[ak + 3][ar] = av.w;
        *(float4*)&Ws[wk][wn] = wv;
        __syncthreads();
#pragma unroll
        for (int k = 0; k < 8; ++k) {
            float a[8], b[8];
#pragma unroll
            for (int i = 0; i < 8; ++i) a[i] = As[k][ty * 8 + i];
#pragma unroll
            for (int j = 0; j < 8; ++j) b[j] = Ws[k][tx * 8 + j];
#pragma unroll
            for (int i = 0; i < 8; ++i)
#pragma unroll
                for (int j = 0; j < 8; ++j) acc[i][j] = fmaf(a[i], b[j], acc[i][j]);
        }
    }
#pragma unroll
    for (int i = 0; i < 8; ++i) {
        const int m = m0 + ty * 8 + i;
        const float s = rs ? rs[m] : 1.f;
#pragma unroll
        for (int j = 0; j < 8; ++j) {
            const int n = n0 + tx * 8 + j;
            if (n < N) { float v = acc[i][j] * s; if (R) v += R[(size_t)m * ldr + n]; C[(size_t)m * ldc + n] = v; }
        }
    }
}

__global__ void k_gla_prep(const float* proj, const float* wgu, const float* bg, float* qq, float* kk, float* ld, int T) {
    const int i = blockIdx.x * blockDim.x + threadIdx.x;
    if (i >= T * GLA_KW) return;
    const int t = i / GLA_KW, c = i % GLA_KW;
    const float* p = proj + (size_t)t * GLA_IN;
    qq[i] = p[c] * 0.08838834764831845f;
    kk[i] = p[GLA_KW + c];
    const float* r = p + 2 * GLA_KW + 2 * MIXW;
    float g = bg[c];
    for (int j = 0; j < GLA_RANK; ++j) g = fmaf(r[j], wgu[j * GLA_KW + c], g);
    ld[i] = logsigmoidf_(g) * (1.f / 16.f);
}
__global__ void k_hg_prep(const float* proj, const float* lbraw  , float* qq, float* kk, float* ld, int T) {
    const int i = blockIdx.x * blockDim.x + threadIdx.x;
    if (i >= T * MIXW) return;
    const int t = i / MIXW, c = i % MIXW;
    const float* p = proj + (size_t)t * HG_IN;
    const float lb = sigmoidf_(lbraw[MIXW + c] - lbraw[c]);
    const float z = p[MIXW + c];
    qq[i] = siluf_(p[c]);
    kk[i] = (1.f - lb) * sigmoidf_(-z);
    const float a = logf(lb), b = log1pf(-lb) + logsigmoidf_(z);
    const float mx = fmaxf(a, b);
    ld[i] = mx + log1pf(expf(-fabsf(a - b)));
}
__global__ void __launch_bounds__(256) k_recur(const float* qq, const float* kk, const float* ld, int KW, const float* v, int ldv, int DV, float* o, int ldo, int T) {
    const int nvb = DV / 4, h = blockIdx.x / nvb, j = (blockIdx.x % nvb) * 4 + (threadIdx.x >> 6), lane = threadIdx.x & 63;
    float S0 = 0.f, S1 = 0.f;
    const size_t cb = (size_t)h * 128 + lane;
    for (int t = 0; t < T; ++t) {
        const size_t r = (size_t)t * KW + cb;
        const float q0 = qq[r], q1 = qq[r + 64], k0 = kk[r], k1 = kk[r + 64], g0 = ld[r], g1 = ld[r + 64];
        const float vj = v[(size_t)t * ldv + h * DV + j];
        S0 = fmaf(expf(g0), S0, k0 * vj);
        S1 = fmaf(expf(g1), S1, k1 * vj);
        const float s = wsum(S0 * q0 + S1 * q1);
        if (lane == 0) o[(size_t)t * ldo + h * DV + j] = s;
    }
}
__global__ void k_outnorm(const float* o, const float* g, int ldg, const float* gain, int H, int DV, float* cat, int T) {
    const int w = (blockIdx.x * blockDim.x + threadIdx.x) >> 6, lane = threadIdx.x & 63;
    if (w >= T * H) return;
    const int t = w / H, h = w % H;
    float vals[3]; float s = 0.f;
    for (int j = 0; j < 3; ++j) { const int c = lane + 64 * j; vals[j] = c < DV ? o[(size_t)t * MIXW + h * DV + c] : 0.f; s += vals[j] * vals[j]; }
    s = wsum(s);
    const float ri = rsqrtf(s / (float)DV + EPS);
    for (int j = 0; j < 3; ++j) { const int c = lane + 64 * j; if (c < DV) cat[(size_t)t * D + h * DV + c] = vals[j] * ri * gain[c] * siluf_(g[(size_t)t * ldg + h * DV + c]); }
}
__global__ void __launch_bounds__(256) k_memattn(const float* mq, int ldq, const float* kv, float* cat, int T) {
    __shared__ float ps[4][256];
    __shared__ float qs[4][64];
    const int wv = threadIdx.x >> 6, lane = threadIdx.x & 63;
    const int w = blockIdx.x * 4 + wv;
    const int t = w >> 2, h = w & 3;
    qs[wv][lane] = mq[(size_t)t * ldq + h * 64 + lane];
    __syncthreads();
    float s[4]; float mx = -1e30f;
    for (int i = 0; i < 4; ++i) {
        const int m = lane + 64 * i; const float* kr = kv + (size_t)m * 512 + h * 64;
        float a = 0.f;
        for (int d = 0; d < 64; ++d) a = fmaf(qs[wv][d], kr[d], a);
        s[i] = a * 0.125f; mx = fmaxf(mx, s[i]);
    }
    mx = wmax(mx);
    float sum = 0.f;
    for (int i = 0; i < 4; ++i) { s[i] = expf(s[i] - mx); sum += s[i]; }
    sum = wsum(sum);
    const float inv = 1.f / sum;
    for (int i = 0; i < 4; ++i) ps[wv][lane + 64 * i] = s[i] * inv;
    __syncthreads();
    float a = 0.f;
    for (int m = 0; m < 256; ++m) a = fmaf(ps[wv][m], kv[(size_t)m * 512 + 256 + h * 64 + lane], a);
    cat[(size_t)t * D + MIXW + h * 64 + lane] = a;
}
__global__ void k_route(const float* h, const float* gain, const float* wg, const float* bgp, const float* wr, const float* br, float* rinv, int* eid, float* gate, int rows) {
    const int w = (blockIdx.x * blockDim.x + threadIdx.x) >> 6, lane = threadIdx.x & 63;
    if (w >= rows) return;
    const float* x = h + (size_t)w * D;
    float s = 0.f;
    for (int j = 0; j < 16; ++j) { const float v = x[lane + 64 * j]; s += v * v; }
    s = wsum(s);
    const float ri = rsqrtf(s * (1.f / D) + EPS);
    float lg[20];
    for (int c = 0; c < 20; ++c) lg[c] = 0.f;
    for (int j = 0; j < 16; ++j) {
        const int k = lane + 64 * j; const float tv = x[k] * ri * gain[k];
        for (int c = 0; c < 4; ++c) lg[c] = fmaf(tv, wg[k * 4 + c], lg[c]);
        for (int c = 0; c < 16; ++c) lg[4 + c] = fmaf(tv, wr[k * 16 + c], lg[4 + c]);
    }
    for (int c = 0; c < 20; ++c) lg[c] = wsum(lg[c]);
    if (lane == 0) {
        for (int c = 0; c < 4; ++c) lg[c] += bgp[c];
        for (int c = 0; c < 16; ++c) lg[4 + c] += br[c];
        int gi = 0; float gm = lg[0];
        for (int c = 1; c < 4; ++c) if (lg[c] > gm) { gm = lg[c]; gi = c; }
        float gs = 0.f; for (int c = 0; c < 4; ++c) gs += expf(lg[c] - gm);
        const float gw = 1.f / gs;
        float e[4]; for (int c = 0; c < 4; ++c) e[c] = lg[4 + gi * 4 + c];
        int i0 = 0; for (int c = 1; c < 4; ++c) if (e[c] > e[i0]) i0 = c;
        int i1 = -1; for (int c = 0; c < 4; ++c) if (c != i0 && (i1 < 0 || e[c] > e[i1])) i1 = c;
        const float p1 = expf(e[i1] - e[i0]); const float den = 1.f + p1;
        rinv[w] = ri;
        eid[2 * w] = gi * 4 + i0; eid[2 * w + 1] = gi * 4 + i1;
        gate[2 * w] = gw / den; gate[2 * w + 1] = gw * p1 / den;
    }
}
__global__ void __launch_bounds__(256) k_moe(float* h, const float* gain, const float* rinv, const int* eid, const float* gate, const float* wup, const float* wdn) {
    __shared__ float ts[D];
    __shared__ float hid[FF];
    const int t = blockIdx.x, tid = threadIdx.x;
    float* x = h + (size_t)t * D;
    const float ri = rinv[t];
    for (int j = 0; j < 4; ++j) { const int k = tid + 256 * j; ts[k] = x[k] * ri * gain[k]; }
    __syncthreads();
    float y0 = 0.f, y1 = 0.f, y2 = 0.f, y3 = 0.f;
    for (int s = 0; s < 2; ++s) {
        const int e = eid[2 * t + s]; const float gt = gate[2 * t + s];
        const float* wu = wup + (size_t)e * D * 2 * FF;
        float a = 0.f, b = 0.f;
        for (int d = 0; d < D; ++d) { const float tv = ts[d]; a = fmaf(tv, wu[(size_t)d * 512 + tid], a); b = fmaf(tv, wu[(size_t)d * 512 + 256 + tid], b); }
        __syncthreads();
        hid[tid] = siluf_(a) * b * gt;
        __syncthreads();
        const float* wd = wdn + (size_t)e * FF * D;
        for (int f = 0; f < FF; ++f) { const float hv = hid[f]; const float4 w4 = *(const float4*)(wd + (size_t)f * D + tid * 4); y0 = fmaf(hv, w4.x, y0); y1 = fmaf(hv, w4.y, y1); y2 = fmaf(hv, w4.z, y2); y3 = fmaf(hv, w4.w, y3); }
    }
    float4 o = *(float4*)(x + tid * 4);
    o.x += y0; o.y += y1; o.z += y2; o.w += y3;
    *(float4*)(x + tid * 4) = o;
}
__global__ void k_final(float* h, const float* gain, int rows) {
    const int w = (blockIdx.x * blockDim.x + threadIdx.x) >> 6, lane = threadIdx.x & 63;
    if (w >= rows) return;
    float4* p = (float4*)(h + (size_t)w * D);
    float4 v[4]; float s = 0.f;
    for (int j = 0; j < 4; ++j) { v[j] = p[lane + 64 * j]; s += v[j].x * v[j].x + v[j].y * v[j].y + v[j].z * v[j].z + v[j].w * v[j].w; }
    s = wsum(s);
    const float ri = rsqrtf(s * (1.f / D) + EPS);
    for (int j = 0; j < 4; ++j) { const float4 g = ((const float4*)gain)[lane + 64 * j]; v[j].x *= ri * g.x; v[j].y *= ri * g.y; v[j].z *= ri * g.z; v[j].w *= ri * g.w; p[lane + 64 * j] = v[j]; }
}
}

extern "C" void kernel_launch(void* const* d_in, const int* in_sizes, int n_in, void* d_out, int out_size, void* d_ws, size_t ws_size, hipStream_t stream) {
    using namespace gold;
    const float* x = (const float*)d_in[0];
    const float* mem = (const float*)d_in[1];
    const float* mix_norm = (const float*)d_in[2];
    const float* ffn_norm = (const float*)d_in[3];
    const float* mem_norm = (const float*)d_in[4];
    const float* final_norm = (const float*)d_in[5];
    const float* gla_w_in = (const float*)d_in[6];
    const float* gla_wgu = (const float*)d_in[7];
    const float* gla_bg = (const float*)d_in[8];
    const float* gla_on = (const float*)d_in[9];
    const float* hg_w_in = (const float*)d_in[10];
    const float* hg_lb = (const float*)d_in[11];
    const float* hg_on = (const float*)d_in[12];
    const float* w_mem_kv = (const float*)d_in[13];
    const float* w_out = (const float*)d_in[14];
    const float* w_group = (const float*)d_in[15];
    const float* b_group = (const float*)d_in[16];
    const float* w_router = (const float*)d_in[17];
    const float* b_router = (const float*)d_in[18];
    const float* w_up = (const float*)d_in[19];
    const float* w_down = (const float*)d_in[20];
    float* hbuf = (float*)d_out;
    float* ws = (float*)d_ws;
    size_t off = 0;
    auto take = [&](size_t n) { float* p = ws + off; off += (n + 63) / 64 * 64; return p; };
    float* rinv = take(M);
    float* rinv_mem = take(BATCH * NMEM);
    float* kv = take((size_t)BATCH * NMEM * 512);
    float* proj = take((size_t)SEQ * HG_IN);
    float* qq = take((size_t)SEQ * MIXW);
    float* kk = take((size_t)SEQ * MIXW);
    float* ld = take((size_t)SEQ * MIXW);
    float* ob = take((size_t)SEQ * MIXW);
    float* cat = take((size_t)SEQ * D);
    float* gate = take((size_t)M * 2);
    int* eid = (int*)take((size_t)M * 2);

    for (int layer = 0; layer < 2; ++layer) {
        const float* hin = layer == 0 ? x : hbuf;
        k_rinv<<<M / 4, 256, 0, stream>>>(hin, rinv, M);
        k_rinv<<<BATCH * NMEM / 4, 256, 0, stream>>>(mem, rinv_mem, BATCH * NMEM);
        k_gemm<<<dim3(512 / 128, BATCH * NMEM / 128), 256, 0, stream>>>(mem, D, w_mem_kv + (size_t)layer * D * 512, 512, kv, 512, BATCH * NMEM, 512, D, rinv_mem, mem_norm + layer * D, nullptr, 0);
        for (int b = 0; b < BATCH; ++b) {
            const float* hb = hin + (size_t)b * SEQ * D;
            if (layer == 0) {
                k_gemm<<<dim3((GLA_IN + 127) / 128, SEQ / 128), 256, 0, stream>>>(hb, D, gla_w_in, GLA_IN, proj, GLA_IN, SEQ, GLA_IN, D, rinv + b * SEQ, mix_norm, nullptr, 0);
                k_gla_prep<<<SEQ * GLA_KW / 256, 256, 0, stream>>>(proj, gla_wgu, gla_bg, qq, kk, ld, SEQ);
                k_recur<<<GLA_H * GLA_DV / 4, 256, 0, stream>>>(qq, kk, ld, GLA_KW, proj + 2 * GLA_KW, GLA_IN, GLA_DV, ob, MIXW, SEQ);
                k_outnorm<<<SEQ * GLA_H / 4, 256, 0, stream>>>(ob, proj + 2 * GLA_KW + MIXW, GLA_IN, gla_on, GLA_H, GLA_DV, cat, SEQ);
                k_memattn<<<SEQ, 256, 0, stream>>>(proj + 2 * GLA_KW + 2 * MIXW + GLA_RANK, GLA_IN, kv + (size_t)b * NMEM * 512, cat, SEQ);
            } else {
                k_gemm<<<dim3(HG_IN / 128, SEQ / 128), 256, 0, stream>>>(hb, D, hg_w_in, HG_IN, proj, HG_IN, SEQ, HG_IN, D, rinv + b * SEQ, mix_norm + D, nullptr, 0);
                k_hg_prep<<<SEQ * MIXW / 256, 256, 0, stream>>>(proj, hg_lb, qq, kk, ld, SEQ);
                k_recur<<<HG_H * HG_DV / 4, 256, 0, stream>>>(qq, kk, ld, MIXW, proj + 2 * MIXW, HG_IN, HG_DV, ob, MIXW, SEQ);
                k_outnorm<<<SEQ * HG_H / 4, 256, 0, stream>>>(ob, proj + 3 * MIXW, HG_IN, hg_on, HG_H, HG_DV, cat, SEQ);
                k_memattn<<<SEQ, 256, 0, stream>>>(proj + 4 * MIXW, HG_IN, kv + (size_t)b * NMEM * 512, cat, SEQ);
            }
            k_gemm<<<dim3(D / 128, SEQ / 128), 256, 0, stream>>>(cat, D, w_out + (size_t)layer * D * D, D, hbuf + (size_t)b * SEQ * D, D, SEQ, D, D, nullptr, nullptr, hb, D);
        }
        k_route<<<M / 4, 256, 0, stream>>>(hbuf, ffn_norm + layer * D, w_group + (size_t)layer * D * NG, b_group + layer * NG, w_router + (size_t)layer * D * NE, b_router + layer * NE, rinv, eid, gate, M);
        k_moe<<<M, 256, 0, stream>>>(hbuf, ffn_norm + layer * D, rinv, eid, gate, w_up + (size_t)layer * NE * D * 2 * FF, w_down + (size_t)layer * NE * FF * D);
    }
    k_final<<<M / 4, 256, 0, stream>>>(hbuf, final_norm, M);
}
```

```cpp
#include <hip/hip_runtime.h>
#include <cstdio>
#include <cstdint>

#define GAS __attribute__((address_space(1)))
#define LAS __attribute__((address_space(3)))
typedef unsigned short bf16;
typedef unsigned v4u __attribute__((ext_vector_type(4)));
typedef unsigned v2u __attribute__((ext_vector_type(2)));
typedef float f32x4 __attribute__((ext_vector_type(4)));
typedef short bf16x8 __attribute__((ext_vector_type(8)));
typedef short s16x4 __attribute__((ext_vector_type(4)));
typedef GAS unsigned gu32;
typedef GAS unsigned long long gu64;
#define RLX_AGENT __ATOMIC_RELAXED, __HIP_MEMORY_SCOPE_AGENT
#define LDS_WAIT() asm volatile("s_waitcnt lgkmcnt(0)" ::: "memory")
#define VM_WAIT() asm volatile("s_waitcnt vmcnt(0)" ::: "memory")

constexpr int D = 1024, BATCH = 4, SEQ = 4096, M = BATCH * SEQ, NMEM = 256, MROWS = BATCH * NMEM;
constexpr int MIXW = 768, MEMW = 256, CH = 64, NCH = SEQ / CH;
constexpr int GLA_H = 4, GLA_KW = 512, GLA_DK = 128, GLA_DV = 192, GLA_IN = 2832, GLA_RANK = 16;
constexpr int HG_H = 6, HG_DK = 128, HG_DV = 128, HG_IN = 3328;
constexpr int NG = 4, EPG = 4, NE = 16, FF = 256;
constexpr float EPS = 1e-6f;
constexpr int GLA_LDP = 3072, GLA_CQ = 0, GLA_CK = 512, GLA_CG = 1024, GLA_CV = 1792, GLA_CMQ = 2560, GLA_CR = 2816;
constexpr int HG_LDP = 3328, HG_CQ = 0, HG_CF = 768, HG_CG = 1536, HG_CV = 2304, HG_CMQ = 3072;

__device__ __forceinline__ float bf2f(bf16 b) { return __uint_as_float(((unsigned)b) << 16); }
__device__ __forceinline__ bf16 f2bf(float f) { return __builtin_bit_cast(unsigned short, (__bf16)f); }
__device__ __forceinline__ unsigned pk2(float lo, float hi) { return (unsigned)f2bf(lo) | ((unsigned)f2bf(hi) << 16); }
__device__ __forceinline__ float wave_sum(float v) {
#pragma unroll
    for (int o = 32; o >= 1; o >>= 1) v += __shfl_xor(v, o);
    return v;
}
__device__ __forceinline__ float wave_max(float v) {
#pragma unroll
    for (int o = 32; o >= 1; o >>= 1) v = fmaxf(v, __shfl_xor(v, o));
    return v;
}
__device__ __forceinline__ float sigmoidf_(float x) { return 1.f / (1.f + __expf(-x)); }
__device__ __forceinline__ float siluf_(float x) { return x / (1.f + __expf(-x)); }
__device__ __forceinline__ float logsigmoidf_(float x) { return fminf(x, 0.f) - log1pf(__expf(-fabsf(x))); }

#define N_LAUNCHES 19
namespace pg8 {
#define PG8_LAS __attribute__((address_space(3)))
typedef unsigned short bf16_t;
typedef short bf16x8 __attribute__((ext_vector_type(8)));
typedef float f32x4 __attribute__((ext_vector_type(4)));
typedef unsigned u32x4 __attribute__((ext_vector_type(4)));
constexpr int BM = 256, BK = 64, HALF = 128, HTB = HALF * BK * 2  , STAGE_BYTES = 8 * HTB, NXCD = 8, WGM = 8;

__host__ __device__ __forceinline__ int lds_byte(int r, int c) { const int st = (r >> 4) * 2 + (c >> 5), rr = r & 15, cc = c & 31, ob = rr * 64 + cc * 2; return st * 1024 + (ob ^ (((ob >> 9) & 1) << 5)); }
__host__ __device__ __forceinline__ void stage_rc(int b, int& R, int& C) { const int st = b / 1024, sb = b % 1024, swz = sb ^ (((sb >> 9) & 1) << 5); R = (st >> 1) * 16 + swz / 64; C = (st & 1) * 32 + (swz % 64) / 2; }
__host__ __device__ __forceinline__ int perm32(int rho) { const int n = rho >> 4, i = rho & 15; return 8 * (i >> 2) + 4 * n + (i & 3); }

struct Unit { int pm, pn; int x0, x1, x2, x3; };
struct Gemm { const bf16_t* A; const bf16_t* Bt; int M, N, K, lda, ldb; };

struct StaticOrder {
    int nM, nN, nwg, G, c;
    __host__ __device__ void init(int M, int N, int G_, int c_) { nM = M / BM; nN = N / BM; nwg = nM * nN; G = G_; c = c_; }
    __host__ __device__ bool next(int i, Unit& u) const {
        const long L = (long)i * G + c; if (L >= nwg) return false;
        int wgid = (int)L; { const int q = nwg / NXCD, r = nwg % NXCD, xcd = wgid % NXCD, off = wgid / NXCD; wgid = (xcd < r ? xcd * (q + 1) : r * (q + 1) + (xcd - r) * q) + off; }
        const int nig = WGM * nN, gid = wgid / nig, fm = gid * WGM, gsz = (nM - fm) < WGM ? (nM - fm) : WGM;
        u.pm = fm + ((wgid % nig) % gsz); u.pn = (wgid % nig) / gsz; return true;
    }
    __device__ __forceinline__ void a_ready(const Unit&) const {}
    __device__ __forceinline__ void done(const Unit&) const {}
    static constexpr bool GATHER = false;
    __device__ __forceinline__ unsigned a_off(const Gemm& g, const Unit& u, int r) const { return 0u; }
    __device__ __forceinline__ size_t b_off(const Gemm& g, const Unit& u) const { return (size_t)u.pn * BM * g.ldb * 2; }
    __device__ __forceinline__ long b_delta(const Gemm&, const Unit&) const { return 0; }
};
__device__ __forceinline__ unsigned cvt_pk_bf16(float lo, float hi) { unsigned r; asm volatile("v_cvt_pk_bf16_f32 %0, %1, %2" : "=v"(r) : "v"(lo), "v"(hi)); return r; }
template <class Epi, class Sched, bool ALIGN_EPI = false>
__device__ __forceinline__ void gemm_phase(PG8_LAS unsigned char* lds, const Gemm g, const Sched& S, const Epi& E) {
    int tid_ = threadIdx.x; asm volatile("" : "+v"(tid_));
    const int tid = tid_, wid = __builtin_amdgcn_readfirstlane(tid >> 6), lane = tid & 63, wr = wid >> 2, wc = wid & 3, fr = lane & 15, fq = lane >> 4;
    const int K = g.K, nt = K / BK;
    int Rst[2], Cst[2]; unsigned voffB[2];
#pragma unroll
    for (int i = 0; i < 2; ++i) { int R, C; stage_rc(tid * 16 + i * 8192, R, C); const int Rb = Epi::PERM ? ((R & ~31) + perm32(R & 31)) : R;
        Rst[i] = R; Cst[i] = C * 2; voffB[i] = (unsigned)(Rb * g.ldb + C) * 2u; }
    const unsigned kstep = (unsigned)(BK * 2);
    const size_t hstepB = (size_t)HALF * g.ldb * 2;
    const unsigned ldsw = (unsigned)wid * 1024u;
    const int aoff = lds_byte(wr * 64 + fr, fq * 8), boff = lds_byte(wc * 32 + fr, fq * 8);
#define PG8_SA(b, h) (((b) * 2 + (h)) * HTB)
#define PG8_SB(b, h) ((4 + (b) * 2 + (h)) * HTB)
#define PG8_STAGE_B(bufoff, gbase) do { _Pragma("unroll") for (int _i = 0; _i < 2; ++_i) \
        __builtin_amdgcn_global_load_lds((const unsigned*)((const char*)(gbase) + voffB[_i]), (PG8_LAS unsigned*)(lds + (bufoff) + ldsw + _i * 8192), 16, 0, 0); } while (0)
#define PG8_STAGE_A(bufoff, so, o0, o1) do { const char* _ab = (const char*)g.A + (so); \
        __builtin_amdgcn_global_load_lds((const unsigned*)(_ab + (o0)), (PG8_LAS unsigned*)(lds + (bufoff) + ldsw), 16, 0, 0); \
        __builtin_amdgcn_global_load_lds((const unsigned*)(_ab + (o1)), (PG8_LAS unsigned*)(lds + (bufoff) + ldsw + 8192), 16, 0, 0); } while (0)
#define PG8_LDA(dst, b, h) do { _Pragma("unroll") for (int m = 0; m < 4; ++m) _Pragma("unroll") for (int k = 0; k < 2; ++k) dst[m][k] = *(const PG8_LAS bf16x8*)(lds + PG8_SA(b, h) + aoff + m * 2048 + k * 1024); } while (0)
#define PG8_LDB(dst, b, h) do { _Pragma("unroll") for (int n = 0; n < 2; ++n) _Pragma("unroll") for (int k = 0; k < 2; ++k) dst[n][k] = *(const PG8_LAS bf16x8*)(lds + PG8_SB(b, h) + boff + n * 2048 + k * 1024); } while (0)
#define PG8_MMA(ai, bj, At, Bt) do { __builtin_amdgcn_s_setprio(1); _Pragma("unroll") for (int m = 0; m < 4; ++m) _Pragma("unroll") for (int n = 0; n < 2; ++n) _Pragma("unroll") for (int k = 0; k < 2; ++k) \
        acc[ai][bj][m][n] = __builtin_amdgcn_mfma_f32_16x16x32_bf16(Bt[n][k], At[m][k], acc[ai][bj][m][n], 0, 0, 0); __builtin_amdgcn_s_setprio(0); } while (0)
#define PG8_WAIT_V(n) asm volatile("s_waitcnt vmcnt(" #n ")" ::: "memory")
#define PG8_WAIT_L(n) asm volatile("s_waitcnt lgkmcnt(" #n ")" ::: "memory")
#define PG8_BAR __builtin_amdgcn_s_barrier()
#define PG8_SCHED __builtin_amdgcn_sched_barrier(0)
    Unit cur, nxt; int ui = 0;
    if (!S.next(0, cur)) return;
    f32x4 acc[2][2][4][2];
#pragma unroll
    for (int a = 0; a < 2; ++a)
#pragma unroll
        for (int b = 0; b < 2; ++b)
#pragma unroll
            for (int m = 0; m < 4; ++m)
#pragma unroll
                for (int n = 0; n < 2; ++n) acc[a][b][m][n] = (f32x4){0.f, 0.f, 0.f, 0.f};
    bf16x8 At[4][2], B0[2][2], B1[2][2];
    S.a_ready(cur);
    constexpr bool GA = Sched::GATHER;
    const unsigned voffA0 = (unsigned)(Rst[0] * g.lda) * 2u + Cst[0], voffA1 = (unsigned)(Rst[1] * g.lda) * 2u + Cst[1];
    const size_t hstepA = (size_t)HALF * g.lda * 2;
    unsigned vc00 = voffA0, vc01 = voffA1, vc10 = voffA0, vc11 = voffA1; size_t sc0 = 0, sc1 = 0;
    if constexpr (GA) { vc00 = S.a_off(g, cur, Rst[0]) + Cst[0]; vc01 = S.a_off(g, cur, Rst[1]) + Cst[1]; vc10 = S.a_off(g, cur, HALF + Rst[0]) + Cst[0]; vc11 = S.a_off(g, cur, HALF + Rst[1]) + Cst[1]; }
    else { sc0 = (size_t)cur.pm * 2 * hstepA; sc1 = sc0 + hstepA; }
    const char* cB = (const char*)g.Bt + S.b_off(g, cur); long cD = S.b_delta(g, cur);
    PG8_STAGE_B(PG8_SB(0, 0), cB); PG8_STAGE_B(PG8_SB(0, 1), cB + hstepB); PG8_STAGE_A(PG8_SA(0, 0), sc0, vc00, vc01); PG8_STAGE_A(PG8_SA(0, 1), sc1, vc10, vc11);
    if (wr == 1) PG8_BAR;
    PG8_WAIT_V(2); PG8_BAR;
    PG8_STAGE_B(PG8_SB(1, 0), cB + kstep); PG8_STAGE_A(PG8_SA(1, 0), sc0 + kstep, vc00, vc01); PG8_STAGE_B(PG8_SB(1, 1), cB + hstepB + kstep);
    PG8_WAIT_V(6); PG8_BAR;
    for (;;) {
        const bool has_next = S.next(ui + 1, nxt);
        unsigned vn00 = vc00, vn01 = vc01, vn10 = vc10, vn11 = vc11; size_t sn0 = sc0, sn1 = sc1; const char* nB = cB; long nD = cD;
        if (has_next) {
            if constexpr (GA) { vn00 = S.a_off(g, nxt, Rst[0]) + Cst[0]; vn01 = S.a_off(g, nxt, Rst[1]) + Cst[1]; vn10 = S.a_off(g, nxt, HALF + Rst[0]) + Cst[0]; vn11 = S.a_off(g, nxt, HALF + Rst[1]) + Cst[1]; }
            else { sn0 = (size_t)nxt.pm * 2 * hstepA; sn1 = sn0 + hstepA; }
            nB = (const char*)g.Bt + S.b_off(g, nxt); nD = S.b_delta(g, nxt); }
#pragma nounroll
        for (int t = 0; t < nt; t += 2) {
            const bool last = (t == nt - 2);
            const unsigned k1 = (unsigned)(t + 1) * kstep, k2 = (unsigned)(t + 2) * kstep;
            unsigned o00 = vc00, o01 = vc01, o10 = vc10, o11 = vc11;
            if constexpr (GA) { o00 = last ? vn00 : vc00; o01 = last ? vn01 : vc01; o10 = last ? vn10 : vc10; o11 = last ? vn11 : vc11; }
            const size_t s20 = last ? sn0 : sc0 + k2, s21 = last ? sn1 : sc1 + k2;
            const char* b2 = last ? nB : cB + k2 + ((t + 2) >= nt / 2 ? cD : 0); const char* b3 = b2 + kstep;
            if (last && has_next) S.a_ready(nxt);
            PG8_LDB(B0, 0, 0); PG8_LDB(B1, 0, 1); PG8_SCHED; PG8_LDA(At, 0, 0); PG8_STAGE_A(PG8_SA(1, 1), sc1 + k1, vc10, vc11);
            PG8_WAIT_V(8); PG8_WAIT_L(0); PG8_BAR; PG8_MMA(0, 0, At, B0); PG8_MMA(0, 1, At, B1); PG8_BAR; PG8_SCHED;
            PG8_LDA(At, 0, 1); PG8_STAGE_B(PG8_SB(0, 0), b2); PG8_STAGE_B(PG8_SB(0, 1), b2 + hstepB); PG8_STAGE_A(PG8_SA(0, 0), s20, o00, o01);
            PG8_WAIT_V(8); PG8_WAIT_L(0); PG8_BAR; PG8_MMA(1, 0, At, B0); PG8_MMA(1, 1, At, B1); PG8_BAR; PG8_SCHED;
            PG8_LDB(B0, 1, 0); PG8_LDB(B1, 1, 1); PG8_SCHED; PG8_LDA(At, 1, 0); PG8_STAGE_A(PG8_SA(0, 1), s21, o10, o11);
            PG8_WAIT_V(8); PG8_WAIT_L(0); PG8_BAR; PG8_MMA(0, 0, At, B0); PG8_MMA(0, 1, At, B1); PG8_BAR; PG8_SCHED;
            PG8_LDA(At, 1, 1); PG8_STAGE_B(PG8_SB(1, 0), b3); PG8_STAGE_B(PG8_SB(1, 1), b3 + hstepB); PG8_STAGE_A(PG8_SA(1, 0), s20 + kstep, o00, o01);
            PG8_WAIT_V(8); PG8_WAIT_L(0); PG8_BAR; PG8_MMA(1, 0, At, B0); PG8_MMA(1, 1, At, B1); PG8_BAR; PG8_SCHED;
        }
        if constexpr (ALIGN_EPI) { if (wr == 0) PG8_BAR; }
        if constexpr (!Epi::AFTER_DRAIN) { E(acc, cur, wr, wc, fr, fq); S.done(cur); }
        if (!has_next) break;
#pragma unroll
        for (int a = 0; a < 2; ++a)
#pragma unroll
            for (int b = 0; b < 2; ++b)
#pragma unroll
                for (int m = 0; m < 4; ++m)
#pragma unroll
                    for (int n = 0; n < 2; ++n) acc[a][b][m][n] = (f32x4){0.f, 0.f, 0.f, 0.f};
        cur = nxt; vc00 = vn00; vc01 = vn01; vc10 = vn10; vc11 = vn11; sc0 = sn0; sc1 = sn1; cB = nB; cD = nD; ++ui;
        if constexpr (ALIGN_EPI) { if (wr == 1) PG8_BAR; }
    }
    PG8_WAIT_V(0);
    if constexpr (!ALIGN_EPI) { if (wr == 0) PG8_BAR; }
    PG8_BAR;
    if constexpr (Epi::AFTER_DRAIN) { E.fused(acc, cur, wr, wc, fr, fq, lds, wid, lane); S.done(cur); }
#undef PG8_SA
#undef PG8_SB
#undef PG8_STAGE_A
#undef PG8_STAGE_B
#undef PG8_LDA
#undef PG8_LDB
#undef PG8_MMA
#undef PG8_WAIT_V
#undef PG8_WAIT_L
#undef PG8_BAR
#undef PG8_SCHED
}
}
#define XB_TMO      128
#define XB_XCNT(j)  (256  + 64 * (j))
#define XB_XSUB(j)  (1280 + 64 * (j))
#define XB_XGEN(j)  (2304 + 64 * (j))
#define XB_TOP      3328
#define XB_TOPGEN   3392
#define XCD_BAR_WORDS 3456
#define XB_SPIN_CAP (1u << 18)

__device__ __forceinline__ unsigned xb_ld(unsigned* p)              { return __hip_atomic_load(p, __ATOMIC_RELAXED, __HIP_MEMORY_SCOPE_AGENT); }
__device__ __forceinline__ unsigned xb_add(unsigned* p, unsigned v) { return __hip_atomic_fetch_add(p, v, __ATOMIC_RELAXED, __HIP_MEMORY_SCOPE_AGENT); }
__device__ __forceinline__ unsigned xb_xcc_id() { return (unsigned)__builtin_amdgcn_s_getreg((3 << 11) | 20) & 0xFu; }
#define XB_SPIN(cond, bar) do { unsigned _sp = 0; while (cond) { __builtin_amdgcn_s_sleep(1); \
    if ((++_sp & 255u) == 0u) { if (xb_ld(&(bar)[XB_TMO])) break; if (_sp > XB_SPIN_CAP) { atomicAdd(&(bar)[XB_TMO], 1u); break; } } } } while (0)

struct XcdBarrier {
    unsigned* bar; unsigned x;
    volatile LAS unsigned* st;
};

__device__ __forceinline__ XcdBarrier xcd_barrier_post(unsigned* bar, volatile LAS unsigned* st) {
    XcdBarrier b; b.bar = bar; b.x = xb_xcc_id(); b.st = st;
    if (threadIdx.x == 0) (void)xb_add(&bar[XB_XCNT(b.x)], 1u);
    return b;
}
__device__ __forceinline__ void xcd_barrier_complete(unsigned* bar, unsigned x, unsigned& nloc, unsigned& nx) {
    const unsigned G = gridDim.x * gridDim.y * gridDim.z;
    unsigned sum, cnt, mine, sp = 0u;
    for (;;) {
        sum = 0u; cnt = 0u; mine = 0u;
#pragma unroll
        for (unsigned j = 0; j < 16; ++j) { const unsigned c = xb_ld(&bar[XB_XCNT(j)]); sum += c; cnt += (c > 0u) ? 1u : 0u; mine = (j == x) ? c : mine; }
        if (sum == G) break;
        __builtin_amdgcn_s_sleep(1);
        if ((++sp & 255u) == 0u) { if (xb_ld(&bar[XB_TMO])) break; if (sp > XB_SPIN_CAP) { atomicAdd(&bar[XB_TMO], 1u); break; } }
    }
    nloc = mine > 0u ? mine : 1u; nx = cnt > 0u ? cnt : 1u;
}

__device__ __forceinline__ void xcd_barrier(const XcdBarrier& b) {
    asm volatile("s_waitcnt vmcnt(0)" ::: "memory");
    __syncthreads();
    if (threadIdx.x == 0) {
        unsigned* bar = b.bar;
        __builtin_amdgcn_s_waitcnt(0);
        unsigned nloc = b.st[0], nx = b.st[1];
        if (nloc == 0u) { xcd_barrier_complete(bar, b.x, nloc, nx); b.st[0] = nloc; b.st[1] = nx; }
        const unsigned old = xb_add(&bar[XB_XSUB(b.x)], 1u);
        const unsigned gen = old / nloc;
        if (old + 1u == (gen + 1u) * nloc) {
            __builtin_amdgcn_fence(__ATOMIC_RELEASE, "agent");
            asm volatile("s_waitcnt vmcnt(0)" ::: "memory");
            const unsigned og = xb_add(&bar[XB_TOP], 1u);
            const unsigned tg = og / nx;
            if (og + 1u == (tg + 1u) * nx) xb_add(&bar[XB_TOPGEN], 1u);
            else XB_SPIN(xb_ld(&bar[XB_TOPGEN]) == tg, bar);
            __builtin_amdgcn_fence(__ATOMIC_ACQUIRE, "agent");
            xb_add(&bar[XB_XGEN(b.x)], 1u);
            asm volatile("s_waitcnt vmcnt(0)" ::: "memory");
        } else {
            XB_SPIN(xb_ld(&bar[XB_XGEN(b.x)]) == gen, bar);
            __builtin_amdgcn_fence(__ATOMIC_ACQUIRE, "agent");
            asm volatile("s_waitcnt vmcnt(0)" ::: "memory");
        }
    }
    __syncthreads();
}
constexpr size_t MiB = 1u << 20;
constexpr size_t WS_CTL = 0, CTL_ZERO_BYTES = 1 * MiB;
constexpr size_t WS_WIN = 1 * MiB;
constexpr size_t WS_WOUT = WS_WIN + 13 * MiB / 2;
constexpr size_t WS_WKV = WS_WOUT + 2 * MiB;
constexpr size_t WS_WUP = WS_WKV + 1 * MiB;
constexpr size_t WS_WDN = WS_WUP + 16 * MiB;
constexpr size_t WS_HBF = 35 * MiB;
constexpr size_t WS_MEMBF = WS_HBF + 32 * MiB;
constexpr size_t WS_PROJ = 69 * MiB;
constexpr size_t WS_STATE = 173 * MiB;
constexpr size_t WS_MISC = 250 * MiB;
constexpr size_t WS_RINV = WS_MISC;
constexpr size_t WS_RINVM = WS_RINV + 64 * 1024;
constexpr size_t WS_KVMEM = WS_RINVM + 4096;
constexpr size_t WS_DECAY = WS_KVMEM + 1 * MiB;
constexpr size_t WS_DUMMY = WS_DECAY + 1 * MiB;
constexpr size_t WS_END_OPT = WS_DUMMY + 4096;
static_assert(WS_WDN + 8 * MiB <= WS_HBF && WS_END_OPT <= 256 * MiB, "ws map");
constexpr int CW_BAR = 4096;

constexpr int RING_BYTES = 131072;
constexpr int LDSCTL_OFF = RING_BYTES, MISC_OFF = LDSCTL_OFF + 320;
constexpr int LDS_BYTES = 147456;
constexpr int NWAVES = 8, NTHREADS = 512;
constexpr int NPH = 9;

struct Args {
    const float* in[21]; float* out; unsigned char* ws;
    int ph_lo, ph_hi, use_bar, pad;
};

namespace pg8 {
struct EpiRowScale {
    static constexpr bool PERM = true, AFTER_DRAIN = false;
    bf16_t* O; int ldc; const float* rs;
    __device__ __forceinline__ void operator()(const f32x4 (&acc)[2][2][4][2], const Unit& u, int wr, int wc, int fr, int fq) const {
        const int row0 = u.pm * BM + wr * 64 + fr, col0 = u.pn * BM + wc * 32 + 8 * fq;
#pragma unroll
        for (int ai = 0; ai < 2; ++ai)
#pragma unroll
            for (int m = 0; m < 4; ++m) { const int row = row0 + ai * HALF + m * 16; const float s = rs[row]; bf16_t* rowp = O + (size_t)row * ldc + col0;
#pragma unroll
                for (int bj = 0; bj < 2; ++bj) { const f32x4 v0 = acc[ai][bj][m][0] * s, v1 = acc[ai][bj][m][1] * s;
                    u32x4 w; w.x = cvt_pk_bf16(v0[0], v0[1]); w.y = cvt_pk_bf16(v0[2], v0[3]); w.z = cvt_pk_bf16(v1[0], v1[1]); w.w = cvt_pk_bf16(v1[2], v1[3]);
                    *(u32x4*)(rowp + bj * HALF) = w; } }
    }
};
}

__device__ __forceinline__ int win_dst_row(int layer, int n, float& sc) {
    sc = 1.f;
    if (layer == 0) {
        if (n < 512) { sc = 0.08838834764831845f; return GLA_CQ + n; }
        if (n < 1024) return GLA_CK + (n - 512);
        if (n < 1792) return GLA_CV + (n - 1024);
        if (n < 2560) return GLA_CG + (n - 1792);
        if (n < 2576) return GLA_CR + (n - 2560);
        return GLA_CMQ + (n - 2576);
    } else {
        if (n < 768) return HG_CQ + n;
        if (n < 1536) return HG_CF + (n - 768);
        if (n < 2304) return HG_CV + (n - 1536);
        if (n < 3072) return HG_CG + (n - 2304);
        return HG_CMQ + (n - 3072);
    }
}
template <int MODE>
__device__ __forceinline__ void p0_tr_item(const float* W, int K, int N, const float* gain, bf16* WT, int layer, LAS float* scr, int item, int lane) {
    const int nblk = (N + 31) / 32, kb = item / nblk, nb = item % nblk, k0 = 64 * kb, n0 = 32 * nb;
    const int nn = lane & 7, kq = lane >> 3;
#pragma unroll 4
    for (int i = 0; i < 8; ++i) {
        const int kk = 8 * i + kq; const int n = n0 + 4 * nn;
        f32x4 v = {0.f, 0.f, 0.f, 0.f};
        if (n < N) v = *(const GAS f32x4*)(W + (size_t)(k0 + kk) * N + n);
        const float gk = gain ? gain[k0 + kk] : 1.f;
        scr[(4 * nn + 0) * 65 + kk] = v.x * gk; scr[(4 * nn + 1) * 65 + kk] = v.y * gk; scr[(4 * nn + 2) * 65 + kk] = v.z * gk; scr[(4 * nn + 3) * 65 + kk] = v.w * gk;
    }
    LDS_WAIT(); asm volatile("" ::: "memory");
    const int c = lane & 7;
#pragma unroll
    for (int j = 0; j < 4; ++j) {
        const int nl = (lane >> 3) + 8 * j, n = n0 + nl;
        float sc = 1.f; int dr = n;
        if (MODE == 1) dr = win_dst_row(layer, n, sc);
        if (MODE == 2) { const int f = n & 255, isb = n >> 8; dr = (f >> 7) * 256 + isb * 128 + (f & 127); }
        const LAS float* s = scr + nl * 65 + 8 * c;
        v4u o; o.x = pk2(s[0] * sc, s[1] * sc); o.y = pk2(s[2] * sc, s[3] * sc); o.z = pk2(s[4] * sc, s[5] * sc); o.w = pk2(s[6] * sc, s[7] * sc);
        if (n < N) *(GAS v4u*)(WT + (size_t)dr * K + k0 + 8 * c) = o;
    }
    LDS_WAIT(); asm volatile("" ::: "memory");
}
__device__ __forceinline__ void row_to_bf16(const float* xrow, bf16* orow, float* rinv, int lane) {
    const GAS f32x4* xr = (const GAS f32x4*)xrow + lane;
    f32x4 v[4]; float s = 0.f;
#pragma unroll
    for (int j = 0; j < 4; ++j) { v[j] = xr[64 * j]; s += (v[j].x * v[j].x + v[j].y * v[j].y) + (v[j].z * v[j].z + v[j].w * v[j].w); }
    s = wave_sum(s);
    GAS unsigned long long* o8 = (GAS unsigned long long*)orow + lane;
#pragma unroll
    for (int j = 0; j < 4; ++j) o8[64 * j] = (unsigned long long)pk2(v[j].x, v[j].y) | ((unsigned long long)pk2(v[j].z, v[j].w) << 32);
    if (lane == 0) *rinv = rsqrtf(s * (1.f / D) + EPS);
}
__device__ __forceinline__ void p0_prologue(const Args& a, int layer, LAS unsigned char* lds, int gw, int NGW, int wave, int lane) {
    unsigned char* ws = a.ws;
    LAS float* scr = (LAS float*)(lds + wave * 8448);
    const float* w_in = layer == 0 ? a.in[6] : a.in[10];
    const int NIN = layer == 0 ? GLA_IN : HG_IN;
    const int I_IN = 16 * ((NIN + 31) / 32), I_OUT = 16 * 32, I_KV = 16 * 16, I_UP = 16 * 16 * 16, I_DN = 16 * 4 * 32;
    const int NITEMS = I_IN + I_OUT + I_KV + I_UP + I_DN;
    for (int it = gw; it < NITEMS; it += NGW) {
        int r = it;
        if (r < I_IN) { p0_tr_item<1>(w_in, D, NIN, a.in[2] + layer * D, (bf16*)(ws + WS_WIN), layer, scr, r, lane); continue; } r -= I_IN;
        if (r < I_OUT) { p0_tr_item<0>(a.in[14] + (size_t)layer * D * D, D, D, nullptr, (bf16*)(ws + WS_WOUT), layer, scr, r, lane); continue; } r -= I_OUT;
        if (r < I_KV) { p0_tr_item<0>(a.in[13] + (size_t)layer * D * 512, D, 512, a.in[4] + layer * D, (bf16*)(ws + WS_WKV), layer, scr, r, lane); continue; } r -= I_KV;
        if (r < I_UP) { const int e = r / 256; p0_tr_item<2>(a.in[19] + ((size_t)layer * NE + e) * D * 512, D, 512, a.in[3] + layer * D, (bf16*)(ws + WS_WUP) + (size_t)e * 512 * D, layer, scr, r % 256, lane); continue; } r -= I_UP;
        { const int e = r / 128; p0_tr_item<0>(a.in[20] + ((size_t)layer * NE + e) * FF * D, FF, D, nullptr, (bf16*)(ws + WS_WDN) + (size_t)e * D * FF, layer, scr, r % 128, lane); }
    }
    if (layer == 1) { for (int m = gw; m < M; m += NGW) row_to_bf16(a.out + (size_t)m * D, (bf16*)(ws + WS_HBF) + (size_t)m * D, (float*)(ws + WS_RINV) + m, lane); }
    if (layer == 0) {
        for (int m = gw; m < M; m += NGW) row_to_bf16(a.in[0] + (size_t)m * D, (bf16*)(ws + WS_HBF) + (size_t)m * D, (float*)(ws + WS_RINV) + m, lane);
        for (int m = gw; m < MROWS; m += NGW) row_to_bf16(a.in[1] + (size_t)m * D, (bf16*)(ws + WS_MEMBF) + (size_t)m * D, (float*)(ws + WS_RINVM) + m, lane);
    }
}

template <int MIX> struct MixCfg;
template <> struct MixCfg<0> { static constexpr int H = GLA_H, DV = GLA_DV, LDP = GLA_LDP, CQ = GLA_CQ, CK = GLA_CK, CV = GLA_CV, CG = GLA_CG, CMQ = GLA_CMQ, VSTR = 416; };
template <> struct MixCfg<1> { static constexpr int H = HG_H, DV = HG_DV, LDP = HG_LDP, CQ = HG_CQ, CK = HG_CF, CV = HG_CV, CG = HG_CG, CMQ = HG_CMQ, VSTR = 288; };
constexpr int ISTR = 288;
constexpr int MX_G = 0, MX_T = 32768, MX_BL = 34816, MX_WG = 35328, MX_PREP_END = 43520;
constexpr int MXA_KD = 43520, MXA_V = 61952;
constexpr int MXB_ST = 0, MXB_QD = 55296, MXB_KD = 73728, MXB_V = 92160, MXB_RS = 118784;

__device__ __forceinline__ bf16x8 ld_row8(LAS unsigned char* base, int row, int col, int stride) { return *(const LAS bf16x8*)(base + row * stride + col * 2); }
__device__ __forceinline__ s16x4 ld_tr4(LAS unsigned char* p) { return __builtin_amdgcn_ds_read_tr16_b64_v4i16((LAS s16x4*)p); }
__device__ __forceinline__ bf16x8 ld_trfrag(LAS unsigned char* base, int row0, int col0, int stride, int lane) {
    const int g = lane >> 4, q = (lane & 15) >> 2, p = lane & 3;
    LAS unsigned char* a = base + (row0 + 4 * g + q) * stride + (col0 + 4 * p) * 2;
    const s16x4 lo = ld_tr4(a), hi = ld_tr4(a + 16 * stride);
    return __builtin_shufflevector(lo, hi, 0, 1, 2, 3, 4, 5, 6, 7);
}
__device__ __forceinline__ void unpack8(const v4u w, float (&f)[8]) {
    f[0] = __uint_as_float(w.x << 16); f[1] = __uint_as_float(w.x & 0xffff0000u); f[2] = __uint_as_float(w.y << 16); f[3] = __uint_as_float(w.y & 0xffff0000u);
    f[4] = __uint_as_float(w.z << 16); f[5] = __uint_as_float(w.z & 0xffff0000u); f[6] = __uint_as_float(w.w << 16); f[7] = __uint_as_float(w.w & 0xffff0000u);
}
__device__ __forceinline__ v4u pack8(const float (&f)[8]) { v4u w; w.x = pk2(f[0], f[1]); w.y = pk2(f[2], f[3]); w.z = pk2(f[4], f[5]); w.w = pk2(f[6], f[7]); return w; }

template <int MIX>
__device__ __forceinline__ void mixer_gates(const Args& a, const bf16* proj, LAS unsigned char* lds, int tid, int h, size_t tok0, float (&kx)[2][8]) {
    typedef MixCfg<MIX> C;
    const int co = tid & 15, tg = tid >> 4;
    LAS float* G = (LAS float*)(lds + MX_G); LAS float* T = (LAS float*)(lds + MX_T); LAS float* BL = (LAS float*)(lds + MX_BL);
    float gv[2][8];
    if (MIX == 0) {
        LAS float* WG = (LAS float*)(lds + MX_WG);
        { const int r = tid >> 5, c4 = (tid & 31) * 4; *(LAS f32x4*)(WG + r * 128 + c4) = *(const GAS f32x4*)(a.in[7] + r * GLA_KW + h * 128 + c4); }
        float rr[2][16];
#pragma unroll
        for (int s = 0; s < 2; ++s) {
            const bf16* rowp = proj + (tok0 + 2 * tg + s) * C::LDP;
            const v4u kw = *(const GAS v4u*)(rowp + C::CK + h * 128 + 8 * co); unpack8(kw, kx[s]);
            const v4u r0 = *(const GAS v4u*)(rowp + GLA_CR), r1 = *(const GAS v4u*)(rowp + GLA_CR + 8);
            float t0[8], t1[8]; unpack8(r0, t0); unpack8(r1, t1);
#pragma unroll
            for (int e = 0; e < 8; ++e) { rr[s][e] = t0[e]; rr[s][8 + e] = t1[e]; }
        }
        float bgv[8];
        { const f32x4 b0 = *(const GAS f32x4*)(a.in[8] + h * 128 + 8 * co), b1 = *(const GAS f32x4*)(a.in[8] + h * 128 + 8 * co + 4);
          bgv[0] = b0.x; bgv[1] = b0.y; bgv[2] = b0.z; bgv[3] = b0.w; bgv[4] = b1.x; bgv[5] = b1.y; bgv[6] = b1.z; bgv[7] = b1.w; }
        __syncthreads();
#pragma unroll
        for (int s = 0; s < 2; ++s)
#pragma unroll
            for (int e = 0; e < 8; ++e) gv[s][e] = bgv[e];
#pragma unroll
        for (int r = 0; r < 16; ++r) {
            const f32x4 w0 = *(const LAS f32x4*)(WG + r * 128 + 8 * co), w1 = *(const LAS f32x4*)(WG + r * 128 + 8 * co + 4);
            const float wv[8] = {w0.x, w0.y, w0.z, w0.w, w1.x, w1.y, w1.z, w1.w};
#pragma unroll
            for (int s = 0; s < 2; ++s)
#pragma unroll
                for (int e = 0; e < 8; ++e) gv[s][e] = fmaf(rr[s][r], wv[e], gv[s][e]);
        }
#pragma unroll
        for (int s = 0; s < 2; ++s)
#pragma unroll
            for (int e = 0; e < 8; ++e) { const float xg = gv[s][e]; gv[s][e] = (fminf(xg, 0.f) - __logf(1.f + __expf(-fabsf(xg)))) * (1.f / 16.f); }
    } else {
        float oml[8];
#pragma unroll
        for (int e = 0; e < 8; ++e) { const int c = h * 128 + 8 * co + e; const float dlt = a.in[11][MIXW + c] - a.in[11][c]; oml[e] = 1.f - 1.f / (1.f + __expf(-dlt)); }
#pragma unroll
        for (int s = 0; s < 2; ++s) {
            const bf16* rowp = proj + (tok0 + 2 * tg + s) * C::LDP;
            const v4u zw = *(const GAS v4u*)(rowp + C::CK + h * 128 + 8 * co); float z[8]; unpack8(zw, z);
#pragma unroll
            for (int e = 0; e < 8; ++e) { const float omf = oml[e] / (1.f + __expf(z[e])); kx[s][e] = omf; gv[s][e] = __logf(1.f - omf); }
        }
    }
#pragma unroll
    for (int s = 0; s < 2; ++s) {
        LAS float* gp = G + (2 * tg + s) * 128 + 8 * co;
        *(LAS f32x4*)gp = (f32x4){gv[s][0], gv[s][1], gv[s][2], gv[s][3]}; *(LAS f32x4*)(gp + 4) = (f32x4){gv[s][4], gv[s][5], gv[s][6], gv[s][7]};
    }
    __syncthreads();
    {
        const int kk = tid & 127, seg = tid >> 7;
        float c[16]; float run = 0.f;
#pragma unroll
        for (int i = 0; i < 16; ++i) { run += G[(16 * seg + i) * 128 + kk]; c[i] = run; }
        T[seg * 128 + kk] = run;
        __syncthreads();
        float offs = 0.f, tot = 0.f;
#pragma unroll
        for (int s = 0; s < 4; ++s) { const float ts = T[s * 128 + kk]; tot += ts; if (s < seg) offs += ts; }
#pragma unroll
        for (int i = 0; i < 16; ++i) G[(16 * seg + i) * 128 + kk] = c[i] + offs;
        if (seg == 0) BL[kk] = tot;
    }
    __syncthreads();
}

template <int MIX>
__device__ __forceinline__ void mixer_phase_a(const Args& a, LAS unsigned char* lds, int vcu, int G_) {
    typedef MixCfg<MIX> C;
    int tid = threadIdx.x; asm volatile("" : "+v"(tid));
    const int lane = tid & 63, wave = __builtin_amdgcn_readfirstlane(tid >> 6);
    const bf16* proj = (const bf16*)(a.ws + WS_PROJ);
    constexpr int NIT = BATCH * C::H * NCH, NDT = C::DV / 16, VCH = C::DV / 8;
    for (int item = vcu; item < NIT; item += G_) {
        const int c = item % NCH, h = (item / NCH) % C::H, b = item / (NCH * C::H);
        const size_t tok0 = (size_t)b * SEQ + (size_t)c * CH;
#pragma unroll
        for (int i = 0; i < VCH * 64 / NTHREADS; ++i) { const int id = tid + NTHREADS * i, j = id / VCH, cv = id % VCH;
            *(LAS v4u*)(lds + MXA_V + j * C::VSTR + cv * 16) = *(const GAS v4u*)(proj + (tok0 + j) * C::LDP + C::CV + h * C::DV + 8 * cv); }
        float kx[2][8];
        mixer_gates<MIX>(a, proj, lds, tid, h, tok0, kx);
        {
            const int co = tid & 15, tg = tid >> 4;
            const LAS float* G = (const LAS float*)(lds + MX_G); const LAS float* BL = (const LAS float*)(lds + MX_BL);
            const f32x4 l0 = *(const LAS f32x4*)(BL + 8 * co), l1 = *(const LAS f32x4*)(BL + 8 * co + 4);
            const float bl[8] = {l0.x, l0.y, l0.z, l0.w, l1.x, l1.y, l1.z, l1.w};
#pragma unroll
            for (int s = 0; s < 2; ++s) { const int j = 2 * tg + s;
                const f32x4 b0 = *(const LAS f32x4*)(G + j * 128 + 8 * co), b1 = *(const LAS f32x4*)(G + j * 128 + 8 * co + 4);
                const float bb[8] = {b0.x, b0.y, b0.z, b0.w, b1.x, b1.y, b1.z, b1.w}; float o[8];
#pragma unroll
                for (int e = 0; e < 8; ++e) o[e] = kx[s][e] * __expf(bl[e] - bb[e]);
                *(LAS v4u*)(lds + MXA_KD + j * ISTR + 16 * co) = pack8(o); }
            if (tid < 128) ((float*)(a.ws + WS_DECAY))[(size_t)item * 128 + tid] = __expf(BL[tid]);
        }
        __syncthreads();
        f32x4 acc[NDT];
#pragma unroll
        for (int d = 0; d < NDT; ++d) acc[d] = (f32x4){0.f, 0.f, 0.f, 0.f};
#pragma unroll
        for (int ks = 0; ks < 2; ++ks) {
            const bf16x8 bfrag = ld_trfrag(lds + MXA_KD, 32 * ks, 16 * wave, ISTR, lane);
#pragma unroll
            for (int d = 0; d < NDT; ++d) { const bf16x8 afrag = ld_trfrag(lds + MXA_V, 32 * ks, 16 * d, C::VSTR, lane);
                acc[d] = __builtin_amdgcn_mfma_f32_16x16x32_bf16(afrag, bfrag, acc[d], 0, 0, 0); }
        }
        __syncthreads();
        {   const int g = lane >> 4, kk = 16 * wave + (lane & 15);
#pragma unroll
            for (int d = 0; d < NDT; ++d)
#pragma unroll
                for (int r = 0; r < 4; ++r) *(LAS bf16*)(lds + (16 * d + 4 * g + r) * 256 + kk * 2) = f2bf(acc[d][r]); }
        __syncthreads();
        {   bf16* st = (bf16*)(a.ws + WS_STATE) + (size_t)item * C::DV * 128;
#pragma unroll
            for (int i = 0; i < C::DV * 256 / 16 / NTHREADS; ++i) { const int id = tid + NTHREADS * i; *(GAS v4u*)(st + id * 8) = *(const LAS v4u*)(lds + id * 16); } }
        __syncthreads();
    }
}

template <int MIX>
__device__ __forceinline__ void mixer_scan(const Args& a, int vcu, int G_) {
    typedef MixCfg<MIX> C;
    int tid = threadIdx.x; asm volatile("" : "+v"(tid));
    constexpr int EPB = C::DV * 128 / 2;
    constexpr int NTASK = BATCH * C::H * EPB;
    const float* dec = (const float*)(a.ws + WS_DECAY);
    for (int task = vcu * NTHREADS + tid; task < NTASK; task += G_ * NTHREADS) {
        const int bh = task / EPB, e2 = task % EPB, kk = (2 * e2) & 127;
        unsigned* sp = (unsigned*)(a.ws + WS_STATE) + (size_t)bh * NCH * EPB + e2;
        const float* dp = dec + (size_t)bh * NCH * 128 + kk;
        float s0 = 0.f, s1 = 0.f;
#pragma unroll 8
        for (int c = 0; c < NCH; ++c) {
            const unsigned lw = sp[(size_t)c * EPB];
            const float d0 = dp[c * 128], d1 = dp[c * 128 + 1];
            sp[(size_t)c * EPB] = pk2(s0, s1);
            s0 = fmaf(s0, d0, __uint_as_float(lw << 16)); s1 = fmaf(s1, d1, __uint_as_float(lw & 0xffff0000u));
        }
    }
}

template <int MIX>
__device__ __forceinline__ void mixer_phase_b(const Args& a, LAS unsigned char* lds, int vcu, int G_) {
    typedef MixCfg<MIX> C;
    int tid = threadIdx.x; asm volatile("" : "+v"(tid));
    const int lane = tid & 63, wave = __builtin_amdgcn_readfirstlane(tid >> 6);
    bf16* proj = (bf16*)(a.ws + WS_PROJ);
    constexpr int NIT = BATCH * C::H * NCH, NDT = C::DV / 16, NDH = NDT / 2, VCH = C::DV / 8, SCH = C::DV * 16 / NTHREADS;
    const float* onorm = MIX == 0 ? a.in[9] : a.in[12];
    for (int item = vcu; item < NIT; item += G_) {
        const int c = item % NCH, h = (item / NCH) % C::H, b = item / (NCH * C::H);
        const size_t tok0 = (size_t)b * SEQ + (size_t)c * CH;
        const int co = tid & 15, tg = tid >> 4;
        v4u sreg[SCH];
        { const bf16* st = (const bf16*)(a.ws + WS_STATE) + (size_t)item * C::DV * 128;
#pragma unroll
          for (int i = 0; i < SCH; ++i) sreg[i] = *(const GAS v4u*)(st + (tid + NTHREADS * i) * 8); }
#pragma unroll
        for (int i = 0; i < VCH * 64 / NTHREADS; ++i) { const int id = tid + NTHREADS * i, j = id / VCH, cv = id % VCH;
            *(LAS v4u*)(lds + MXB_V + j * C::VSTR + cv * 16) = *(const GAS v4u*)(proj + (tok0 + j) * C::LDP + C::CV + h * C::DV + 8 * cv); }
        float qx[2][8];
#pragma unroll
        for (int s = 0; s < 2; ++s) { const v4u qw = *(const GAS v4u*)(proj + (tok0 + 2 * tg + s) * C::LDP + C::CQ + h * 128 + 8 * co); unpack8(qw, qx[s]);
            if (MIX == 1) {
#pragma unroll
                for (int e = 0; e < 8; ++e) qx[s][e] = qx[s][e] / (1.f + __expf(-qx[s][e])); } }
        float kx[2][8];
        mixer_gates<MIX>(a, proj, lds, tid, h, tok0, kx);
        {
            const LAS float* G = (const LAS float*)(lds + MX_G);
            float bb[2][8];
#pragma unroll
            for (int s = 0; s < 2; ++s) { const int j = 2 * tg + s;
                const f32x4 b0 = *(const LAS f32x4*)(G + j * 128 + 8 * co), b1 = *(const LAS f32x4*)(G + j * 128 + 8 * co + 4);
                bb[s][0] = b0.x; bb[s][1] = b0.y; bb[s][2] = b0.z; bb[s][3] = b0.w; bb[s][4] = b1.x; bb[s][5] = b1.y; bb[s][6] = b1.z; bb[s][7] = b1.w; }
            __syncthreads();
#pragma unroll
            for (int s = 0; s < 2; ++s) { const int j = 2 * tg + s; float oq[8], ok[8];
#pragma unroll
                for (int e = 0; e < 8; ++e) { const float ex = __expf(bb[s][e]); oq[e] = qx[s][e] * ex; ok[e] = kx[s][e] / ex; }
                *(LAS v4u*)(lds + MXB_QD + j * ISTR + 16 * co) = pack8(oq); *(LAS v4u*)(lds + MXB_KD + j * ISTR + 16 * co) = pack8(ok); }
#pragma unroll
            for (int i = 0; i < SCH; ++i) { const int id = tid + NTHREADS * i, row = id >> 4, ch = id & 15; *(LAS v4u*)(lds + MXB_ST + row * ISTR + ch * 16) = sreg[i]; }
        }
        __syncthreads();
        const int it = wave & 3, dh = wave >> 2, g = lane >> 4, li = lane & 15;
        bf16x8 qf[4];
#pragma unroll
        for (int ks = 0; ks < 4; ++ks) qf[ks] = ld_row8(lds + MXB_QD, 16 * it + li, 32 * ks + 8 * g, ISTR);
        f32x4 X[4];
#pragma unroll
        for (int jt = 0; jt < 4; ++jt) { X[jt] = (f32x4){0.f, 0.f, 0.f, 0.f};
            if (jt <= it) {
#pragma unroll
                for (int ks = 0; ks < 4; ++ks) { const bf16x8 kf = ld_row8(lds + MXB_KD, 16 * jt + li, 32 * ks + 8 * g, ISTR);
                    X[jt] = __builtin_amdgcn_mfma_f32_16x16x32_bf16(kf, qf[ks], X[jt], 0, 0, 0); }
                if (jt == it) {
#pragma unroll
                    for (int r = 0; r < 4; ++r) if (4 * g + r > li) X[jt][r] = 0.f; } } }
        bf16x8 pf[2];
#pragma unroll
        for (int k2 = 0; k2 < 2; ++k2) { v4u w; w.x = pk2(X[2 * k2][0], X[2 * k2][1]); w.y = pk2(X[2 * k2][2], X[2 * k2][3]); w.z = pk2(X[2 * k2 + 1][0], X[2 * k2 + 1][1]); w.w = pk2(X[2 * k2 + 1][2], X[2 * k2 + 1][3]);
            pf[k2] = __builtin_bit_cast(bf16x8, w); }
        f32x4 acc[NDH];
        float ssq = 0.f;
#pragma unroll
        for (int d = 0; d < NDH; ++d) { const int dt = dh * NDH + d; acc[d] = (f32x4){0.f, 0.f, 0.f, 0.f};
#pragma unroll
            for (int k2 = 0; k2 < 2; ++k2) if (2 * k2 <= it) { const bf16x8 vf = ld_trfrag(lds + MXB_V, 32 * k2, 16 * dt, C::VSTR, lane);
                acc[d] = __builtin_amdgcn_mfma_f32_16x16x32_bf16(vf, pf[k2], acc[d], 0, 0, 0); }
#pragma unroll
            for (int ks = 0; ks < 4; ++ks) { const bf16x8 sf = ld_row8(lds + MXB_ST, 16 * dt + li, 32 * ks + 8 * g, ISTR);
                acc[d] = __builtin_amdgcn_mfma_f32_16x16x32_bf16(sf, qf[ks], acc[d], 0, 0, 0); }
            ssq += (acc[d][0] * acc[d][0] + acc[d][1] * acc[d][1]) + (acc[d][2] * acc[d][2] + acc[d][3] * acc[d][3]); }
        ssq += __shfl_xor(ssq, 16); ssq += __shfl_xor(ssq, 32);
        LAS float* RS = (LAS float*)(lds + MXB_RS);
        if (g == 0) RS[dh * 64 + 16 * it + li] = ssq;
        __syncthreads();
        {   const float tot = RS[16 * it + li] + RS[64 + 16 * it + li];
            const float ri = rsqrtf(tot * (1.f / C::DV) + EPS);
            bf16* rowp = proj + (tok0 + 16 * it + li) * C::LDP;
#pragma unroll
            for (int d = 0; d < NDH; ++d) { const int dv = 16 * (dh * NDH + d) + 4 * g;
                const v2u gw = *(const GAS v2u*)(rowp + C::CG + h * C::DV + dv);
                const f32x4 gn = *(const GAS f32x4*)(onorm + dv);
                const float g0 = __uint_as_float(gw.x << 16), g1 = __uint_as_float(gw.x & 0xffff0000u), g2 = __uint_as_float(gw.y << 16), g3 = __uint_as_float(gw.y & 0xffff0000u);
                v2u o; o.x = pk2(acc[d][0] * ri * gn.x * (g0 / (1.f + __expf(-g0))), acc[d][1] * ri * gn.y * (g1 / (1.f + __expf(-g1))));
                o.y = pk2(acc[d][2] * ri * gn.z * (g2 / (1.f + __expf(-g2))), acc[d][3] * ri * gn.w * (g3 / (1.f + __expf(-g3))));
                *(GAS v2u*)(rowp + C::CV + h * C::DV + dv) = o; } }
        __syncthreads();
    }
}

constexpr int MA_STR = 160, MA_K = 0, MA_V = 40960, MA_Q = 81920;
template <int MIX>
__device__ __forceinline__ void memattn_phase(const Args& a, LAS unsigned char* lds, int vcu, int G_) {
    typedef MixCfg<MIX> C;
    int tid = threadIdx.x; asm volatile("" : "+v"(tid));
    const int lane = tid & 63, wave = __builtin_amdgcn_readfirstlane(tid >> 6), g = lane >> 4, li = lane & 15;
    bf16* proj = (bf16*)(a.ws + WS_PROJ);
    const bf16* kvm = (const bf16*)(a.ws + WS_KVMEM);
    constexpr int NIT = (M / 128) * 4;
    for (int item = vcu; item < NIT; item += G_) {
        const int hm = item & 3, tile = item >> 2; const size_t tok0 = (size_t)tile * 128; const int b = (int)(tok0 / SEQ);
#pragma unroll
        for (int i = 0; i < 4; ++i) { const int id = tid + NTHREADS * i, m = id >> 3, ch = id & 7;
            *(LAS v4u*)(lds + MA_K + m * MA_STR + ch * 16) = *(const GAS v4u*)(kvm + (size_t)(b * NMEM + m) * 512 + hm * 64 + 8 * ch);
            *(LAS v4u*)(lds + MA_V + m * MA_STR + ch * 16) = *(const GAS v4u*)(kvm + (size_t)(b * NMEM + m) * 512 + 256 + hm * 64 + 8 * ch); }
#pragma unroll
        for (int i = 0; i < 2; ++i) { const int id = tid + NTHREADS * i, t = id >> 3, ch = id & 7;
            *(LAS v4u*)(lds + MA_Q + t * MA_STR + ch * 16) = *(const GAS v4u*)(proj + (tok0 + t) * C::LDP + C::CMQ + hm * 64 + 8 * ch); }
        __syncthreads();
        bf16x8 qf[2];
#pragma unroll
        for (int ks = 0; ks < 2; ++ks) qf[ks] = ld_row8(lds + MA_Q, 16 * wave + li, 32 * ks + 8 * g, MA_STR);
        f32x4 X[16]; float mx = -3.0e38f;
#pragma unroll
        for (int kt = 0; kt < 16; ++kt) { X[kt] = (f32x4){0.f, 0.f, 0.f, 0.f};
#pragma unroll
            for (int ks = 0; ks < 2; ++ks) { const bf16x8 kf = ld_row8(lds + MA_K, 16 * kt + li, 32 * ks + 8 * g, MA_STR);
                X[kt] = __builtin_amdgcn_mfma_f32_16x16x32_bf16(kf, qf[ks], X[kt], 0, 0, 0); }
            mx = fmaxf(mx, fmaxf(fmaxf(X[kt][0], X[kt][1]), fmaxf(X[kt][2], X[kt][3]))); }
        mx = fmaxf(mx, __shfl_xor(mx, 16)); mx = fmaxf(mx, __shfl_xor(mx, 32));
        float sum = 0.f;
#pragma unroll
        for (int kt = 0; kt < 16; ++kt)
#pragma unroll
            for (int r = 0; r < 4; ++r) { const float p = __expf((X[kt][r] - mx) * 0.125f); X[kt][r] = p; sum += p; }
        sum += __shfl_xor(sum, 16); sum += __shfl_xor(sum, 32);
        const float inv = 1.f / sum;
        f32x4 acc[4];
#pragma unroll
        for (int d = 0; d < 4; ++d) acc[d] = (f32x4){0.f, 0.f, 0.f, 0.f};
#pragma unroll
        for (int k2 = 0; k2 < 8; ++k2) {
            v4u w; w.x = pk2(X[2 * k2][0] * inv, X[2 * k2][1] * inv); w.y = pk2(X[2 * k2][2] * inv, X[2 * k2][3] * inv);
            w.z = pk2(X[2 * k2 + 1][0] * inv, X[2 * k2 + 1][1] * inv); w.w = pk2(X[2 * k2 + 1][2] * inv, X[2 * k2 + 1][3] * inv);
            const bf16x8 pf = __builtin_bit_cast(bf16x8, w);
#pragma unroll
            for (int d = 0; d < 4; ++d) { const bf16x8 vf = ld_trfrag(lds + MA_V, 32 * k2, 16 * d, MA_STR, lane);
                acc[d] = __builtin_amdgcn_mfma_f32_16x16x32_bf16(vf, pf, acc[d], 0, 0, 0); }
        }
        {   bf16* rowp = proj + (tok0 + 16 * wave + li) * C::LDP + C::CMQ + hm * 64;
#pragma unroll
            for (int d = 0; d < 4; ++d) { v2u o; o.x = pk2(acc[d][0], acc[d][1]); o.y = pk2(acc[d][2], acc[d][3]); *(GAS v2u*)(rowp + 16 * d + 4 * g) = o; } }
        __syncthreads();
    }
}
constexpr size_t WS_SLOT = WS_STATE;
constexpr size_t WS_HACT = WS_PROJ;
constexpr int NBK = 24;
constexpr int CW_CNT = 8192;
constexpr int TT_OFF = LDSCTL_OFF + 1024;
struct SlotRec { int token; float rinv, glo, ghi; };

namespace pg8 {
struct EpiResid {
    static constexpr bool PERM = false, AFTER_DRAIN = false;
    const float* base; float* out; int ldc;
    __device__ __forceinline__ void operator()(const f32x4 (&acc)[2][2][4][2], const Unit& u, int wr, int wc, int fr, int fq) const {
        const int row0 = u.pm * BM + wr * 64 + fr, col0 = u.pn * BM + wc * 32 + 4 * fq;
#pragma unroll
        for (int ai = 0; ai < 2; ++ai)
#pragma unroll
            for (int m = 0; m < 4; ++m) { const size_t off = (size_t)(row0 + ai * HALF + m * 16) * ldc + col0;
#pragma unroll
                for (int bj = 0; bj < 2; ++bj)
#pragma unroll
                    for (int n = 0; n < 2; ++n) { const f32x4 bs = *(const f32x4*)(base + off + bj * HALF + n * 16); *(f32x4*)(out + off + bj * HALF + n * 16) = bs + acc[ai][bj][m][n]; }
                asm volatile("" ::: "memory"); }
    }
};
template <int mode> struct MoeOrder {
    static constexpr bool GATHER = (mode == 0);
    const PG8_LAS int* tt; int G, c; const SlotRec* slots;
    __device__ __forceinline__ bool next(int i, Unit& u) const {
        const int L = i * G + c, NT = __builtin_amdgcn_readfirstlane(tt[NBK]);
        if (L >= NT * 4) return false;
        const int rt = L >> 2; int bk = 0;
        for (int b = 1; b < NBK; ++b) if (rt >= __builtin_amdgcn_readfirstlane(tt[b])) bk = b;
        const int tb = __builtin_amdgcn_readfirstlane(tt[bk]), cn = __builtin_amdgcn_readfirstlane(tt[25 + bk]);
        u.pm = rt; u.pn = L & 3; u.x0 = bk; const int first = (rt - tb) * BM; u.x1 = min(cn - first, BM); u.x2 = bk * M + first; u.x3 = 0;
        return true;
    }
    __device__ __forceinline__ void a_ready(const Unit&) const {}
    __device__ __forceinline__ void done(const Unit&) const {}
    __device__ __forceinline__ static void experts(int bk, int& ea, int& eb) { const int g = bk / 6, p = bk % 6; const int lo = p < 3 ? 0 : (p < 5 ? 1 : 2), hi = p < 3 ? p + 1 : (p < 5 ? p - 1 : 3); ea = 4 * g + lo; eb = 4 * g + hi; }
    __device__ __forceinline__ unsigned a_off(const Gemm& g, const Unit& u, int r) const {
        const int rr = r < u.x1 ? r : u.x1 - 1; const int tok = slots[u.x2 + rr].token; return (unsigned)(tok * g.lda) * 2u;
    }
    __device__ __forceinline__ size_t b_off(const Gemm& g, const Unit& u) const {
        int ea, eb; experts(u.x0, ea, eb);
        if (mode == 0) { const int e = (u.pn < 2) ? ea : eb; return ((size_t)e * 512 + (size_t)(u.pn & 1) * 256) * D * 2; }
        return ((size_t)ea * D + (size_t)u.pn * 256) * FF * 2;
    }
    __device__ __forceinline__ long b_delta(const Gemm& g, const Unit& u) const {
        if (mode == 0) return 0;
        int ea, eb; experts(u.x0, ea, eb); return (long)(eb - ea) * D * FF * 2 - (long)FF * 2;
    }
};
struct EpiMoeUp {
    static constexpr bool PERM = true, AFTER_DRAIN = false;
    bf16_t* hact; const SlotRec* slots;
    __device__ __forceinline__ void operator()(const f32x4 (&acc)[2][2][4][2], const Unit& u, int wr, int wc, int fr, int fq) const {
        const int colo = (u.pn >> 1) * 256 + (u.pn & 1) * 128 + wc * 32 + 8 * fq;
#pragma unroll
        for (int ai = 0; ai < 2; ++ai)
#pragma unroll
            for (int m = 0; m < 4; ++m) { const int r = ai * HALF + wr * 64 + m * 16 + fr;
                { const SlotRec sr = slots[u.x2 + (r < u.x1 ? r : u.x1 - 1)]; const float ri = sr.rinv, gt = (u.pn < 2) ? sr.glo : sr.ghi; asm volatile("" ::: "memory");
                    float o[8];
#pragma unroll
                    for (int n = 0; n < 2; ++n)
#pragma unroll
                        for (int j = 0; j < 4; ++j) { const float av = acc[ai][0][m][n][j] * ri, bv = acc[ai][1][m][n][j] * ri; o[4 * n + j] = av / (1.f + __expf(-av)) * bv * gt; }
                    u32x4 w; w.x = cvt_pk_bf16(o[0], o[1]); w.y = cvt_pk_bf16(o[2], o[3]); w.z = cvt_pk_bf16(o[4], o[5]); w.w = cvt_pk_bf16(o[6], o[7]);
                    *(u32x4*)(hact + (size_t)(u.pm * BM + r) * 512 + colo) = w; } }
    }
};
struct EpiMoeDown {
    static constexpr bool PERM = false, AFTER_DRAIN = false;
    float* h; const SlotRec* slots; float* dummy;
    __device__ __forceinline__ void operator()(const f32x4 (&acc)[2][2][4][2], const Unit& u, int wr, int wc, int fr, int fq) const {
        const int col0 = u.pn * BM + wc * 32 + 4 * fq;
#pragma unroll
        for (int ai = 0; ai < 2; ++ai)
#pragma unroll
            for (int m = 0; m < 4; ++m) { const int r = ai * HALF + wr * 64 + m * 16 + fr;
                { const int tok = slots[u.x2 + (r < u.x1 ? r : u.x1 - 1)].token; float* rowp = (r < u.x1 ? h + (size_t)tok * D : dummy) + col0;
#pragma unroll
                    for (int bj = 0; bj < 2; ++bj)
#pragma unroll
                        for (int n = 0; n < 2; ++n) { const f32x4 bs = *(const f32x4*)(rowp + bj * HALF + n * 16); *(f32x4*)(rowp + bj * HALF + n * 16) = bs + acc[ai][bj][m][n]; } }
                asm volatile("" ::: "memory"); }
    }
};
}

__device__ __forceinline__ void route_phase(const Args& a, int layer, LAS unsigned char* lds, int gw, int NGW) {
    int tid = threadIdx.x; asm volatile("" : "+v"(tid));
    const int lane = tid & 63;
    LAS float* WR = (LAS float*)lds;
    const float* gain = a.in[3] + layer * D; const float* wg = a.in[15] + (size_t)layer * D * NG; const float* wr = a.in[17] + (size_t)layer * D * NE;
    for (int idx = tid; idx < 20 * D; idx += NTHREADS) { const int c = idx >> 10, k = idx & 1023; WR[idx] = gain[k] * (c < 4 ? wg[k * 4 + c] : wr[k * 16 + (c - 4)]); }
    __syncthreads();
    float* h = a.out; bf16* hbf = (bf16*)(a.ws + WS_HBF); SlotRec* slots = (SlotRec*)(a.ws + WS_SLOT);
    unsigned* cnt = (unsigned*)(a.ws + WS_CTL) + CW_CNT + layer * 512;
    const float* bgp = a.in[16] + layer * NG; const float* brp = a.in[18] + layer * NE;
    for (int m = gw; m < M; m += NGW) {
        LAS float* WRl = WR + 4 * lane; asm volatile("" : "+v"(WRl));
        const GAS f32x4* xr = (const GAS f32x4*)(h + (size_t)m * D) + lane;
        f32x4 v[4]; float s = 0.f;
#pragma unroll
        for (int j = 0; j < 4; ++j) { v[j] = xr[64 * j]; s += (v[j].x * v[j].x + v[j].y * v[j].y) + (v[j].z * v[j].z + v[j].w * v[j].w); }
        GAS unsigned long long* o8 = (GAS unsigned long long*)(hbf + (size_t)m * D) + lane;
#pragma unroll
        for (int j = 0; j < 4; ++j) o8[64 * j] = (unsigned long long)pk2(v[j].x, v[j].y) | ((unsigned long long)pk2(v[j].z, v[j].w) << 32);
        float lg[20];
#pragma unroll
        for (int c = 0; c < 20; ++c) { float acc = 0.f;
#pragma unroll
            for (int j = 0; j < 4; ++j) { const f32x4 w = *(const LAS f32x4*)(WRl + c * D + 256 * j); acc += (v[j].x * w.x + v[j].y * w.y) + (v[j].z * w.z + v[j].w * w.w); }
            lg[c] = acc; }
        s = wave_sum(s);
#pragma unroll
        for (int c = 0; c < 20; ++c) lg[c] = wave_sum(lg[c]);
        const float ri = rsqrtf(s * (1.f / D) + EPS);
#pragma unroll
        for (int c = 0; c < 4; ++c) lg[c] = lg[c] * ri + bgp[c];
#pragma unroll
        for (int c = 0; c < 16; ++c) lg[4 + c] = lg[4 + c] * ri + brp[c];
        int gi = 0; float gm = lg[0];
#pragma unroll
        for (int c = 1; c < 4; ++c) if (lg[c] > gm) { gm = lg[c]; gi = c; }
        float gs = 0.f;
#pragma unroll
        for (int c = 0; c < 4; ++c) gs += __expf(lg[c] - gm);
        const float gwt = 1.f / gs;
        float e[4];
#pragma unroll
        for (int c = 0; c < 4; ++c) e[c] = gi == 0 ? lg[4 + c] : (gi == 1 ? lg[8 + c] : (gi == 2 ? lg[12 + c] : lg[16 + c]));
        int i0 = 0;
#pragma unroll
        for (int c = 1; c < 4; ++c) if (e[c] > e[i0 == 0 ? 0 : (i0 == 1 ? 1 : (i0 == 2 ? 2 : 3))]) i0 = c;
        float e0 = i0 == 0 ? e[0] : (i0 == 1 ? e[1] : (i0 == 2 ? e[2] : e[3]));
        int i1 = -1; float e1 = -3.0e38f;
#pragma unroll
        for (int c = 0; c < 4; ++c) if (c != i0 && e[c] > e1) { e1 = e[c]; i1 = c; }
        const float p1 = __expf(e1 - e0), den = 1.f / (1.f + p1);
        const float w0 = gwt * den, w1 = gwt * p1 * den;
        const int lo = i0 < i1 ? i0 : i1, hi = i0 < i1 ? i1 : i0;
        const int pr = lo == 0 ? hi - 1 : (lo == 1 ? hi + 1 : 5);
        const int bk = gi * 6 + pr;
        if (lane == 0) {
            const unsigned pos = __hip_atomic_fetch_add(cnt + bk * 16, 1u, __ATOMIC_RELAXED, __HIP_MEMORY_SCOPE_AGENT);
            SlotRec sr; sr.token = m; sr.rinv = ri; sr.glo = i0 < i1 ? w0 : w1; sr.ghi = i0 < i1 ? w1 : w0;
            slots[(size_t)bk * M + pos] = sr;
        }
    }
}
__device__ __forceinline__ void moe_tile_table(const Args& a, int layer, LAS unsigned char* lds) {
    LAS int* tt = (LAS int*)(lds + TT_OFF);
    if (threadIdx.x == 0) {
        const unsigned* cnt = (const unsigned*)(a.ws + WS_CTL) + CW_CNT + layer * 512;
        int acc = 0;
        for (int b = 0; b < NBK; ++b) { const int c = (int)__hip_atomic_load(cnt + b * 16, __ATOMIC_RELAXED, __HIP_MEMORY_SCOPE_AGENT); tt[b] = acc; tt[25 + b] = c; acc += (c + 255) >> 8; }
        tt[NBK] = acc;
    }
    __syncthreads();
}
__device__ __forceinline__ void final_norm_phase(const Args& a, int gw, int NGW) {
    int tid = threadIdx.x; asm volatile("" : "+v"(tid));
    const int lane = tid & 63;
    const float* gain = a.in[5];
    for (int m = gw; m < M; m += NGW) {
        GAS f32x4* xr = (GAS f32x4*)(a.out + (size_t)m * D) + lane;
        f32x4 v[4]; float s = 0.f;
#pragma unroll
        for (int j = 0; j < 4; ++j) { v[j] = xr[64 * j]; s += (v[j].x * v[j].x + v[j].y * v[j].y) + (v[j].z * v[j].z + v[j].w * v[j].w); }
        s = wave_sum(s);
        const float ri = rsqrtf(s * (1.f / D) + EPS);
#pragma unroll
        for (int j = 0; j < 4; ++j) { const f32x4 gn = *((const GAS f32x4*)gain + lane + 64 * j); xr[64 * j] = v[j] * ri * gn; }
    }
}
__global__ void __launch_bounds__(NTHREADS, 2) fwd(Args args) {
    extern __shared__ __attribute__((aligned(16))) unsigned char lds_raw[];
    LAS unsigned char* lds = (LAS unsigned char*)lds_raw;
    const int tid = threadIdx.x, lane0 = tid & 63, wave = __builtin_amdgcn_readfirstlane(tid >> 6);
    const int G = gridDim.x; const int bx = blockIdx.x;
    const int vcu = (G % 8 == 0) ? (bx % 8) * (G / 8) + bx / 8 : bx;
    gu32* ctl = (gu32*)(args.ws + WS_CTL);
    volatile LAS unsigned* MISC = (volatile LAS unsigned*)(lds + MISC_OFF);
    for (int u = tid; u < (LDS_BYTES - LDSCTL_OFF) / 4; u += NTHREADS) ((LAS unsigned*)(lds + LDSCTL_OFF))[u] = 0u;
    __syncthreads();
    XcdBarrier bar; bar.bar = (unsigned*)(ctl + CW_BAR); bar.x = 0; bar.st = nullptr;
    if (args.use_bar) bar = xcd_barrier_post((unsigned*)(ctl + CW_BAR), MISC + 8);
    const int lo = args.ph_lo, hi = args.ph_hi;
#define IN(k) (lo <= (k) && (k) < hi)
#define SEAM(k) do { if (IN(k) && IN((k) + 1)) xcd_barrier(bar); } while (0)
    const int gw = vcu * NWAVES + wave, NGW = G * NWAVES;

    for (int layer = 0; layer < 2; ++layer) {
        const int pb = layer * NPH;
        int lane = lane0; asm volatile("" : "+v"(lane));
        unsigned char* ws = args.ws; asm volatile("" : "+s"(ws));
        if (IN(pb + 0)) { p0_prologue(args, layer, lds, gw, NGW, wave, lane); }
        SEAM(pb + 0);
        if (IN(pb + 1)) {
            const int ldp = layer == 0 ? GLA_LDP : HG_LDP;
            { pg8::Gemm g{(const bf16*)(ws + WS_HBF), (const bf16*)(ws + WS_WIN), M, ldp, D, D, D}; pg8::StaticOrder S; S.init(M, ldp, G, bx);
              pg8::EpiRowScale E{(bf16*)(ws + WS_PROJ), ldp, (const float*)(ws + WS_RINV)};
              pg8::gemm_phase<pg8::EpiRowScale, pg8::StaticOrder, true>(lds, g, S, E); }
            { pg8::Gemm g{(const bf16*)(ws + WS_MEMBF), (const bf16*)(ws + WS_WKV), MROWS, 512, D, D, D}; pg8::StaticOrder S; S.init(MROWS, 512, G, bx);
              pg8::EpiRowScale E{(bf16*)(ws + WS_KVMEM), 512, (const float*)(ws + WS_RINVM)};
              pg8::gemm_phase<pg8::EpiRowScale, pg8::StaticOrder, true>(lds, g, S, E); }
        }
        SEAM(pb + 1);
        if (IN(pb + 2)) { if (layer == 0) mixer_phase_a<0>(args, lds, vcu, G); else mixer_phase_a<1>(args, lds, vcu, G); }
        SEAM(pb + 2);
        if (IN(pb + 3)) { if (layer == 0) mixer_scan<0>(args, vcu, G); else mixer_scan<1>(args, vcu, G); }
        SEAM(pb + 3);
        if (IN(pb + 4)) { if (layer == 0) { mixer_phase_b<0>(args, lds, vcu, G); memattn_phase<0>(args, lds, vcu, G); } else { mixer_phase_b<1>(args, lds, vcu, G); memattn_phase<1>(args, lds, vcu, G); } }
        SEAM(pb + 4);
        if (IN(pb + 5)) {
            const int ldp = layer == 0 ? GLA_LDP : HG_LDP, cv = layer == 0 ? GLA_CV : HG_CV;
            pg8::Gemm g{(const bf16*)(ws + WS_PROJ) + cv, (const bf16*)(ws + WS_WOUT), M, D, D, ldp, D}; pg8::StaticOrder S; S.init(M, D, G, bx);
            pg8::EpiResid E{layer == 0 ? args.in[0] : args.out, args.out, D};
            pg8::gemm_phase<pg8::EpiResid, pg8::StaticOrder, true>(lds, g, S, E);
        }
        SEAM(pb + 5);
        if (IN(pb + 6)) route_phase(args, layer, lds, gw, NGW);
        SEAM(pb + 6);
        if (IN(pb + 7)) {
            moe_tile_table(args, layer, lds);
            pg8::Gemm g{(const bf16*)(ws + WS_HBF), (const bf16*)(ws + WS_WUP), M, 1024, D, D, D};
            pg8::MoeOrder<0> S{(const LAS int*)(lds + TT_OFF), G, vcu, (const SlotRec*)(ws + WS_SLOT)};
            pg8::EpiMoeUp E{(bf16*)(ws + WS_HACT), (const SlotRec*)(ws + WS_SLOT)};
            pg8::gemm_phase<pg8::EpiMoeUp, pg8::MoeOrder<0>, true>(lds, g, S, E);
        }
        SEAM(pb + 7);
        if (IN(pb + 8)) {
            moe_tile_table(args, layer, lds);
            pg8::Gemm g{(const bf16*)(ws + WS_HACT), (const bf16*)(ws + WS_WDN), M, D, 2 * FF, 2 * FF, FF};
            pg8::MoeOrder<1> S{(const LAS int*)(lds + TT_OFF), G, vcu, (const SlotRec*)(ws + WS_SLOT)};
            pg8::EpiMoeDown E{args.out, (const SlotRec*)(ws + WS_SLOT), (float*)(ws + WS_DUMMY)};
            pg8::gemm_phase<pg8::EpiMoeDown, pg8::MoeOrder<1>, true>(lds, g, S, E);
        }
        SEAM(pb + 8);
    }
    if (IN(2 * NPH)) final_norm_phase(args, gw, NGW);
#undef IN
#undef SEAM
}
#ifndef N_LAUNCHES
#define N_LAUNCHES 1
#endif
constexpr int NPHASES = 2 * NPH + 1;
extern "C" void kernel_launch(void* const* d_in, const int* in_sizes, int n_in, void* d_out, int out_size, void* d_ws, size_t ws_size, hipStream_t stream) {
    static int grid = 0;
    if (grid == 0) {
        int dev = 0, cus = 0, per_cu = 0;
        if (n_in != 21 || out_size != M * D || ws_size < 256 * MiB) { fprintf(stderr, "kernel_launch: unexpected problem shape (n_in %d, out %d, ws %zu)\n", n_in, out_size, ws_size); grid = -1; return; }
        if (hipGetDevice(&dev) != hipSuccess || hipDeviceGetAttribute(&cus, hipDeviceAttributeMultiprocessorCount, dev) != hipSuccess) { fprintf(stderr, "kernel_launch: device query failed\n"); grid = -1; return; }
        if (hipFuncSetAttribute((const void*)fwd, hipFuncAttributeMaxDynamicSharedMemorySize, LDS_BYTES) != hipSuccess) { fprintf(stderr, "kernel_launch: hipFuncSetAttribute failed\n"); grid = -1; return; }
        if (hipOccupancyMaxActiveBlocksPerMultiprocessor(&per_cu, (const void*)fwd, NTHREADS, LDS_BYTES) != hipSuccess || per_cu < 1) { fprintf(stderr, "kernel_launch: occupancy query reports %d workgroups per CU; nothing launched\n", per_cu); (void)hipGetLastError(); grid = -1; return; }
        (void)hipGetLastError();
        grid = cus;
    }
    if (grid < 0) return;
    (void)hipMemsetAsync((char*)d_ws + WS_CTL, 0, CTL_ZERO_BYTES, stream);
    Args a{};
    for (int i = 0; i < 21; ++i) a.in[i] = (const float*)d_in[i];
    a.out = (float*)d_out; a.ws = (unsigned char*)d_ws;
    if (N_LAUNCHES == 1) { a.ph_lo = 0; a.ph_hi = NPHASES; a.use_bar = 1; hipLaunchKernelGGL(fwd, dim3(grid), dim3(NTHREADS), LDS_BYTES, stream, a); }
    else for (int p = 0; p < NPHASES; ++p) { a.ph_lo = p; a.ph_hi = p + 1; a.use_bar = 0; hipLaunchKernelGGL(fwd, dim3(grid), dim3(NTHREADS), LDS_BYTES, stream, a); }
}
```

```cpp
#include <hip/hip_runtime.h>
#include <cstdio>
#include <cstdint>

#define GAS __attribute__((address_space(1)))
#define LAS __attribute__((address_space(3)))
typedef unsigned short bf16;
typedef unsigned v4u __attribute__((ext_vector_type(4)));
typedef unsigned v2u __attribute__((ext_vector_type(2)));
typedef float f32x4 __attribute__((ext_vector_type(4)));
typedef short bf16x8 __attribute__((ext_vector_type(8)));
typedef short s16x4 __attribute__((ext_vector_type(4)));
typedef GAS unsigned gu32;
typedef GAS unsigned long long gu64;
#define RLX_AGENT __ATOMIC_RELAXED, __HIP_MEMORY_SCOPE_AGENT
#define LDS_WAIT() asm volatile("s_waitcnt lgkmcnt(0)" ::: "memory")
#define VM_WAIT() asm volatile("s_waitcnt vmcnt(0)" ::: "memory")

constexpr int D = 1024, BATCH = 4, SEQ = 4096, M = BATCH * SEQ, NMEM = 256, MROWS = BATCH * NMEM;
constexpr int MIXW = 768, MEMW = 256, CH = 64, NCH = SEQ / CH;
constexpr int GLA_H = 4, GLA_KW = 512, GLA_DK = 128, GLA_DV = 192, GLA_IN = 2832, GLA_RANK = 16;
constexpr int HG_H = 6, HG_DK = 128, HG_DV = 128, HG_IN = 3328;
constexpr int NG = 4, EPG = 4, NE = 16, FF = 256;
constexpr float EPS = 1e-6f;
constexpr int GLA_LDP = 3072, GLA_CQ = 0, GLA_CK = 512, GLA_CG = 1024, GLA_CV = 1792, GLA_CMQ = 2560, GLA_CR = 2816;
constexpr int HG_LDP = 3328, HG_CQ = 0, HG_CF = 768, HG_CG = 1536, HG_CV = 2304, HG_CMQ = 3072;

__device__ __forceinline__ float bf2f(bf16 b) { return __uint_as_float(((unsigned)b) << 16); }
__device__ __forceinline__ bf16 f2bf(float f) { return __builtin_bit_cast(unsigned short, (__bf16)f); }
__device__ __forceinline__ unsigned pk2(float lo, float hi) { return (unsigned)f2bf(lo) | ((unsigned)f2bf(hi) << 16); }
__device__ __forceinline__ float wave_sum(float v) {
#pragma unroll
    for (int o = 32; o >= 1; o >>= 1) v += __shfl_xor(v, o);
    return v;
}
__device__ __forceinline__ float wave_max(float v) {
#pragma unroll
    for (int o = 32; o >= 1; o >>= 1) v = fmaxf(v, __shfl_xor(v, o));
    return v;
}
__device__ __forceinline__ float sigmoidf_(float x) { return 1.f / (1.f + __expf(-x)); }
__device__ __forceinline__ float siluf_(float x) { return x / (1.f + __expf(-x)); }
__device__ __forceinline__ float logsigmoidf_(float x) { return fminf(x, 0.f) - log1pf(__expf(-fabsf(x))); }

#define N_LAUNCHES 1
namespace pg8 {
#define PG8_LAS __attribute__((address_space(3)))
typedef unsigned short bf16_t;
typedef short bf16x8 __attribute__((ext_vector_type(8)));
typedef float f32x4 __attribute__((ext_vector_type(4)));
typedef unsigned u32x4 __attribute__((ext_vector_type(4)));
constexpr int BM = 256, BK = 64, HALF = 128, HTB = HALF * BK * 2  , STAGE_BYTES = 8 * HTB, NXCD = 8, WGM = 8;

__host__ __device__ __forceinline__ int lds_byte(int r, int c) { const int st = (r >> 4) * 2 + (c >> 5), rr = r & 15, cc = c & 31, ob = rr * 64 + cc * 2; return st * 1024 + (ob ^ (((ob >> 9) & 1) << 5)); }
__host__ __device__ __forceinline__ void stage_rc(int b, int& R, int& C) { const int st = b / 1024, sb = b % 1024, swz = sb ^ (((sb >> 9) & 1) << 5); R = (st >> 1) * 16 + swz / 64; C = (st & 1) * 32 + (swz % 64) / 2; }
__host__ __device__ __forceinline__ int perm32(int rho) { const int n = rho >> 4, i = rho & 15; return 8 * (i >> 2) + 4 * n + (i & 3); }

struct Unit { int pm, pn; int x0, x1, x2, x3; };
struct Gemm { const bf16_t* A; const bf16_t* Bt; int M, N, K, lda, ldb; };

struct StaticOrder {
    int nM, nN, nwg, G, c;
    __host__ __device__ void init(int M, int N, int G_, int c_) { nM = M / BM; nN = N / BM; nwg = nM * nN; G = G_; c = c_; }
    __host__ __device__ bool next(int i, Unit& u) const {
        const long L = (long)i * G + c; if (L >= nwg) return false;
        int wgid = (int)L; { const int q = nwg / NXCD, r = nwg % NXCD, xcd = wgid % NXCD, off = wgid / NXCD; wgid = (xcd < r ? xcd * (q + 1) : r * (q + 1) + (xcd - r) * q) + off; }
        const int nig = WGM * nN, gid = wgid / nig, fm = gid * WGM, gsz = (nM - fm) < WGM ? (nM - fm) : WGM;
        u.pm = fm + ((wgid % nig) % gsz); u.pn = (wgid % nig) / gsz; return true;
    }
    __device__ __forceinline__ void a_ready(const Unit&) const {}
    __device__ __forceinline__ void done(const Unit&) const {}
    static constexpr bool GATHER = false;
    __device__ __forceinline__ unsigned a_off(const Gemm& g, const Unit& u, int r) const { return 0u; }
    __device__ __forceinline__ size_t b_off(const Gemm& g, const Unit& u) const { return (size_t)u.pn * BM * g.ldb * 2; }
    __device__ __forceinline__ long b_delta(const Gemm&, const Unit&) const { return 0; }
};
__device__ __forceinline__ unsigned cvt_pk_bf16(float lo, float hi) { unsigned r; asm volatile("v_cvt_pk_bf16_f32 %0, %1, %2" : "=v"(r) : "v"(lo), "v"(hi)); return r; }
template <class Epi, class Sched, bool ALIGN_EPI = false>
__device__ __forceinline__ void gemm_phase(PG8_LAS unsigned char* lds, const Gemm g, const Sched& S, const Epi& E) {
    int tid_ = threadIdx.x; asm volatile("" : "+v"(tid_));
    const int tid = tid_, wid = __builtin_amdgcn_readfirstlane(tid >> 6), lane = tid & 63, wr = wid >> 2, wc = wid & 3, fr = lane & 15, fq = lane >> 4;
    const int K = g.K, nt = K / BK;
    int Rst[2], Cst[2]; unsigned voffB[2];
#pragma unroll
    for (int i = 0; i < 2; ++i) { int R, C; stage_rc(tid * 16 + i * 8192, R, C); const int Rb = Epi::PERM ? ((R & ~31) + perm32(R & 31)) : R;
        Rst[i] = R; Cst[i] = C * 2; voffB[i] = (unsigned)(Rb * g.ldb + C) * 2u; }
    const unsigned kstep = (unsigned)(BK * 2);
    const size_t hstepB = (size_t)HALF * g.ldb * 2;
    const unsigned ldsw = (unsigned)wid * 1024u;
    const int aoff = lds_byte(wr * 64 + fr, fq * 8), boff = lds_byte(wc * 32 + fr, fq * 8);
#define PG8_SA(b, h) (((b) * 2 + (h)) * HTB)
#define PG8_SB(b, h) ((4 + (b) * 2 + (h)) * HTB)
#define PG8_STAGE_B(bufoff, gbase) do { _Pragma("unroll") for (int _i = 0; _i < 2; ++_i) \
        __builtin_amdgcn_global_load_lds((const unsigned*)((const char*)(gbase) + voffB[_i]), (PG8_LAS unsigned*)(lds + (bufoff) + ldsw + _i * 8192), 16, 0, 0); } while (0)
#define PG8_STAGE_A(bufoff, so, o0, o1) do { const char* _ab = (const char*)g.A + (so); \
        __builtin_amdgcn_global_load_lds((const unsigned*)(_ab + (o0)), (PG8_LAS unsigned*)(lds + (bufoff) + ldsw), 16, 0, 0); \
        __builtin_amdgcn_global_load_lds((const unsigned*)(_ab + (o1)), (PG8_LAS unsigned*)(lds + (bufoff) + ldsw + 8192), 16, 0, 0); } while (0)
#define PG8_LDA(dst, b, h) do { _Pragma("unroll") for (int m = 0; m < 4; ++m) _Pragma("unroll") for (int k = 0; k < 2; ++k) dst[m][k] = *(const PG8_LAS bf16x8*)(lds + PG8_SA(b, h) + aoff + m * 2048 + k * 1024); } while (0)
#define PG8_LDB(dst, b, h) do { _Pragma("unroll") for (int n = 0; n < 2; ++n) _Pragma("unroll") for (int k = 0; k < 2; ++k) dst[n][k] = *(const PG8_LAS bf16x8*)(lds + PG8_SB(b, h) + boff + n * 2048 + k * 1024); } while (0)
#define PG8_MMA(ai, bj, At, Bt) do { __builtin_amdgcn_s_setprio(1); _Pragma("unroll") for (int m = 0; m < 4; ++m) _Pragma("unroll") for (int n = 0; n < 2; ++n) _Pragma("unroll") for (int k = 0; k < 2; ++k) \
        acc[ai][bj][m][n] = __builtin_amdgcn_mfma_f32_16x16x32_bf16(Bt[n][k], At[m][k], acc[ai][bj][m][n], 0, 0, 0); __builtin_amdgcn_s_setprio(0); } while (0)
#define PG8_WAIT_V(n) asm volatile("s_waitcnt vmcnt(" #n ")" ::: "memory")
#define PG8_WAIT_L(n) asm volatile("s_waitcnt lgkmcnt(" #n ")" ::: "memory")
#define PG8_BAR __builtin_amdgcn_s_barrier()
#define PG8_SCHED __builtin_amdgcn_sched_barrier(0)
    Unit cur, nxt; int ui = 0;
    if (!S.next(0, cur)) return;
    f32x4 acc[2][2][4][2];
#pragma unroll
    for (int a = 0; a < 2; ++a)
#pragma unroll
        for (int b = 0; b < 2; ++b)
#pragma unroll
            for (int m = 0; m < 4; ++m)
#pragma unroll
                for (int n = 0; n < 2; ++n) acc[a][b][m][n] = (f32x4){0.f, 0.f, 0.f, 0.f};
    bf16x8 At[4][2], B0[2][2], B1[2][2];
    S.a_ready(cur);
    constexpr bool GA = Sched::GATHER;
    const unsigned voffA0 = (unsigned)(Rst[0] * g.lda) * 2u + Cst[0], voffA1 = (unsigned)(Rst[1] * g.lda) * 2u + Cst[1];
    const size_t hstepA = (size_t)HALF * g.lda * 2;
    unsigned vc00 = voffA0, vc01 = voffA1, vc10 = voffA0, vc11 = voffA1; size_t sc0 = 0, sc1 = 0;
    if constexpr (GA) { vc00 = S.a_off(g, cur, Rst[0]) + Cst[0]; vc01 = S.a_off(g, cur, Rst[1]) + Cst[1]; vc10 = S.a_off(g, cur, HALF + Rst[0]) + Cst[0]; vc11 = S.a_off(g, cur, HALF + Rst[1]) + Cst[1]; }
    else { sc0 = (size_t)cur.pm * 2 * hstepA; sc1 = sc0 + hstepA; }
    const char* cB = (const char*)g.Bt + S.b_off(g, cur); long cD = S.b_delta(g, cur);
    PG8_STAGE_B(PG8_SB(0, 0), cB); PG8_STAGE_B(PG8_SB(0, 1), cB + hstepB); PG8_STAGE_A(PG8_SA(0, 0), sc0, vc00, vc01); PG8_STAGE_A(PG8_SA(0, 1), sc1, vc10, vc11);
    if (wr == 1) PG8_BAR;
    PG8_WAIT_V(2); PG8_BAR;
    PG8_STAGE_B(PG8_SB(1, 0), cB + kstep); PG8_STAGE_A(PG8_SA(1, 0), sc0 + kstep, vc00, vc01); PG8_STAGE_B(PG8_SB(1, 1), cB + hstepB + kstep);
    PG8_WAIT_V(6); PG8_BAR;
    for (;;) {
        const bool has_next = S.next(ui + 1, nxt);
        unsigned vn00 = vc00, vn01 = vc01, vn10 = vc10, vn11 = vc11; size_t sn0 = sc0, sn1 = sc1; const char* nB = cB; long nD = cD;
        if (has_next) {
            if constexpr (GA) { vn00 = S.a_off(g, nxt, Rst[0]) + Cst[0]; vn01 = S.a_off(g, nxt, Rst[1]) + Cst[1]; vn10 = S.a_off(g, nxt, HALF + Rst[0]) + Cst[0]; vn11 = S.a_off(g, nxt, HALF + Rst[1]) + Cst[1]; }
            else { sn0 = (size_t)nxt.pm * 2 * hstepA; sn1 = sn0 + hstepA; }
            nB = (const char*)g.Bt + S.b_off(g, nxt); nD = S.b_delta(g, nxt); }
#pragma nounroll
        for (int t = 0; t < nt; t += 2) {
            const bool last = (t == nt - 2);
            const unsigned k1 = (unsigned)(t + 1) * kstep, k2 = (unsigned)(t + 2) * kstep;
            unsigned o00 = vc00, o01 = vc01, o10 = vc10, o11 = vc11;
            if constexpr (GA) { o00 = last ? vn00 : vc00; o01 = last ? vn01 : vc01; o10 = last ? vn10 : vc10; o11 = last ? vn11 : vc11; }
            const size_t s20 = last ? sn0 : sc0 + k2, s21 = last ? sn1 : sc1 + k2;
            const char* b2 = last ? nB : cB + k2 + ((t + 2) >= nt / 2 ? cD : 0); const char* b3 = b2 + kstep;
            if (last && has_next) S.a_ready(nxt);
            PG8_LDB(B0, 0, 0); PG8_LDB(B1, 0, 1); PG8_SCHED; PG8_LDA(At, 0, 0); PG8_STAGE_A(PG8_SA(1, 1), sc1 + k1, vc10, vc11);
            PG8_WAIT_V(8); PG8_WAIT_L(0); PG8_BAR; PG8_MMA(0, 0, At, B0); PG8_MMA(0, 1, At, B1); PG8_BAR; PG8_SCHED;
            PG8_LDA(At, 0, 1); PG8_STAGE_B(PG8_SB(0, 0), b2); PG8_STAGE_B(PG8_SB(0, 1), b2 + hstepB); PG8_STAGE_A(PG8_SA(0, 0), s20, o00, o01);
            PG8_WAIT_V(8); PG8_WAIT_L(0); PG8_BAR; PG8_MMA(1, 0, At, B0); PG8_MMA(1, 1, At, B1); PG8_BAR; PG8_SCHED;
            PG8_LDB(B0, 1, 0); PG8_LDB(B1, 1, 1); PG8_SCHED; PG8_LDA(At, 1, 0); PG8_STAGE_A(PG8_SA(0, 1), s21, o10, o11);
            PG8_WAIT_V(8); PG8_WAIT_L(0); PG8_BAR; PG8_MMA(0, 0, At, B0); PG8_MMA(0, 1, At, B1); PG8_BAR; PG8_SCHED;
            PG8_LDA(At, 1, 1); PG8_STAGE_B(PG8_SB(1, 0), b3); PG8_STAGE_B(PG8_SB(1, 1), b3 + hstepB); PG8_STAGE_A(PG8_SA(1, 0), s20 + kstep, o00, o01);
            PG8_WAIT_V(8); PG8_WAIT_L(0); PG8_BAR; PG8_MMA(1, 0, At, B0); PG8_MMA(1, 1, At, B1); PG8_BAR; PG8_SCHED;
        }
        if constexpr (ALIGN_EPI) { if (wr == 0) PG8_BAR; }
        if constexpr (!Epi::AFTER_DRAIN) { E(acc, cur, wr, wc, fr, fq); S.done(cur); }
        if (!has_next) break;
#pragma unroll
        for (int a = 0; a < 2; ++a)
#pragma unroll
            for (int b = 0; b < 2; ++b)
#pragma unroll
                for (int m = 0; m < 4; ++m)
#pragma unroll
                    for (int n = 0; n < 2; ++n) acc[a][b][m][n] = (f32x4){0.f, 0.f, 0.f, 0.f};
        cur = nxt; vc00 = vn00; vc01 = vn01; vc10 = vn10; vc11 = vn11; sc0 = sn0; sc1 = sn1; cB = nB; cD = nD; ++ui;
        if constexpr (ALIGN_EPI) { if (wr == 1) PG8_BAR; }
    }
    PG8_WAIT_V(0);
    if constexpr (!ALIGN_EPI) { if (wr == 0) PG8_BAR; }
    PG8_BAR;
    if constexpr (Epi::AFTER_DRAIN) { E.fused(acc, cur, wr, wc, fr, fq, lds, wid, lane); S.done(cur); }
#undef PG8_SA
#undef PG8_SB
#undef PG8_STAGE_A
#undef PG8_STAGE_B
#undef PG8_LDA
#undef PG8_LDB
#undef PG8_MMA
#undef PG8_WAIT_V
#undef PG8_WAIT_L
#undef PG8_BAR
#undef PG8_SCHED
}
}
#define XB_TMO      128
#define XB_XCNT(j)  (256  + 64 * (j))
#define XB_XSUB(j)  (1280 + 64 * (j))
#define XB_XGEN(j)  (2304 + 64 * (j))
#define XB_TOP      3328
#define XB_TOPGEN   3392
#define XCD_BAR_WORDS 3456
#define XB_SPIN_CAP (1u << 18)

__device__ __forceinline__ unsigned xb_ld(unsigned* p)              { return __hip_atomic_load(p, __ATOMIC_RELAXED, __HIP_MEMORY_SCOPE_AGENT); }
__device__ __forceinline__ unsigned xb_add(unsigned* p, unsigned v) { return __hip_atomic_fetch_add(p, v, __ATOMIC_RELAXED, __HIP_MEMORY_SCOPE_AGENT); }
__device__ __forceinline__ unsigned xb_xcc_id() { return (unsigned)__builtin_amdgcn_s_getreg((3 << 11) | 20) & 0xFu; }
#define XB_SPIN(cond, bar) do { unsigned _sp = 0; while (cond) { __builtin_amdgcn_s_sleep(1); \
    if ((++_sp & 255u) == 0u) { if (xb_ld(&(bar)[XB_TMO])) break; if (_sp > XB_SPIN_CAP) { atomicAdd(&(bar)[XB_TMO], 1u); break; } } } } while (0)

struct XcdBarrier {
    unsigned* bar; unsigned x;
    volatile LAS unsigned* st;
};

__device__ __forceinline__ XcdBarrier xcd_barrier_post(unsigned* bar, volatile LAS unsigned* st) {
    XcdBarrier b; b.bar = bar; b.x = xb_xcc_id(); b.st = st;
    if (threadIdx.x == 0) (void)xb_add(&bar[XB_XCNT(b.x)], 1u);
    return b;
}
__device__ __forceinline__ void xcd_barrier_complete(unsigned* bar, unsigned x, unsigned& nloc, unsigned& nx) {
    const unsigned G = gridDim.x * gridDim.y * gridDim.z;
    unsigned sum, cnt, mine, sp = 0u;
    for (;;) {
        sum = 0u; cnt = 0u; mine = 0u;
#pragma unroll
        for (unsigned j = 0; j < 16; ++j) { const unsigned c = xb_ld(&bar[XB_XCNT(j)]); sum += c; cnt += (c > 0u) ? 1u : 0u; mine = (j == x) ? c : mine; }
        if (sum == G) break;
        __builtin_amdgcn_s_sleep(1);
        if ((++sp & 255u) == 0u) { if (xb_ld(&bar[XB_TMO])) break; if (sp > XB_SPIN_CAP) { atomicAdd(&bar[XB_TMO], 1u); break; } }
    }
    nloc = mine > 0u ? mine : 1u; nx = cnt > 0u ? cnt : 1u;
}

__device__ __forceinline__ void xcd_barrier(const XcdBarrier& b) {
    asm volatile("s_waitcnt vmcnt(0)" ::: "memory");
    __syncthreads();
    if (threadIdx.x == 0) {
        unsigned* bar = b.bar;
        __builtin_amdgcn_s_waitcnt(0);
        unsigned nloc = b.st[0], nx = b.st[1];
        if (nloc == 0u) { xcd_barrier_complete(bar, b.x, nloc, nx); b.st[0] = nloc; b.st[1] = nx; }
        const unsigned old = xb_add(&bar[XB_XSUB(b.x)], 1u);
        const unsigned gen = old / nloc;
        if (old + 1u == (gen + 1u) * nloc) {
            __builtin_amdgcn_fence(__ATOMIC_RELEASE, "agent");
            asm volatile("s_waitcnt vmcnt(0)" ::: "memory");
            const unsigned og = xb_add(&bar[XB_TOP], 1u);
            const unsigned tg = og / nx;
            if (og + 1u == (tg + 1u) * nx) xb_add(&bar[XB_TOPGEN], 1u);
            else XB_SPIN(xb_ld(&bar[XB_TOPGEN]) == tg, bar);
            __builtin_amdgcn_fence(__ATOMIC_ACQUIRE, "agent");
            xb_add(&bar[XB_XGEN(b.x)], 1u);
            asm volatile("s_waitcnt vmcnt(0)" ::: "memory");
        } else {
            XB_SPIN(xb_ld(&bar[XB_XGEN(b.x)]) == gen, bar);
            __builtin_amdgcn_fence(__ATOMIC_ACQUIRE, "agent");
            asm volatile("s_waitcnt vmcnt(0)" ::: "memory");
        }
    }
    __syncthreads();
}
constexpr size_t MiB = 1u << 20;
constexpr size_t WS_CTL = 0, CTL_ZERO_BYTES = 1 * MiB;
constexpr size_t WS_WIN = 1 * MiB;
constexpr size_t WS_WOUT = WS_WIN + 13 * MiB / 2;
constexpr size_t WS_WKV = WS_WOUT + 2 * MiB;
constexpr size_t WS_WUP = WS_WKV + 1 * MiB;
constexpr size_t WS_WDN = WS_WUP + 16 * MiB;
constexpr size_t WS_HBF = 35 * MiB;
constexpr size_t WS_MEMBF = WS_HBF + 32 * MiB;
constexpr size_t WS_PROJ = 69 * MiB;
constexpr size_t WS_STATE = 173 * MiB;
constexpr size_t WS_MISC = 250 * MiB;
constexpr size_t WS_RINV = WS_MISC;
constexpr size_t WS_RINVM = WS_RINV + 64 * 1024;
constexpr size_t WS_KVMEM = WS_RINVM + 4096;
constexpr size_t WS_DECAY = WS_KVMEM + 1 * MiB;
constexpr size_t WS_DUMMY = WS_DECAY + 1 * MiB;
constexpr size_t WS_END_OPT = WS_DUMMY + 4096;
static_assert(WS_WDN + 8 * MiB <= WS_HBF && WS_END_OPT <= 256 * MiB, "ws map");
constexpr int CW_BAR = 4096;

constexpr int RING_BYTES = 131072;
constexpr int LDSCTL_OFF = RING_BYTES, MISC_OFF = LDSCTL_OFF + 320;
constexpr int LDS_BYTES = 147456;
constexpr int NWAVES = 8, NTHREADS = 512;
constexpr int NPH = 9;

struct Args {
    const float* in[21]; float* out; unsigned char* ws;
    int ph_lo, ph_hi, use_bar, pad;
};

namespace pg8 {
struct EpiRowScale {
    static constexpr bool PERM = true, AFTER_DRAIN = false;
    bf16_t* O; int ldc; const float* rs;
    __device__ __forceinline__ void operator()(const f32x4 (&acc)[2][2][4][2], const Unit& u, int wr, int wc, int fr, int fq) const {
        const int row0 = u.pm * BM + wr * 64 + fr, col0 = u.pn * BM + wc * 32 + 8 * fq;
#pragma unroll
        for (int ai = 0; ai < 2; ++ai)
#pragma unroll
            for (int m = 0; m < 4; ++m) { const int row = row0 + ai * HALF + m * 16; const float s = rs[row]; bf16_t* rowp = O + (size_t)row * ldc + col0;
#pragma unroll
                for (int bj = 0; bj < 2; ++bj) { const f32x4 v0 = acc[ai][bj][m][0] * s, v1 = acc[ai][bj][m][1] * s;
                    u32x4 w; w.x = cvt_pk_bf16(v0[0], v0[1]); w.y = cvt_pk_bf16(v0[2], v0[3]); w.z = cvt_pk_bf16(v1[0], v1[1]); w.w = cvt_pk_bf16(v1[2], v1[3]);
                    *(u32x4*)(rowp + bj * HALF) = w; } }
    }
};
}

__device__ __forceinline__ int win_dst_row(int layer, int n, float& sc) {
    sc = 1.f;
    if (layer == 0) {
        if (n < 512) { sc = 0.08838834764831845f; return GLA_CQ + n; }
        if (n < 1024) return GLA_CK + (n - 512);
        if (n < 1792) return GLA_CV + (n - 1024);
        if (n < 2560) return GLA_CG + (n - 1792);
        if (n < 2576) return GLA_CR + (n - 2560);
        return GLA_CMQ + (n - 2576);
    } else {
        if (n < 768) return HG_CQ + n;
        if (n < 1536) return HG_CF + (n - 768);
        if (n < 2304) return HG_CV + (n - 1536);
        if (n < 3072) return HG_CG + (n - 2304);
        return HG_CMQ + (n - 3072);
    }
}
template <int MODE>
__device__ __forceinline__ void p0_tr_item(const float* W, int K, int N, const float* gain, bf16* WT, int layer, LAS float* scr, int item, int lane) {
    const int nblk = (N + 31) / 32, kb = item / nblk, nb = item % nblk, k0 = 64 * kb, n0 = 32 * nb;
    const int nn = lane & 7, kq = lane >> 3;
#pragma unroll 4
    for (int i = 0; i < 8; ++i) {
        const int kk = 8 * i + kq; const int n = n0 + 4 * nn;
        f32x4 v = {0.f, 0.f, 0.f, 0.f};
        if (n < N) v = *(const GAS f32x4*)(W + (size_t)(k0 + kk) * N + n);
        const float gk = gain ? gain[k0 + kk] : 1.f;
        scr[(4 * nn + 0) * 65 + kk] = v.x * gk; scr[(4 * nn + 1) * 65 + kk] = v.y * gk; scr[(4 * nn + 2) * 65 + kk] = v.z * gk; scr[(4 * nn + 3) * 65 + kk] = v.w * gk;
    }
    LDS_WAIT(); asm volatile("" ::: "memory");
    const int c = lane & 7;
#pragma unroll
    for (int j = 0; j < 4; ++j) {
        const int nl = (lane >> 3) + 8 * j, n = n0 + nl;
        float sc = 1.f; int dr = n;
        if (MODE == 1) dr = win_dst_row(layer, n, sc);
        if (MODE == 2) { const int f = n & 255, isb = n >> 8; dr = (f >> 7) * 256 + isb * 128 + (f & 127); }
        const LAS float* s = scr + nl * 65 + 8 * c;
        v4u o; o.x = pk2(s[0] * sc, s[1] * sc); o.y = pk2(s[2] * sc, s[3] * sc); o.z = pk2(s[4] * sc, s[5] * sc); o.w = pk2(s[6] * sc, s[7] * sc);
        if (n < N) *(GAS v4u*)(WT + (size_t)dr * K + k0 + 8 * c) = o;
    }
    LDS_WAIT(); asm volatile("" ::: "memory");
}
__device__ __forceinline__ void row_to_bf16(const float* xrow, bf16* orow, float* rinv, int lane) {
    const GAS f32x4* xr = (const GAS f32x4*)xrow + lane;
    f32x4 v[4]; float s = 0.f;
#pragma unroll
    for (int j = 0; j < 4; ++j) { v[j] = xr[64 * j]; s += (v[j].x * v[j].x + v[j].y * v[j].y) + (v[j].z * v[j].z + v[j].w * v[j].w); }
    s = wave_sum(s);
    GAS unsigned long long* o8 = (GAS unsigned long long*)orow + lane;
#pragma unroll
    for (int j = 0; j < 4; ++j) o8[64 * j] = (unsigned long long)pk2(v[j].x, v[j].y) | ((unsigned long long)pk2(v[j].z, v[j].w) << 32);
    if (lane == 0) *rinv = rsqrtf(s * (1.f / D) + EPS);
}
__device__ __forceinline__ void p0_prologue(const Args& a, int layer, LAS unsigned char* lds, int gw, int NGW, int wave, int lane) {
    unsigned char* ws = a.ws;
    LAS float* scr = (LAS float*)(lds + wave * 8448);
    const float* w_in = layer == 0 ? a.in[6] : a.in[10];
    const int NIN = layer == 0 ? GLA_IN : HG_IN;
    const int I_IN = 16 * ((NIN + 31) / 32), I_OUT = 16 * 32, I_KV = 16 * 16, I_UP = 16 * 16 * 16, I_DN = 16 * 4 * 32;
    const int NITEMS = I_IN + I_OUT + I_KV + I_UP + I_DN;
    for (int it = gw; it < NITEMS; it += NGW) {
        int r = it;
        if (r < I_IN) { p0_tr_item<1>(w_in, D, NIN, a.in[2] + layer * D, (bf16*)(ws + WS_WIN), layer, scr, r, lane); continue; } r -= I_IN;
        if (r < I_OUT) { p0_tr_item<0>(a.in[14] + (size_t)layer * D * D, D, D, nullptr, (bf16*)(ws + WS_WOUT), layer, scr, r, lane); continue; } r -= I_OUT;
        if (r < I_KV) { p0_tr_item<0>(a.in[13] + (size_t)layer * D * 512, D, 512, a.in[4] + layer * D, (bf16*)(ws + WS_WKV), layer, scr, r, lane); continue; } r -= I_KV;
        if (r < I_UP) { const int e = r / 256; p0_tr_item<2>(a.in[19] + ((size_t)layer * NE + e) * D * 512, D, 512, a.in[3] + layer * D, (bf16*)(ws + WS_WUP) + (size_t)e * 512 * D, layer, scr, r % 256, lane); continue; } r -= I_UP;
        { const int e = r / 128; p0_tr_item<0>(a.in[20] + ((size_t)layer * NE + e) * FF * D, FF, D, nullptr, (bf16*)(ws + WS_WDN) + (size_t)e * D * FF, layer, scr, r % 128, lane); }
    }
    if (layer == 1) { for (int m = gw; m < M; m += NGW) row_to_bf16(a.out + (size_t)m * D, (bf16*)(ws + WS_HBF) + (size_t)m * D, (float*)(ws + WS_RINV) + m, lane); }
    if (layer == 0) {
        for (int m = gw; m < M; m += NGW) row_to_bf16(a.in[0] + (size_t)m * D, (bf16*)(ws + WS_HBF) + (size_t)m * D, (float*)(ws + WS_RINV) + m, lane);
        for (int m = gw; m < MROWS; m += NGW) row_to_bf16(a.in[1] + (size_t)m * D, (bf16*)(ws + WS_MEMBF) + (size_t)m * D, (float*)(ws + WS_RINVM) + m, lane);
    }
}

template <int MIX> struct MixCfg;
template <> struct MixCfg<0> { static constexpr int H = GLA_H, DV = GLA_DV, LDP = GLA_LDP, CQ = GLA_CQ, CK = GLA_CK, CV = GLA_CV, CG = GLA_CG, CMQ = GLA_CMQ, VSTR = 416; };
template <> struct MixCfg<1> { static constexpr int H = HG_H, DV = HG_DV, LDP = HG_LDP, CQ = HG_CQ, CK = HG_CF, CV = HG_CV, CG = HG_CG, CMQ = HG_CMQ, VSTR = 288; };
constexpr int ISTR = 288;
constexpr int MX_G = 0, MX_T = 32768, MX_BL = 34816, MX_WG = 35328, MX_PREP_END = 43520;
constexpr int MXA_KD = 43520, MXA_V = 61952;
constexpr int MXB_ST = 0, MXB_QD = 55296, MXB_KD = 73728, MXB_V = 92160, MXB_RS = 118784;

__device__ __forceinline__ bf16x8 ld_row8(LAS unsigned char* base, int row, int col, int stride) { return *(const LAS bf16x8*)(base + row * stride + col * 2); }
__device__ __forceinline__ s16x4 ld_tr4(LAS unsigned char* p) { return __builtin_amdgcn_ds_read_tr16_b64_v4i16((LAS s16x4*)p); }
__device__ __forceinline__ bf16x8 ld_trfrag(LAS unsigned char* base, int row0, int col0, int stride, int lane) {
    const int g = lane >> 4, q = (lane & 15) >> 2, p = lane & 3;
    LAS unsigned char* a = base + (row0 + 4 * g + q) * stride + (col0 + 4 * p) * 2;
    const s16x4 lo = ld_tr4(a), hi = ld_tr4(a + 16 * stride);
    return __builtin_shufflevector(lo, hi, 0, 1, 2, 3, 4, 5, 6, 7);
}
__device__ __forceinline__ void unpack8(const v4u w, float (&f)[8]) {
    f[0] = __uint_as_float(w.x << 16); f[1] = __uint_as_float(w.x & 0xffff0000u); f[2] = __uint_as_float(w.y << 16); f[3] = __uint_as_float(w.y & 0xffff0000u);
    f[4] = __uint_as_float(w.z << 16); f[5] = __uint_as_float(w.z & 0xffff0000u); f[6] = __uint_as_float(w.w << 16); f[7] = __uint_as_float(w.w & 0xffff0000u);
}
__device__ __forceinline__ v4u pack8(const float (&f)[8]) { v4u w; w.x = pk2(f[0], f[1]); w.y = pk2(f[2], f[3]); w.z = pk2(f[4], f[5]); w.w = pk2(f[6], f[7]); return w; }

template <int MIX>
__device__ __forceinline__ void mixer_gates(const Args& a, const bf16* proj, LAS unsigned char* lds, int tid, int h, size_t tok0, float (&kx)[2][8]) {
    typedef MixCfg<MIX> C;
    const int co = tid & 15, tg = tid >> 4;
    LAS float* G = (LAS float*)(lds + MX_G); LAS float* T = (LAS float*)(lds + MX_T); LAS float* BL = (LAS float*)(lds + MX_BL);
    float gv[2][8];
    if (MIX == 0) {
        LAS float* WG = (LAS float*)(lds + MX_WG);
        { const int r = tid >> 5, c4 = (tid & 31) * 4; *(LAS f32x4*)(WG + r * 128 + c4) = *(const GAS f32x4*)(a.in[7] + r * GLA_KW + h * 128 + c4); }
        float rr[2][16];
#pragma unroll
        for (int s = 0; s < 2; ++s) {
            const bf16* rowp = proj + (tok0 + 2 * tg + s) * C::LDP;
            const v4u kw = *(const GAS v4u*)(rowp + C::CK + h * 128 + 8 * co); unpack8(kw, kx[s]);
            const v4u r0 = *(const GAS v4u*)(rowp + GLA_CR), r1 = *(const GAS v4u*)(rowp + GLA_CR + 8);
            float t0[8], t1[8]; unpack8(r0, t0); unpack8(r1, t1);
#pragma unroll
            for (int e = 0; e < 8; ++e) { rr[s][e] = t0[e]; rr[s][8 + e] = t1[e]; }
        }
        float bgv[8];
        { const f32x4 b0 = *(const GAS f32x4*)(a.in[8] + h * 128 + 8 * co), b1 = *(const GAS f32x4*)(a.in[8] + h * 128 + 8 * co + 4);
          bgv[0] = b0.x; bgv[1] = b0.y; bgv[2] = b0.z; bgv[3] = b0.w; bgv[4] = b1.x; bgv[5] = b1.y; bgv[6] = b1.z; bgv[7] = b1.w; }
        __syncthreads();
#pragma unroll
        for (int s = 0; s < 2; ++s)
#pragma unroll
            for (int e = 0; e < 8; ++e) gv[s][e] = bgv[e];
#pragma unroll
        for (int r = 0; r < 16; ++r) {
            const f32x4 w0 = *(const LAS f32x4*)(WG + r * 128 + 8 * co), w1 = *(const LAS f32x4*)(WG + r * 128 + 8 * co + 4);
            const float wv[8] = {w0.x, w0.y, w0.z, w0.w, w1.x, w1.y, w1.z, w1.w};
#pragma unroll
            for (int s = 0; s < 2; ++s)
#pragma unroll
                for (int e = 0; e < 8; ++e) gv[s][e] = fmaf(rr[s][r], wv[e], gv[s][e]);
        }
#pragma unroll
        for (int s = 0; s < 2; ++s)
#pragma unroll
            for (int e = 0; e < 8; ++e) { const float xg = gv[s][e]; gv[s][e] = (fminf(xg, 0.f) - __logf(1.f + __expf(-fabsf(xg)))) * (1.f / 16.f); }
    } else {
        float oml[8];
#pragma unroll
        for (int e = 0; e < 8; ++e) { const int c = h * 128 + 8 * co + e; const float dlt = a.in[11][MIXW + c] - a.in[11][c]; oml[e] = 1.f - 1.f / (1.f + __expf(-dlt)); }
#pragma unroll
        for (int s = 0; s < 2; ++s) {
            const bf16* rowp = proj + (tok0 + 2 * tg + s) * C::LDP;
            const v4u zw = *(const GAS v4u*)(rowp + C::CK + h * 128 + 8 * co); float z[8]; unpack8(zw, z);
#pragma unroll
            for (int e = 0; e < 8; ++e) { const float omf = oml[e] / (1.f + __expf(z[e])); kx[s][e] = omf; gv[s][e] = __logf(1.f - omf); }
        }
    }
#pragma unroll
    for (int s = 0; s < 2; ++s) {
        LAS float* gp = G + (2 * tg + s) * 128 + 8 * co;
        *(LAS f32x4*)gp = (f32x4){gv[s][0], gv[s][1], gv[s][2], gv[s][3]}; *(LAS f32x4*)(gp + 4) = (f32x4){gv[s][4], gv[s][5], gv[s][6], gv[s][7]};
    }
    __syncthreads();
    {
        const int kk = tid & 127, seg = tid >> 7;
        float c[16]; float run = 0.f;
#pragma unroll
        for (int i = 0; i < 16; ++i) { run += G[(16 * seg + i) * 128 + kk]; c[i] = run; }
        T[seg * 128 + kk] = run;
        __syncthreads();
        float offs = 0.f, tot = 0.f;
#pragma unroll
        for (int s = 0; s < 4; ++s) { const float ts = T[s * 128 + kk]; tot += ts; if (s < seg) offs += ts; }
#pragma unroll
        for (int i = 0; i < 16; ++i) G[(16 * seg + i) * 128 + kk] = c[i] + offs;
        if (seg == 0) BL[kk] = tot;
    }
    __syncthreads();
}

template <int MIX>
__device__ __forceinline__ void mixer_phase_a(const Args& a, LAS unsigned char* lds, int vcu, int G_) {
    typedef MixCfg<MIX> C;
    int tid = threadIdx.x; asm volatile("" : "+v"(tid));
    const int lane = tid & 63, wave = __builtin_amdgcn_readfirstlane(tid >> 6);
    const bf16* proj = (const bf16*)(a.ws + WS_PROJ);
    constexpr int NIT = BATCH * C::H * NCH, NDT = C::DV / 16, VCH = C::DV / 8;
    for (int item = vcu; item < NIT; item += G_) {
        const int c = item % NCH, h = (item / NCH) % C::H, b = item / (NCH * C::H);
        const size_t tok0 = (size_t)b * SEQ + (size_t)c * CH;
#pragma unroll
        for (int i = 0; i < VCH * 64 / NTHREADS; ++i) { const int id = tid + NTHREADS * i, j = id / VCH, cv = id % VCH;
            *(LAS v4u*)(lds + MXA_V + j * C::VSTR + cv * 16) = *(const GAS v4u*)(proj + (tok0 + j) * C::LDP + C::CV + h * C::DV + 8 * cv); }
        float kx[2][8];
        mixer_gates<MIX>(a, proj, lds, tid, h, tok0, kx);
        {
            const int co = tid & 15, tg = tid >> 4;
            const LAS float* G = (const LAS float*)(lds + MX_G); const LAS float* BL = (const LAS float*)(lds + MX_BL);
            const f32x4 l0 = *(const LAS f32x4*)(BL + 8 * co), l1 = *(const LAS f32x4*)(BL + 8 * co + 4);
            const float bl[8] = {l0.x, l0.y, l0.z, l0.w, l1.x, l1.y, l1.z, l1.w};
#pragma unroll
            for (int s = 0; s < 2; ++s) { const int j = 2 * tg + s;
                const f32x4 b0 = *(const LAS f32x4*)(G + j * 128 + 8 * co), b1 = *(const LAS f32x4*)(G + j * 128 + 8 * co + 4);
                const float bb[8] = {b0.x, b0.y, b0.z, b0.w, b1.x, b1.y, b1.z, b1.w}; float o[8];
#pragma unroll
                for (int e = 0; e < 8; ++e) o[e] = kx[s][e] * __expf(bl[e] - bb[e]);
                *(LAS v4u*)(lds + MXA_KD + j * ISTR + 16 * co) = pack8(o); }
            if (tid < 128) ((float*)(a.ws + WS_DECAY))[(size_t)item * 128 + tid] = __expf(BL[tid]);
        }
        __syncthreads();
        f32x4 acc[NDT];
#pragma unroll
        for (int d = 0; d < NDT; ++d) acc[d] = (f32x4){0.f, 0.f, 0.f, 0.f};
#pragma unroll
        for (int ks = 0; ks < 2; ++ks) {
            const bf16x8 bfrag = ld_trfrag(lds + MXA_KD, 32 * ks, 16 * wave, ISTR, lane);
#pragma unroll
            for (int d = 0; d < NDT; ++d) { const bf16x8 afrag = ld_trfrag(lds + MXA_V, 32 * ks, 16 * d, C::VSTR, lane);
                acc[d] = __builtin_amdgcn_mfma_f32_16x16x32_bf16(afrag, bfrag, acc[d], 0, 0, 0); }
        }
        __syncthreads();
        {   const int g = lane >> 4, kk = 16 * wave + (lane & 15);
#pragma unroll
            for (int d = 0; d < NDT; ++d)
#pragma unroll
                for (int r = 0; r < 4; ++r) *(LAS bf16*)(lds + (16 * d + 4 * g + r) * 256 + kk * 2) = f2bf(acc[d][r]); }
        __syncthreads();
        {   bf16* st = (bf16*)(a.ws + WS_STATE) + (size_t)item * C::DV * 128;
#pragma unroll
            for (int i = 0; i < C::DV * 256 / 16 / NTHREADS; ++i) { const int id = tid + NTHREADS * i; *(GAS v4u*)(st + id * 8) = *(const LAS v4u*)(lds + id * 16); } }
        __syncthreads();
    }
}

template <int MIX>
__device__ __forceinline__ void mixer_scan(const Args& a, int vcu, int G_) {
    typedef MixCfg<MIX> C;
    int tid = threadIdx.x; asm volatile("" : "+v"(tid));
    constexpr int EPB = C::DV * 128 / 2;
    constexpr int NTASK = BATCH * C::H * EPB;
    const float* dec = (const float*)(a.ws + WS_DECAY);
    for (int task = vcu * NTHREADS + tid; task < NTASK; task += G_ * NTHREADS) {
        const int bh = task / EPB, e2 = task % EPB, kk = (2 * e2) & 127;
        unsigned* sp = (unsigned*)(a.ws + WS_STATE) + (size_t)bh * NCH * EPB + e2;
        const float* dp = dec + (size_t)bh * NCH * 128 + kk;
        float s0 = 0.f, s1 = 0.f;
#pragma unroll 8
        for (int c = 0; c < NCH; ++c) {
            const unsigned lw = sp[(size_t)c * EPB];
            const float d0 = dp[c * 128], d1 = dp[c * 128 + 1];
            sp[(size_t)c * EPB] = pk2(s0, s1);
            s0 = fmaf(s0, d0, __uint_as_float(lw << 16)); s1 = fmaf(s1, d1, __uint_as_float(lw & 0xffff0000u));
        }
    }
}

template <int MIX>
__device__ __forceinline__ void mixer_phase_b(const Args& a, LAS unsigned char* lds, int vcu, int G_) {
    typedef MixCfg<MIX> C;
    int tid = threadIdx.x; asm volatile("" : "+v"(tid));
    const int lane = tid & 63, wave = __builtin_amdgcn_readfirstlane(tid >> 6);
    bf16* proj = (bf16*)(a.ws + WS_PROJ);
    constexpr int NIT = BATCH * C::H * NCH, NDT = C::DV / 16, NDH = NDT / 2, VCH = C::DV / 8, SCH = C::DV * 16 / NTHREADS;
    const float* onorm = MIX == 0 ? a.in[9] : a.in[12];
    for (int item = vcu; item < NIT; item += G_) {
        const int c = item % NCH, h = (item / NCH) % C::H, b = item / (NCH * C::H);
        const size_t tok0 = (size_t)b * SEQ + (size_t)c * CH;
        const int co = tid & 15, tg = tid >> 4;
        v4u sreg[SCH];
        { const bf16* st = (const bf16*)(a.ws + WS_STATE) + (size_t)item * C::DV * 128;
#pragma unroll
          for (int i = 0; i < SCH; ++i) sreg[i] = *(const GAS v4u*)(st + (tid + NTHREADS * i) * 8); }
#pragma unroll
        for (int i = 0; i < VCH * 64 / NTHREADS; ++i) { const int id = tid + NTHREADS * i, j = id / VCH, cv = id % VCH;
            *(LAS v4u*)(lds + MXB_V + j * C::VSTR + cv * 16) = *(const GAS v4u*)(proj + (tok0 + j) * C::LDP + C::CV + h * C::DV + 8 * cv); }
        float qx[2][8];
#pragma unroll
        for (int s = 0; s < 2; ++s) { const v4u qw = *(const GAS v4u*)(proj + (tok0 + 2 * tg + s) * C::LDP + C::CQ + h * 128 + 8 * co); unpack8(qw, qx[s]);
            if (MIX == 1) {
#pragma unroll
                for (int e = 0; e < 8; ++e) qx[s][e] = qx[s][e] / (1.f + __expf(-qx[s][e])); } }
        float kx[2][8];
        mixer_gates<MIX>(a, proj, lds, tid, h, tok0, kx);
        {
            const LAS float* G = (const LAS float*)(lds + MX_G);
            float bb[2][8];
#pragma unroll
            for (int s = 0; s < 2; ++s) { const int j = 2 * tg + s;
                const f32x4 b0 = *(const LAS f32x4*)(G + j * 128 + 8 * co), b1 = *(const LAS f32x4*)(G + j * 128 + 8 * co + 4);
                bb[s][0] = b0.x; bb[s][1] = b0.y; bb[s][2] = b0.z; bb[s][3] = b0.w; bb[s][4] = b1.x; bb[s][5] = b1.y; bb[s][6] = b1.z; bb[s][7] = b1.w; }
            __syncthreads();
#pragma unroll
            for (int s = 0; s < 2; ++s) { const int j = 2 * tg + s; float oq[8], ok[8];
#pragma unroll
                for (int e = 0; e < 8; ++e) { const float ex = __expf(bb[s][e]); oq[e] = qx[s][e] * ex; ok[e] = kx[s][e] / ex; }
                *(LAS v4u*)(lds + MXB_QD + j * ISTR + 16 * co) = pack8(oq); *(LAS v4u*)(lds + MXB_KD + j * ISTR + 16 * co) = pack8(ok); }
#pragma unroll
            for (int i = 0; i < SCH; ++i) { const int id = tid + NTHREADS * i, row = id >> 4, ch = id & 15; *(LAS v4u*)(lds + MXB_ST + row * ISTR + ch * 16) = sreg[i]; }
        }
        __syncthreads();
        const int it = wave & 3, dh = wave >> 2, g = lane >> 4, li = lane & 15;
        bf16x8 qf[4];
#pragma unroll
        for (int ks = 0; ks < 4; ++ks) qf[ks] = ld_row8(lds + MXB_QD, 16 * it + li, 32 * ks + 8 * g, ISTR);
        f32x4 X[4];
#pragma unroll
        for (int jt = 0; jt < 4; ++jt) { X[jt] = (f32x4){0.f, 0.f, 0.f, 0.f};
            if (jt <= it) {
#pragma unroll
                for (int ks = 0; ks < 4; ++ks) { const bf16x8 kf = ld_row8(lds + MXB_KD, 16 * jt + li, 32 * ks + 8 * g, ISTR);
                    X[jt] = __builtin_amdgcn_mfma_f32_16x16x32_bf16(kf, qf[ks], X[jt], 0, 0, 0); }
                if (jt == it) {
#pragma unroll
                    for (int r = 0; r < 4; ++r) if (4 * g + r > li) X[jt][r] = 0.f; } } }
        bf16x8 pf[2];
#pragma unroll
        for (int k2 = 0; k2 < 2; ++k2) { v4u w; w.x = pk2(X[2 * k2][0], X[2 * k2][1]); w.y = pk2(X[2 * k2][2], X[2 * k2][3]); w.z = pk2(X[2 * k2 + 1][0], X[2 * k2 + 1][1]); w.w = pk2(X[2 * k2 + 1][2], X[2 * k2 + 1][3]);
            pf[k2] = __builtin_bit_cast(bf16x8, w); }
        f32x4 acc[NDH];
        float ssq = 0.f;
#pragma unroll
        for (int d = 0; d < NDH; ++d) { const int dt = dh * NDH + d; acc[d] = (f32x4){0.f, 0.f, 0.f, 0.f};
#pragma unroll
            for (int k2 = 0; k2 < 2; ++k2) if (2 * k2 <= it) { const bf16x8 vf = ld_trfrag(lds + MXB_V, 32 * k2, 16 * dt, C::VSTR, lane);
                acc[d] = __builtin_amdgcn_mfma_f32_16x16x32_bf16(vf, pf[k2], acc[d], 0, 0, 0); }
#pragma unroll
            for (int ks = 0; ks < 4; ++ks) { const bf16x8 sf = ld_row8(lds + MXB_ST, 16 * dt + li, 32 * ks + 8 * g, ISTR);
                acc[d] = __builtin_amdgcn_mfma_f32_16x16x32_bf16(sf, qf[ks], acc[d], 0, 0, 0); }
            ssq += (acc[d][0] * acc[d][0] + acc[d][1] * acc[d][1]) + (acc[d][2] * acc[d][2] + acc[d][3] * acc[d][3]); }
        ssq += __shfl_xor(ssq, 16); ssq += __shfl_xor(ssq, 32);
        LAS float* RS = (LAS float*)(lds + MXB_RS);
        if (g == 0) RS[dh * 64 + 16 * it + li] = ssq;
        __syncthreads();
        {   const float tot = RS[16 * it + li] + RS[64 + 16 * it + li];
            const float ri = rsqrtf(tot * (1.f / C::DV) + EPS);
            bf16* rowp = proj + (tok0 + 16 * it + li) * C::LDP;
#pragma unroll
            for (int d = 0; d < NDH; ++d) { const int dv = 16 * (dh * NDH + d) + 4 * g;
                const v2u gw = *(const GAS v2u*)(rowp + C::CG + h * C::DV + dv);
                const f32x4 gn = *(const GAS f32x4*)(onorm + dv);
                const float g0 = __uint_as_float(gw.x << 16), g1 = __uint_as_float(gw.x & 0xffff0000u), g2 = __uint_as_float(gw.y << 16), g3 = __uint_as_float(gw.y & 0xffff0000u);
                v2u o; o.x = pk2(acc[d][0] * ri * gn.x * (g0 / (1.f + __expf(-g0))), acc[d][1] * ri * gn.y * (g1 / (1.f + __expf(-g1))));
                o.y = pk2(acc[d][2] * ri * gn.z * (g2 / (1.f + __expf(-g2))), acc[d][3] * ri * gn.w * (g3 / (1.f + __expf(-g3))));
                *(GAS v2u*)(rowp + C::CV + h * C::DV + dv) = o; } }
        __syncthreads();
    }
}

constexpr int MA_STR = 160, MA_K = 0, MA_V = 40960, MA_Q = 81920;
template <int MIX>
__device__ __forceinline__ void memattn_phase(const Args& a, LAS unsigned char* lds, int vcu, int G_) {
    typedef MixCfg<MIX> C;
    int tid = threadIdx.x; asm volatile("" : "+v"(tid));
    const int lane = tid & 63, wave = __builtin_amdgcn_readfirstlane(tid >> 6), g = lane >> 4, li = lane & 15;
    bf16* proj = (bf16*)(a.ws + WS_PROJ);
    const bf16* kvm = (const bf16*)(a.ws + WS_KVMEM);
    constexpr int NIT = (M / 128) * 4;
    for (int item = vcu; item < NIT; item += G_) {
        const int hm = item & 3, tile = item >> 2; const size_t tok0 = (size_t)tile * 128; const int b = (int)(tok0 / SEQ);
#pragma unroll
        for (int i = 0; i < 4; ++i) { const int id = tid + NTHREADS * i, m = id >> 3, ch = id & 7;
            *(LAS v4u*)(lds + MA_K + m * MA_STR + ch * 16) = *(const GAS v4u*)(kvm + (size_t)(b * NMEM + m) * 512 + hm * 64 + 8 * ch);
            *(LAS v4u*)(lds + MA_V + m * MA_STR + ch * 16) = *(const GAS v4u*)(kvm + (size_t)(b * NMEM + m) * 512 + 256 + hm * 64 + 8 * ch); }
#pragma unroll
        for (int i = 0; i < 2; ++i) { const int id = tid + NTHREADS * i, t = id >> 3, ch = id & 7;
            *(LAS v4u*)(lds + MA_Q + t * MA_STR + ch * 16) = *(const GAS v4u*)(proj + (tok0 + t) * C::LDP + C::CMQ + hm * 64 + 8 * ch); }
        __syncthreads();
        bf16x8 qf[2];
#pragma unroll
        for (int ks = 0; ks < 2; ++ks) qf[ks] = ld_row8(lds + MA_Q, 16 * wave + li, 32 * ks + 8 * g, MA_STR);
        f32x4 X[16]; float mx = -3.0e38f;
#pragma unroll
        for (int kt = 0; kt < 16; ++kt) { X[kt] = (f32x4){0.f, 0.f, 0.f, 0.f};
#pragma unroll
            for (int ks = 0; ks < 2; ++ks) { const bf16x8 kf = ld_row8(lds + MA_K, 16 * kt + li, 32 * ks + 8 * g, MA_STR);
                X[kt] = __builtin_amdgcn_mfma_f32_16x16x32_bf16(kf, qf[ks], X[kt], 0, 0, 0); }
            mx = fmaxf(mx, fmaxf(fmaxf(X[kt][0], X[kt][1]), fmaxf(X[kt][2], X[kt][3]))); }
        mx = fmaxf(mx, __shfl_xor(mx, 16)); mx = fmaxf(mx, __shfl_xor(mx, 32));
        float sum = 0.f;
#pragma unroll
        for (int kt = 0; kt < 16; ++kt)
#pragma unroll
            for (int r = 0; r < 4; ++r) { const float p = __expf((X[kt][r] - mx) * 0.125f); X[kt][r] = p; sum += p; }
        sum += __shfl_xor(sum, 16); sum += __shfl_xor(sum, 32);
        const float inv = 1.f / sum;
        f32x4 acc[4];
#pragma unroll
        for (int d = 0; d < 4; ++d) acc[d] = (f32x4){0.f, 0.f, 0.f, 0.f};
#pragma unroll
        for (int k2 = 0; k2 < 8; ++k2) {
            v4u w; w.x = pk2(X[2 * k2][0] * inv, X[2 * k2][1] * inv); w.y = pk2(X[2 * k2][2] * inv, X[2 * k2][3] * inv);
            w.z = pk2(X[2 * k2 + 1][0] * inv, X[2 * k2 + 1][1] * inv); w.w = pk2(X[2 * k2 + 1][2] * inv, X[2 * k2 + 1][3] * inv);
            const bf16x8 pf = __builtin_bit_cast(bf16x8, w);
#pragma unroll
            for (int d = 0; d < 4; ++d) { const bf16x8 vf = ld_trfrag(lds + MA_V, 32 * k2, 16 * d, MA_STR, lane);
                acc[d] = __builtin_amdgcn_mfma_f32_16x16x32_bf16(vf, pf, acc[d], 0, 0, 0); }
        }
        {   bf16* rowp = proj + (tok0 + 16 * wave + li) * C::LDP + C::CMQ + hm * 64;
#pragma unroll
            for (int d = 0; d < 4; ++d) { v2u o; o.x = pk2(acc[d][0], acc[d][1]); o.y = pk2(acc[d][2], acc[d][3]); *(GAS v2u*)(rowp + 16 * d + 4 * g) = o; } }
        __syncthreads();
    }
}
constexpr size_t WS_SLOT = WS_STATE;
constexpr size_t WS_HACT = WS_PROJ;
constexpr int NBK = 24;
constexpr int CW_CNT = 8192;
constexpr int TT_OFF = LDSCTL_OFF + 1024;
struct SlotRec { int token; float rinv, glo, ghi; };

namespace pg8 {
struct EpiResid {
    static constexpr bool PERM = false, AFTER_DRAIN = false;
    const float* base; float* out; int ldc;
    __device__ __forceinline__ void operator()(const f32x4 (&acc)[2][2][4][2], const Unit& u, int wr, int wc, int fr, int fq) const {
        const int row0 = u.pm * BM + wr * 64 + fr, col0 = u.pn * BM + wc * 32 + 4 * fq;
#pragma unroll
        for (int ai = 0; ai < 2; ++ai)
#pragma unroll
            for (int m = 0; m < 4; ++m) { const size_t off = (size_t)(row0 + ai * HALF + m * 16) * ldc + col0;
#pragma unroll
                for (int bj = 0; bj < 2; ++bj)
#pragma unroll
                    for (int n = 0; n < 2; ++n) { const f32x4 bs = *(const f32x4*)(base + off + bj * HALF + n * 16); *(f32x4*)(out + off + bj * HALF + n * 16) = bs + acc[ai][bj][m][n]; }
                asm volatile("" ::: "memory"); }
    }
};
template <int mode> struct MoeOrder {
    static constexpr bool GATHER = (mode == 0);
    const PG8_LAS int* tt; int G, c; const SlotRec* slots;
    __device__ __forceinline__ bool next(int i, Unit& u) const {
        const int L = i * G + c, NT = __builtin_amdgcn_readfirstlane(tt[NBK]);
        if (L >= NT * 4) return false;
        const int rt = L >> 2; int bk = 0;
        for (int b = 1; b < NBK; ++b) if (rt >= __builtin_amdgcn_readfirstlane(tt[b])) bk = b;
        const int tb = __builtin_amdgcn_readfirstlane(tt[bk]), cn = __builtin_amdgcn_readfirstlane(tt[25 + bk]);
        u.pm = rt; u.pn = L & 3; u.x0 = bk; const int first = (rt - tb) * BM; u.x1 = min(cn - first, BM); u.x2 = bk * M + first; u.x3 = 0;
        return true;
    }
    __device__ __forceinline__ void a_ready(const Unit&) const {}
    __device__ __forceinline__ void done(const Unit&) const {}
    __device__ __forceinline__ static void experts(int bk, int& ea, int& eb) { const int g = bk / 6, p = bk % 6; const int lo = p < 3 ? 0 : (p < 5 ? 1 : 2), hi = p < 3 ? p + 1 : (p < 5 ? p - 1 : 3); ea = 4 * g + lo; eb = 4 * g + hi; }
    __device__ __forceinline__ unsigned a_off(const Gemm& g, const Unit& u, int r) const {
        const int rr = r < u.x1 ? r : u.x1 - 1; const int tok = slots[u.x2 + rr].token; return (unsigned)(tok * g.lda) * 2u;
    }
    __device__ __forceinline__ size_t b_off(const Gemm& g, const Unit& u) const {
        int ea, eb; experts(u.x0, ea, eb);
        if (mode == 0) { const int e = (u.pn < 2) ? ea : eb; return ((size_t)e * 512 + (size_t)(u.pn & 1) * 256) * D * 2; }
        return ((size_t)ea * D + (size_t)u.pn * 256) * FF * 2;
    }
    __device__ __forceinline__ long b_delta(const Gemm& g, const Unit& u) const {
        if (mode == 0) return 0;
        int ea, eb; experts(u.x0, ea, eb); return (long)(eb - ea) * D * FF * 2 - (long)FF * 2;
    }
};
struct EpiMoeUp {
    static constexpr bool PERM = true, AFTER_DRAIN = false;
    bf16_t* hact; const SlotRec* slots;
    __device__ __forceinline__ void operator()(const f32x4 (&acc)[2][2][4][2], const Unit& u, int wr, int wc, int fr, int fq) const {
        const int colo = (u.pn >> 1) * 256 + (u.pn & 1) * 128 + wc * 32 + 8 * fq;
#pragma unroll
        for (int ai = 0; ai < 2; ++ai)
#pragma unroll
            for (int m = 0; m < 4; ++m) { const int r = ai * HALF + wr * 64 + m * 16 + fr;
                { const SlotRec sr = slots[u.x2 + (r < u.x1 ? r : u.x1 - 1)]; const float ri = sr.rinv, gt = (u.pn < 2) ? sr.glo : sr.ghi; asm volatile("" ::: "memory");
                    float o[8];
#pragma unroll
                    for (int n = 0; n < 2; ++n)
#pragma unroll
                        for (int j = 0; j < 4; ++j) { const float av = acc[ai][0][m][n][j] * ri, bv = acc[ai][1][m][n][j] * ri; o[4 * n + j] = av / (1.f + __expf(-av)) * bv * gt; }
                    u32x4 w; w.x = cvt_pk_bf16(o[0], o[1]); w.y = cvt_pk_bf16(o[2], o[3]); w.z = cvt_pk_bf16(o[4], o[5]); w.w = cvt_pk_bf16(o[6], o[7]);
                    *(u32x4*)(hact + (size_t)(u.pm * BM + r) * 512 + colo) = w; } }
    }
};
struct EpiMoeDown {
    static constexpr bool PERM = false, AFTER_DRAIN = false;
    float* h; const SlotRec* slots; float* dummy;
    __device__ __forceinline__ void operator()(const f32x4 (&acc)[2][2][4][2], const Unit& u, int wr, int wc, int fr, int fq) const {
        const int col0 = u.pn * BM + wc * 32 + 4 * fq;
#pragma unroll
        for (int ai = 0; ai < 2; ++ai)
#pragma unroll
            for (int m = 0; m < 4; ++m) { const int r = ai * HALF + wr * 64 + m * 16 + fr;
                { const int tok = slots[u.x2 + (r < u.x1 ? r : u.x1 - 1)].token; float* rowp = (r < u.x1 ? h + (size_t)tok * D : dummy) + col0;
#pragma unroll
                    for (int bj = 0; bj < 2; ++bj)
#pragma unroll
                        for (int n = 0; n < 2; ++n) { const f32x4 bs = *(const f32x4*)(rowp + bj * HALF + n * 16); *(f32x4*)(rowp + bj * HALF + n * 16) = bs + acc[ai][bj][m][n]; } }
                asm volatile("" ::: "memory"); }
    }
};
}

__device__ __forceinline__ void route_phase(const Args& a, int layer, LAS unsigned char* lds, int gw, int NGW) {
    int tid = threadIdx.x; asm volatile("" : "+v"(tid));
    const int lane = tid & 63;
    LAS float* WR = (LAS float*)lds;
    const float* gain = a.in[3] + layer * D; const float* wg = a.in[15] + (size_t)layer * D * NG; const float* wr = a.in[17] + (size_t)layer * D * NE;
    for (int idx = tid; idx < 20 * D; idx += NTHREADS) { const int c = idx >> 10, k = idx & 1023; WR[idx] = gain[k] * (c < 4 ? wg[k * 4 + c] : wr[k * 16 + (c - 4)]); }
    __syncthreads();
    float* h = a.out; bf16* hbf = (bf16*)(a.ws + WS_HBF); SlotRec* slots = (SlotRec*)(a.ws + WS_SLOT);
    unsigned* cnt = (unsigned*)(a.ws + WS_CTL) + CW_CNT + layer * 512;
    const float* bgp = a.in[16] + layer * NG; const float* brp = a.in[18] + layer * NE;
    for (int m = gw; m < M; m += NGW) {
        LAS float* WRl = WR + 4 * lane; asm volatile("" : "+v"(WRl));
        const GAS f32x4* xr = (const GAS f32x4*)(h + (size_t)m * D) + lane;
        f32x4 v[4]; float s = 0.f;
#pragma unroll
        for (int j = 0; j < 4; ++j) { v[j] = xr[64 * j]; s += (v[j].x * v[j].x + v[j].y * v[j].y) + (v[j].z * v[j].z + v[j].w * v[j].w); }
        GAS unsigned long long* o8 = (GAS unsigned long long*)(hbf + (size_t)m * D) + lane;
#pragma unroll
        for (int j = 0; j < 4; ++j) o8[64 * j] = (unsigned long long)pk2(v[j].x, v[j].y) | ((unsigned long long)pk2(v[j].z, v[j].w) << 32);
        float lg[20];
#pragma unroll
        for (int c = 0; c < 20; ++c) { float acc = 0.f;
#pragma unroll
            for (int j = 0; j < 4; ++j) { const f32x4 w = *(const LAS f32x4*)(WRl + c * D + 256 * j); acc += (v[j].x * w.x + v[j].y * w.y) + (v[j].z * w.z + v[j].w * w.w); }
            lg[c] = acc; }
        s = wave_sum(s);
#pragma unroll
        for (int c = 0; c < 20; ++c) lg[c] = wave_sum(lg[c]);
        const float ri = rsqrtf(s * (1.f / D) + EPS);
#pragma unroll
        for (int c = 0; c < 4; ++c) lg[c] = lg[c] * ri + bgp[c];
#pragma unroll
        for (int c = 0; c < 16; ++c) lg[4 + c] = lg[4 + c] * ri + brp[c];
        int gi = 0; float gm = lg[0];
#pragma unroll
        for (int c = 1; c < 4; ++c) if (lg[c] > gm) { gm = lg[c]; gi = c; }
        float gs = 0.f;
#pragma unroll
        for (int c = 0; c < 4; ++c) gs += __expf(lg[c] - gm);
        const float gwt = 1.f / gs;
        float e[4];
#pragma unroll
        for (int c = 0; c < 4; ++c) e[c] = gi == 0 ? lg[4 + c] : (gi == 1 ? lg[8 + c] : (gi == 2 ? lg[12 + c] : lg[16 + c]));
        int i0 = 0;
#pragma unroll
        for (int c = 1; c < 4; ++c) if (e[c] > e[i0 == 0 ? 0 : (i0 == 1 ? 1 : (i0 == 2 ? 2 : 3))]) i0 = c;
        float e0 = i0 == 0 ? e[0] : (i0 == 1 ? e[1] : (i0 == 2 ? e[2] : e[3]));
        int i1 = -1; float e1 = -3.0e38f;
#pragma unroll
        for (int c = 0; c < 4; ++c) if (c != i0 && e[c] > e1) { e1 = e[c]; i1 = c; }
        const float p1 = __expf(e1 - e0), den = 1.f / (1.f + p1);
        const float w0 = gwt * den, w1 = gwt * p1 * den;
        const int lo = i0 < i1 ? i0 : i1, hi = i0 < i1 ? i1 : i0;
        const int pr = lo == 0 ? hi - 1 : (lo == 1 ? hi + 1 : 5);
        const int bk = gi * 6 + pr;
        if (lane == 0) {
            const unsigned pos = __hip_atomic_fetch_add(cnt + bk * 16, 1u, __ATOMIC_RELAXED, __HIP_MEMORY_SCOPE_AGENT);
            SlotRec sr; sr.token = m; sr.rinv = ri; sr.glo = i0 < i1 ? w0 : w1; sr.ghi = i0 < i1 ? w1 : w0;
            slots[(size_t)bk * M + pos] = sr;
        }
    }
}
__device__ __forceinline__ void moe_tile_table(const Args& a, int layer, LAS unsigned char* lds) {
    LAS int* tt = (LAS int*)(lds + TT_OFF);
    if (threadIdx.x == 0) {
        const unsigned* cnt = (const unsigned*)(a.ws + WS_CTL) + CW_CNT + layer * 512;
        int acc = 0;
        for (int b = 0; b < NBK; ++b) { const int c = (int)__hip_atomic_load(cnt + b * 16, __ATOMIC_RELAXED, __HIP_MEMORY_SCOPE_AGENT); tt[b] = acc; tt[25 + b] = c; acc += (c + 255) >> 8; }
        tt[NBK] = acc;
    }
    __syncthreads();
}
__device__ __forceinline__ void final_norm_phase(const Args& a, int gw, int NGW) {
    int tid = threadIdx.x; asm volatile("" : "+v"(tid));
    const int lane = tid & 63;
    const float* gain = a.in[5];
    for (int m = gw; m < M; m += NGW) {
        GAS f32x4* xr = (GAS f32x4*)(a.out + (size_t)m * D) + lane;
        f32x4 v[4]; float s = 0.f;
#pragma unroll
        for (int j = 0; j < 4; ++j) { v[j] = xr[64 * j]; s += (v[j].x * v[j].x + v[j].y * v[j].y) + (v[j].z * v[j].z + v[j].w * v[j].w); }
        s = wave_sum(s);
        const float ri = rsqrtf(s * (1.f / D) + EPS);
#pragma unroll
        for (int j = 0; j < 4; ++j) { const f32x4 gn = *((const GAS f32x4*)gain + lane + 64 * j); xr[64 * j] = v[j] * ri * gn; }
    }
}
__global__ void __launch_bounds__(NTHREADS, 2) fwd(Args args) {
    extern __shared__ __attribute__((aligned(16))) unsigned char lds_raw[];
    LAS unsigned char* lds = (LAS unsigned char*)lds_raw;
    const int tid = threadIdx.x, lane0 = tid & 63, wave = __builtin_amdgcn_readfirstlane(tid >> 6);
    const int G = gridDim.x; const int bx = blockIdx.x;
    const int vcu = (G % 8 == 0) ? (bx % 8) * (G / 8) + bx / 8 : bx;
    gu32* ctl = (gu32*)(args.ws + WS_CTL);
    volatile LAS unsigned* MISC = (volatile LAS unsigned*)(lds + MISC_OFF);
    for (int u = tid; u < (LDS_BYTES - LDSCTL_OFF) / 4; u += NTHREADS) ((LAS unsigned*)(lds + LDSCTL_OFF))[u] = 0u;
    __syncthreads();
    XcdBarrier bar; bar.bar = (unsigned*)(ctl + CW_BAR); bar.x = 0; bar.st = nullptr;
    if (args.use_bar) bar = xcd_barrier_post((unsigned*)(ctl + CW_BAR), MISC + 8);
    const int lo = args.ph_lo, hi = args.ph_hi;
#define IN(k) (lo <= (k) && (k) < hi)
#define SEAM(k) do { if (IN(k) && IN((k) + 1)) xcd_barrier(bar); } while (0)
    const int gw = vcu * NWAVES + wave, NGW = G * NWAVES;

    for (int layer = 0; layer < 2; ++layer) {
        const int pb = layer * NPH;
        int lane = lane0; asm volatile("" : "+v"(lane));
        unsigned char* ws = args.ws; asm volatile("" : "+s"(ws));
        if (IN(pb + 0)) { p0_prologue(args, layer, lds, gw, NGW, wave, lane); }
        SEAM(pb + 0);
        if (IN(pb + 1)) {
            const int ldp = layer == 0 ? GLA_LDP : HG_LDP;
            { pg8::Gemm g{(const bf16*)(ws + WS_HBF), (const bf16*)(ws + WS_WIN), M, ldp, D, D, D}; pg8::StaticOrder S; S.init(M, ldp, G, bx);
              pg8::EpiRowScale E{(bf16*)(ws + WS_PROJ), ldp, (const float*)(ws + WS_RINV)};
              pg8::gemm_phase<pg8::EpiRowScale, pg8::StaticOrder, true>(lds, g, S, E); }
            { pg8::Gemm g{(const bf16*)(ws + WS_MEMBF), (const bf16*)(ws + WS_WKV), MROWS, 512, D, D, D}; pg8::StaticOrder S; S.init(MROWS, 512, G, bx);
              pg8::EpiRowScale E{(bf16*)(ws + WS_KVMEM), 512, (const float*)(ws + WS_RINVM)};
              pg8::gemm_phase<pg8::EpiRowScale, pg8::StaticOrder, true>(lds, g, S, E); }
        }
        SEAM(pb + 1);
        if (IN(pb + 2)) { if (layer == 0) mixer_phase_a<0>(args, lds, vcu, G); else mixer_phase_a<1>(args, lds, vcu, G); }
        SEAM(pb + 2);
        if (IN(pb + 3)) { if (layer == 0) mixer_scan<0>(args, vcu, G); else mixer_scan<1>(args, vcu, G); }
        SEAM(pb + 3);
        if (IN(pb + 4)) { if (layer == 0) { mixer_phase_b<0>(args, lds, vcu, G); memattn_phase<0>(args, lds, vcu, G); } else { mixer_phase_b<1>(args, lds, vcu, G); memattn_phase<1>(args, lds, vcu, G); } }
        SEAM(pb + 4);
        if (IN(pb + 5)) {
            const int ldp = layer == 0 ? GLA_LDP : HG_LDP, cv = layer == 0 ? GLA_CV : HG_CV;
            pg8::Gemm g{(const bf16*)(ws + WS_PROJ) + cv, (const bf16*)(ws + WS_WOUT), M, D, D, ldp, D}; pg8::StaticOrder S; S.init(M, D, G, bx);
            pg8::EpiResid E{layer == 0 ? args.in[0] : args.out, args.out, D};
            pg8::gemm_phase<pg8::EpiResid, pg8::StaticOrder, true>(lds, g, S, E);
        }
        SEAM(pb + 5);
        if (IN(pb + 6)) route_phase(args, layer, lds, gw, NGW);
        SEAM(pb + 6);
        if (IN(pb + 7)) {
            moe_tile_table(args, layer, lds);
            pg8::Gemm g{(const bf16*)(ws + WS_HBF), (const bf16*)(ws + WS_WUP), M, 1024, D, D, D};
            pg8::MoeOrder<0> S{(const LAS int*)(lds + TT_OFF), G, vcu, (const SlotRec*)(ws + WS_SLOT)};
            pg8::EpiMoeUp E{(bf16*)(ws + WS_HACT), (const SlotRec*)(ws + WS_SLOT)};
            pg8::gemm_phase<pg8::EpiMoeUp, pg8::MoeOrder<0>, true>(lds, g, S, E);
        }
        SEAM(pb + 7);
        if (IN(pb + 8)) {
            moe_tile_table(args, layer, lds);
            pg8::Gemm g{(const bf16*)(ws + WS_HACT), (const bf16*)(ws + WS_WDN), M, D, 2 * FF, 2 * FF, FF};
            pg8::MoeOrder<1> S{(const LAS int*)(lds + TT_OFF), G, vcu, (const SlotRec*)(ws + WS_SLOT)};
            pg8::EpiMoeDown E{args.out, (const SlotRec*)(ws + WS_SLOT), (float*)(ws + WS_DUMMY)};
            pg8::gemm_phase<pg8::EpiMoeDown, pg8::MoeOrder<1>, true>(lds, g, S, E);
        }
        SEAM(pb + 8);
    }
    if (IN(2 * NPH)) final_norm_phase(args, gw, NGW);
#undef IN
#undef SEAM
}
#ifndef N_LAUNCHES
#define N_LAUNCHES 1
#endif
constexpr int NPHASES = 2 * NPH + 1;
extern "C" void kernel_launch(void* const* d_in, const int* in_sizes, int n_in, void* d_out, int out_size, void* d_ws, size_t ws_size, hipStream_t stream) {
    static int grid = 0;
    if (grid == 0) {
        int dev = 0, cus = 0, per_cu = 0;
        if (n_in != 21 || out_size != M * D || ws_size < 256 * MiB) { fprintf(stderr, "kernel_launch: unexpected problem shape (n_in %d, out %d, ws %zu)\n", n_in, out_size, ws_size); grid = -1; return; }
        if (hipGetDevice(&dev) != hipSuccess || hipDeviceGetAttribute(&cus, hipDeviceAttributeMultiprocessorCount, dev) != hipSuccess) { fprintf(stderr, "kernel_launch: device query failed\n"); grid = -1; return; }
        if (hipFuncSetAttribute((const void*)fwd, hipFuncAttributeMaxDynamicSharedMemorySize, LDS_BYTES) != hipSuccess) { fprintf(stderr, "kernel_launch: hipFuncSetAttribute failed\n"); grid = -1; return; }
        if (hipOccupancyMaxActiveBlocksPerMultiprocessor(&per_cu, (const void*)fwd, NTHREADS, LDS_BYTES) != hipSuccess || per_cu < 1) { fprintf(stderr, "kernel_launch: occupancy query reports %d workgroups per CU; nothing launched\n", per_cu); (void)hipGetLastError(); grid = -1; return; }
        (void)hipGetLastError();
        grid = cus;
    }
    if (grid < 0) return;
    (void)hipMemsetAsync((char*)d_ws + WS_CTL, 0, CTL_ZERO_BYTES, stream);
    Args a{};
    for (int i = 0; i < 21; ++i) a.in[i] = (const float*)d_in[i];
    a.out = (float*)d_out; a.ws = (unsigned char*)d_ws;
    if (N_LAUNCHES == 1) { a.ph_lo = 0; a.ph_hi = NPHASES; a.use_bar = 1; hipLaunchKernelGGL(fwd, dim3(grid), dim3(NTHREADS), LDS_BYTES, stream, a); }
    else for (int p = 0; p < NPHASES; ++p) { a.ph_lo = p; a.ph_hi = p + 1; a.use_bar = 0; hipLaunchKernelGGL(fwd, dim3(grid), dim3(NTHREADS), LDS_BYTES, stream, a); }
}
```

```cpp
#include <hip/hip_runtime.h>
#include <cstdio>
#include <cstdint>

#define GAS __attribute__((address_space(1)))
#define LAS __attribute__((address_space(3)))
typedef unsigned short bf16;
typedef unsigned v4u __attribute__((ext_vector_type(4)));
typedef unsigned v2u __attribute__((ext_vector_type(2)));
typedef float f32x4 __attribute__((ext_vector_type(4)));
typedef short bf16x8 __attribute__((ext_vector_type(8)));
typedef short s16x4 __attribute__((ext_vector_type(4)));
typedef GAS unsigned gu32;
typedef GAS unsigned long long gu64;
#define RLX_AGENT __ATOMIC_RELAXED, __HIP_MEMORY_SCOPE_AGENT
#define LDS_WAIT() asm volatile("s_waitcnt lgkmcnt(0)" ::: "memory")
#define VM_WAIT() asm volatile("s_waitcnt vmcnt(0)" ::: "memory")

constexpr int D = 1024, BATCH = 4, SEQ = 4096, M = BATCH * SEQ, NMEM = 256, MROWS = BATCH * NMEM;
constexpr int MIXW = 768, MEMW = 256, CH = 64, NCH = SEQ / CH;
constexpr int GLA_H = 4, GLA_KW = 512, GLA_DK = 128, GLA_DV = 192, GLA_IN = 2832, GLA_RANK = 16;
constexpr int HG_H = 6, HG_DK = 128, HG_DV = 128, HG_IN = 3328;
constexpr int NG = 4, EPG = 4, NE = 16, FF = 256;
constexpr float EPS = 1e-6f;
constexpr int GLA_LDP = 3072, GLA_CQ = 0, GLA_CK = 512, GLA_CG = 1024, GLA_CV = 1792, GLA_CMQ = 2560, GLA_CR = 2816;
constexpr int HG_LDP = 3328, HG_CQ = 0, HG_CF = 768, HG_CG = 1536, HG_CV = 2304, HG_CMQ = 3072;

__device__ __forceinline__ float bf2f(bf16 b) { return __uint_as_float(((unsigned)b) << 16); }
__device__ __forceinline__ bf16 f2bf(float f) { return __builtin_bit_cast(unsigned short, (__bf16)f); }
__device__ __forceinline__ unsigned pk2(float lo, float hi) { return (unsigned)f2bf(lo) | ((unsigned)f2bf(hi) << 16); }
__device__ __forceinline__ float wave_sum(float v) {
#pragma unroll
    for (int o = 32; o >= 1; o >>= 1) v += __shfl_xor(v, o);
    return v;
}
__device__ __forceinline__ float wave_max(float v) {
#pragma unroll
    for (int o = 32; o >= 1; o >>= 1) v = fmaxf(v, __shfl_xor(v, o));
    return v;
}
__device__ __forceinline__ float sigmoidf_(float x) { return 1.f / (1.f + __expf(-x)); }
__device__ __forceinline__ float siluf_(float x) { return x / (1.f + __expf(-x)); }
__device__ __forceinline__ float logsigmoidf_(float x) { return fminf(x, 0.f) - log1pf(__expf(-fabsf(x))); }

#define N_LAUNCHES 1
namespace pg8 {
#define PG8_LAS __attribute__((address_space(3)))
typedef unsigned short bf16_t;
typedef short bf16x8 __attribute__((ext_vector_type(8)));
typedef float f32x4 __attribute__((ext_vector_type(4)));
typedef unsigned u32x4 __attribute__((ext_vector_type(4)));
constexpr int BM = 256, BK = 64, HALF = 128, HTB = HALF * BK * 2  , STAGE_BYTES = 8 * HTB, NXCD = 8, WGM = 8;

__host__ __device__ __forceinline__ int lds_byte(int r, int c) { const int st = (r >> 4) * 2 + (c >> 5), rr = r & 15, cc = c & 31, ob = rr * 64 + cc * 2; return st * 1024 + (ob ^ (((ob >> 9) & 1) << 5)); }
__host__ __device__ __forceinline__ void stage_rc(int b, int& R, int& C) { const int st = b / 1024, sb = b % 1024, swz = sb ^ (((sb >> 9) & 1) << 5); R = (st >> 1) * 16 + swz / 64; C = (st & 1) * 32 + (swz % 64) / 2; }
__host__ __device__ __forceinline__ int perm32(int rho) { const int n = rho >> 4, i = rho & 15; return 8 * (i >> 2) + 4 * n + (i & 3); }

struct Unit { int pm, pn; int x0, x1, x2, x3; };
struct Gemm { const bf16_t* A; const bf16_t* Bt; int M, N, K, lda, ldb; };

struct StaticOrder {
    int nM, nN, nwg, G, c;
    __host__ __device__ void init(int M, int N, int G_, int c_) { nM = M / BM; nN = N / BM; nwg = nM * nN; G = G_; c = c_; }
    __host__ __device__ bool next(int i, Unit& u) const {
        const long L = (long)i * G + c; if (L >= nwg) return false;
        int wgid = (int)L; { const int q = nwg / NXCD, r = nwg % NXCD, xcd = wgid % NXCD, off = wgid / NXCD; wgid = (xcd < r ? xcd * (q + 1) : r * (q + 1) + (xcd - r) * q) + off; }
        const int nig = WGM * nN, gid = wgid / nig, fm = gid * WGM, gsz = (nM - fm) < WGM ? (nM - fm) : WGM;
        u.pm = fm + ((wgid % nig) % gsz); u.pn = (wgid % nig) / gsz; return true;
    }
    __device__ __forceinline__ void a_ready(const Unit&) const {}
    __device__ __forceinline__ void done(const Unit&) const {}
    static constexpr bool GATHER = false;
    __device__ __forceinline__ unsigned a_off(const Gemm& g, const Unit& u, int r) const { return 0u; }
    __device__ __forceinline__ size_t b_off(const Gemm& g, const Unit& u) const { return (size_t)u.pn * BM * g.ldb * 2; }
    __device__ __forceinline__ long b_delta(const Gemm&, const Unit&) const { return 0; }
};
__device__ __forceinline__ unsigned cvt_pk_bf16(float lo, float hi) { unsigned r; asm volatile("v_cvt_pk_bf16_f32 %0, %1, %2" : "=v"(r) : "v"(lo), "v"(hi)); return r; }
template <class Epi, class Sched, bool ALIGN_EPI = false>
__device__ __forceinline__ void gemm_phase(PG8_LAS unsigned char* lds, const Gemm g, const Sched& S, const Epi& E) {
    int tid_ = threadIdx.x; asm volatile("" : "+v"(tid_));
    const int tid = tid_, wid = __builtin_amdgcn_readfirstlane(tid >> 6), lane = tid & 63, wr = wid >> 2, wc = wid & 3, fr = lane & 15, fq = lane >> 4;
    const int K = g.K, nt = K / BK;
    int Rst[2], Cst[2]; unsigned voffB[2];
#pragma unroll
    for (int i = 0; i < 2; ++i) { int R, C; stage_rc(tid * 16 + i * 8192, R, C); const int Rb = Epi::PERM ? ((R & ~31) + perm32(R & 31)) : R;
        Rst[i] = R; Cst[i] = C * 2; voffB[i] = (unsigned)(Rb * g.ldb + C) * 2u; }
    const unsigned kstep = (unsigned)(BK * 2);
    const size_t hstepB = (size_t)HALF * g.ldb * 2;
    const unsigned ldsw = (unsigned)wid * 1024u;
    const int aoff = lds_byte(wr * 64 + fr, fq * 8), boff = lds_byte(wc * 32 + fr, fq * 8);
#define PG8_SA(b, h) (((b) * 2 + (h)) * HTB)
#define PG8_SB(b, h) ((4 + (b) * 2 + (h)) * HTB)
#define PG8_STAGE_B(bufoff, gbase) do { _Pragma("unroll") for (int _i = 0; _i < 2; ++_i) \
        __builtin_amdgcn_global_load_lds((const unsigned*)((const char*)(gbase) + voffB[_i]), (PG8_LAS unsigned*)(lds + (bufoff) + ldsw + _i * 8192), 16, 0, 0); } while (0)
#define PG8_STAGE_A(bufoff, so, o0, o1) do { const char* _ab = (const char*)g.A + (so); \
        __builtin_amdgcn_global_load_lds((const unsigned*)(_ab + (o0)), (PG8_LAS unsigned*)(lds + (bufoff) + ldsw), 16, 0, 0); \
        __builtin_amdgcn_global_load_lds((const unsigned*)(_ab + (o1)), (PG8_LAS unsigned*)(lds + (bufoff) + ldsw + 8192), 16, 0, 0); } while (0)
#define PG8_LDA(dst, b, h) do { _Pragma("unroll") for (int m = 0; m < 4; ++m) _Pragma("unroll") for (int k = 0; k < 2; ++k) dst[m][k] = *(const PG8_LAS bf16x8*)(lds + PG8_SA(b, h) + aoff + m * 2048 + k * 1024); } while (0)
#define PG8_LDB(dst, b, h) do { _Pragma("unroll") for (int n = 0; n < 2; ++n) _Pragma("unroll") for (int k = 0; k < 2; ++k) dst[n][k] = *(const PG8_LAS bf16x8*)(lds + PG8_SB(b, h) + boff + n * 2048 + k * 1024); } while (0)
#define PG8_MMA(ai, bj, At, Bt) do { __builtin_amdgcn_s_setprio(1); _Pragma("unroll") for (int m = 0; m < 4; ++m) _Pragma("unroll") for (int n = 0; n < 2; ++n) _Pragma("unroll") for (int k = 0; k < 2; ++k) \
        acc[ai][bj][m][n] = __builtin_amdgcn_mfma_f32_16x16x32_bf16(Bt[n][k], At[m][k], acc[ai][bj][m][n], 0, 0, 0); __builtin_amdgcn_s_setprio(0); } while (0)
#define PG8_WAIT_V(n) asm volatile("s_waitcnt vmcnt(" #n ")" ::: "memory")
#define PG8_WAIT_L(n) asm volatile("s_waitcnt lgkmcnt(" #n ")" ::: "memory")
#define PG8_BAR __builtin_amdgcn_s_barrier()
#define PG8_SCHED __builtin_amdgcn_sched_barrier(0)
    Unit cur, nxt; int ui = 0;
    if (!S.next(0, cur)) return;
    f32x4 acc[2][2][4][2];
#pragma unroll
    for (int a = 0; a < 2; ++a)
#pragma unroll
        for (int b = 0; b < 2; ++b)
#pragma unroll
            for (int m = 0; m < 4; ++m)
#pragma unroll
                for (int n = 0; n < 2; ++n) acc[a][b][m][n] = (f32x4){0.f, 0.f, 0.f, 0.f};
    bf16x8 At[4][2], B0[2][2], B1[2][2];
    S.a_ready(cur);
    constexpr bool GA = Sched::GATHER;
    const unsigned voffA0 = (unsigned)(Rst[0] * g.lda) * 2u + Cst[0], voffA1 = (unsigned)(Rst[1] * g.lda) * 2u + Cst[1];
    const size_t hstepA = (size_t)HALF * g.lda * 2;
    unsigned vc00 = voffA0, vc01 = voffA1, vc10 = voffA0, vc11 = voffA1; size_t sc0 = 0, sc1 = 0;
    if constexpr (GA) { vc00 = S.a_off(g, cur, Rst[0]) + Cst[0]; vc01 = S.a_off(g, cur, Rst[1]) + Cst[1]; vc10 = S.a_off(g, cur, HALF + Rst[0]) + Cst[0]; vc11 = S.a_off(g, cur, HALF + Rst[1]) + Cst[1]; }
    else { sc0 = (size_t)cur.pm * 2 * hstepA; sc1 = sc0 + hstepA; }
    const char* cB = (const char*)g.Bt + S.b_off(g, cur); long cD = S.b_delta(g, cur);
    PG8_STAGE_B(PG8_SB(0, 0), cB); PG8_STAGE_B(PG8_SB(0, 1), cB + hstepB); PG8_STAGE_A(PG8_SA(0, 0), sc0, vc00, vc01); PG8_STAGE_A(PG8_SA(0, 1), sc1, vc10, vc11);
    if (wr == 1) PG8_BAR;
    PG8_WAIT_V(2); PG8_BAR;
    PG8_STAGE_B(PG8_SB(1, 0), cB + kstep); PG8_STAGE_A(PG8_SA(1, 0), sc0 + kstep, vc00, vc01); PG8_STAGE_B(PG8_SB(1, 1), cB + hstepB + kstep);
    PG8_WAIT_V(6); PG8_BAR;
    for (;;) {
        const bool has_next = S.next(ui + 1, nxt);
        unsigned vn00 = vc00, vn01 = vc01, vn10 = vc10, vn11 = vc11; size_t sn0 = sc0, sn1 = sc1; const char* nB = cB; long nD = cD;
        if (has_next) {
            if constexpr (GA) { vn00 = S.a_off(g, nxt, Rst[0]) + Cst[0]; vn01 = S.a_off(g, nxt, Rst[1]) + Cst[1]; vn10 = S.a_off(g, nxt, HALF + Rst[0]) + Cst[0]; vn11 = S.a_off(g, nxt, HALF + Rst[1]) + Cst[1]; }
            else { sn0 = (size_t)nxt.pm * 2 * hstepA; sn1 = sn0 + hstepA; }
            nB = (const char*)g.Bt + S.b_off(g, nxt); nD = S.b_delta(g, nxt); }
#pragma nounroll
        for (int t = 0; t < nt; t += 2) {
            const bool last = (t == nt - 2);
            const unsigned k1 = (unsigned)(t + 1) * kstep, k2 = (unsigned)(t + 2) * kstep;
            unsigned o00 = vc00, o01 = vc01, o10 = vc10, o11 = vc11;
            if constexpr (GA) { o00 = last ? vn00 : vc00; o01 = last ? vn01 : vc01; o10 = last ? vn10 : vc10; o11 = last ? vn11 : vc11; }
            const size_t s20 = last ? sn0 : sc0 + k2, s21 = last ? sn1 : sc1 + k2;
            const char* b2 = last ? nB : cB + k2 + ((t + 2) >= nt / 2 ? cD : 0); const char* b3 = b2 + kstep;
            if (last && has_next) S.a_ready(nxt);
            PG8_LDB(B0, 0, 0); PG8_LDB(B1, 0, 1); PG8_SCHED; PG8_LDA(At, 0, 0); PG8_STAGE_A(PG8_SA(1, 1), sc1 + k1, vc10, vc11);
            PG8_WAIT_V(8); PG8_WAIT_L(0); PG8_BAR; PG8_MMA(0, 0, At, B0); PG8_MMA(0, 1, At, B1); PG8_BAR; PG8_SCHED;
            PG8_LDA(At, 0, 1); PG8_STAGE_B(PG8_SB(0, 0), b2); PG8_STAGE_B(PG8_SB(0, 1), b2 + hstepB); PG8_STAGE_A(PG8_SA(0, 0), s20, o00, o01);
            PG8_WAIT_V(8); PG8_WAIT_L(0); PG8_BAR; PG8_MMA(1, 0, At, B0); PG8_MMA(1, 1, At, B1); PG8_BAR; PG8_SCHED;
            PG8_LDB(B0, 1, 0); PG8_LDB(B1, 1, 1); PG8_SCHED; PG8_LDA(At, 1, 0); PG8_STAGE_A(PG8_SA(0, 1), s21, o10, o11);
            PG8_WAIT_V(8); PG8_WAIT_L(0); PG8_BAR; PG8_MMA(0, 0, At, B0); PG8_MMA(0, 1, At, B1); PG8_BAR; PG8_SCHED;
            PG8_LDA(At, 1, 1); PG8_STAGE_B(PG8_SB(1, 0), b3); PG8_STAGE_B(PG8_SB(1, 1), b3 + hstepB); PG8_STAGE_A(PG8_SA(1, 0), s20 + kstep, o00, o01);
            PG8_WAIT_V(8); PG8_WAIT_L(0); PG8_BAR; PG8_MMA(1, 0, At, B0); PG8_MMA(1, 1, At, B1); PG8_BAR; PG8_SCHED;
        }
        if constexpr (ALIGN_EPI) { if (wr == 0) PG8_BAR; }
        if constexpr (!Epi::AFTER_DRAIN) { E(acc, cur, wr, wc, fr, fq); S.done(cur); }
        if (!has_next) break;
#pragma unroll
        for (int a = 0; a < 2; ++a)
#pragma unroll
            for (int b = 0; b < 2; ++b)
#pragma unroll
                for (int m = 0; m < 4; ++m)
#pragma unroll
                    for (int n = 0; n < 2; ++n) acc[a][b][m][n] = (f32x4){0.f, 0.f, 0.f, 0.f};
        cur = nxt; vc00 = vn00; vc01 = vn01; vc10 = vn10; vc11 = vn11; sc0 = sn0; sc1 = sn1; cB = nB; cD = nD; ++ui;
        if constexpr (ALIGN_EPI) { if (wr == 1) PG8_BAR; }
    }
    PG8_WAIT_V(0);
    if constexpr (!ALIGN_EPI) { if (wr == 0) PG8_BAR; }
    PG8_BAR;
    if constexpr (Epi::AFTER_DRAIN) { E.fused(acc, cur, wr, wc, fr, fq, lds, wid, lane); S.done(cur); }
#undef PG8_SA
#undef PG8_SB
#undef PG8_STAGE_A
#undef PG8_STAGE_B
#undef PG8_LDA
#undef PG8_LDB
#undef PG8_MMA
#undef PG8_WAIT_V
#undef PG8_WAIT_L
#undef PG8_BAR
#undef PG8_SCHED
}
}
#define XB_TMO      128
#define XB_XCNT(j)  (256  + 64 * (j))
#define XB_XSUB(j)  (1280 + 64 * (j))
#define XB_XGEN(j)  (2304 + 64 * (j))
#define XB_TOP      3328
#define XB_TOPGEN   3392
#define XCD_BAR_WORDS 3456
#define XB_SPIN_CAP (1u << 18)

__device__ __forceinline__ unsigned xb_ld(unsigned* p)              { return __hip_atomic_load(p, __ATOMIC_RELAXED, __HIP_MEMORY_SCOPE_AGENT); }
__device__ __forceinline__ unsigned xb_add(unsigned* p, unsigned v) { return __hip_atomic_fetch_add(p, v, __ATOMIC_RELAXED, __HIP_MEMORY_SCOPE_AGENT); }
__device__ __forceinline__ unsigned xb_xcc_id() { return (unsigned)__builtin_amdgcn_s_getreg((3 << 11) | 20) & 0xFu; }
#define XB_SPIN(cond, bar) do { unsigned _sp = 0; while (cond) { __builtin_amdgcn_s_sleep(1); \
    if ((++_sp & 255u) == 0u) { if (xb_ld(&(bar)[XB_TMO])) break; if (_sp > XB_SPIN_CAP) { atomicAdd(&(bar)[XB_TMO], 1u); break; } } } } while (0)

struct XcdBarrier {
    unsigned* bar; unsigned x;
    volatile LAS unsigned* st;
};

__device__ __forceinline__ XcdBarrier xcd_barrier_post(unsigned* bar, volatile LAS unsigned* st) {
    XcdBarrier b; b.bar = bar; b.x = xb_xcc_id(); b.st = st;
    if (threadIdx.x == 0) (void)xb_add(&bar[XB_XCNT(b.x)], 1u);
    return b;
}
__device__ __forceinline__ void xcd_barrier_complete(unsigned* bar, unsigned x, unsigned& nloc, unsigned& nx) {
    const unsigned G = gridDim.x * gridDim.y * gridDim.z;
    unsigned sum, cnt, mine, sp = 0u;
    for (;;) {
        sum = 0u; cnt = 0u; mine = 0u;
#pragma unroll
        for (unsigned j = 0; j < 16; ++j) { const unsigned c = xb_ld(&bar[XB_XCNT(j)]); sum += c; cnt += (c > 0u) ? 1u : 0u; mine = (j == x) ? c : mine; }
        if (sum == G) break;
        __builtin_amdgcn_s_sleep(1);
        if ((++sp & 255u) == 0u) { if (xb_ld(&bar[XB_TMO])) break; if (sp > XB_SPIN_CAP) { atomicAdd(&bar[XB_TMO], 1u); break; } }
    }
    nloc = mine > 0u ? mine : 1u; nx = cnt > 0u ? cnt : 1u;
}

__device__ __forceinline__ void xcd_barrier(const XcdBarrier& b) {
    asm volatile("s_waitcnt vmcnt(0)" ::: "memory");
    __syncthreads();
    if (threadIdx.x == 0) {
        unsigned* bar = b.bar;
        __builtin_amdgcn_s_waitcnt(0);
        unsigned nloc = b.st[0], nx = b.st[1];
        if (nloc == 0u) { xcd_barrier_complete(bar, b.x, nloc, nx); b.st[0] = nloc; b.st[1] = nx; }
        const unsigned old = xb_add(&bar[XB_XSUB(b.x)], 1u);
        const unsigned gen = old / nloc;
        if (old + 1u == (gen + 1u) * nloc) {
            __builtin_amdgcn_fence(__ATOMIC_RELEASE, "agent");
            asm volatile("s_waitcnt vmcnt(0)" ::: "memory");
            const unsigned og = xb_add(&bar[XB_TOP], 1u);
            const unsigned tg = og / nx;
            if (og + 1u == (tg + 1u) * nx) xb_add(&bar[XB_TOPGEN], 1u);
            else XB_SPIN(xb_ld(&bar[XB_TOPGEN]) == tg, bar);
            __builtin_amdgcn_fence(__ATOMIC_ACQUIRE, "agent");
            xb_add(&bar[XB_XGEN(b.x)], 1u);
            asm volatile("s_waitcnt vmcnt(0)" ::: "memory");
        } else {
            XB_SPIN(xb_ld(&bar[XB_XGEN(b.x)]) == gen, bar);
            __builtin_amdgcn_fence(__ATOMIC_ACQUIRE, "agent");
            asm volatile("s_waitcnt vmcnt(0)" ::: "memory");
        }
    }
    __syncthreads();
}
constexpr size_t MiB = 1u << 20;
constexpr size_t WS_CTL = 0, CTL_ZERO_BYTES = 1 * MiB;
constexpr size_t WS_WIN = 1 * MiB;
constexpr size_t WS_WOUT = WS_WIN + 13 * MiB / 2;
constexpr size_t WS_WKV = WS_WOUT + 2 * MiB;
constexpr size_t WS_WUP = WS_WKV + 1 * MiB;
constexpr size_t WS_WDN = WS_WUP + 16 * MiB;
constexpr size_t WS_HBF = 35 * MiB;
constexpr size_t WS_MEMBF = WS_HBF + 32 * MiB;
constexpr size_t WS_PROJ = 69 * MiB;
constexpr size_t WS_STATE = 173 * MiB;
constexpr size_t WS_MISC = 250 * MiB;
constexpr size_t WS_RINV = WS_MISC;
constexpr size_t WS_RINVM = WS_RINV + 64 * 1024;
constexpr size_t WS_KVMEM = WS_RINVM + 4096;
constexpr size_t WS_DECAY = WS_KVMEM + 1 * MiB;
constexpr size_t WS_DUMMY = WS_DECAY + 1 * MiB;
constexpr size_t WS_END_OPT = WS_DUMMY + 4096;
static_assert(WS_WDN + 8 * MiB <= WS_HBF && WS_END_OPT <= 256 * MiB, "ws map");
constexpr int CW_BAR = 4096;

constexpr int RING_BYTES = 131072;
constexpr int LDSCTL_OFF = RING_BYTES, MISC_OFF = LDSCTL_OFF + 320;
constexpr int LDS_BYTES = 147456;
constexpr int NWAVES = 8, NTHREADS = 512;
constexpr int NPH = 9;

struct Args {
    const float* in[21]; float* out; unsigned char* ws;
    int ph_lo, ph_hi, use_bar, pad;
};

namespace pg8 {
struct EpiRowScale {
    static constexpr bool PERM = true, AFTER_DRAIN = false;
    bf16_t* O; int ldc; const float* rs;
    __device__ __forceinline__ void operator()(const f32x4 (&acc)[2][2][4][2], const Unit& u, int wr, int wc, int fr, int fq) const {
        const int row0 = u.pm * BM + wr * 64 + fr, col0 = u.pn * BM + wc * 32 + 8 * fq;
#pragma unroll
        for (int ai = 0; ai < 2; ++ai)
#pragma unroll
            for (int m = 0; m < 4; ++m) { const int row = row0 + ai * HALF + m * 16; const float s = rs[row]; bf16_t* rowp = O + (size_t)row * ldc + col0;
#pragma unroll
                for (int bj = 0; bj < 2; ++bj) { const f32x4 v0 = acc[ai][bj][m][0] * s, v1 = acc[ai][bj][m][1] * s;
                    u32x4 w; w.x = cvt_pk_bf16(v0[0], v0[1]); w.y = cvt_pk_bf16(v0[2], v0[3]); w.z = cvt_pk_bf16(v1[0], v1[1]); w.w = cvt_pk_bf16(v1[2], v1[3]);
                    *(u32x4*)(rowp + bj * HALF) = w; } }
    }
};
}

__device__ __forceinline__ int win_dst_row(int layer, int n, float& sc) {
    sc = 1.f;
    if (layer == 0) {
        if (n < 512) { sc = 0.08838834764831845f; return GLA_CQ + n; }
        if (n < 1024) return GLA_CK + (n - 512);
        if (n < 1792) return GLA_CV + (n - 1024);
        if (n < 2560) return GLA_CG + (n - 1792);
        if (n < 2576) return GLA_CR + (n - 2560);
        return GLA_CMQ + (n - 2576);
    } else {
        if (n < 768) return HG_CQ + n;
        if (n < 1536) return HG_CF + (n - 768);
        if (n < 2304) return HG_CV + (n - 1536);
        if (n < 3072) return HG_CG + (n - 2304);
        return HG_CMQ + (n - 3072);
    }
}
template <int MODE>
__device__ __forceinline__ void p0_tr_item(const float* W, int K, int N, const float* gain, bf16* WT, int layer, LAS float* scr, int item, int lane) {
    const int nblk = (N + 31) / 32, kb = item / nblk, nb = item % nblk, k0 = 64 * kb, n0 = 32 * nb;
    const int nn = lane & 7, kq = lane >> 3;
#pragma unroll 4
    for (int i = 0; i < 8; ++i) {
        const int kk = 8 * i + kq; const int n = n0 + 4 * nn;
        f32x4 v = {0.f, 0.f, 0.f, 0.f};
        if (n < N) v = *(const GAS f32x4*)(W + (size_t)(k0 + kk) * N + n);
        const float gk = gain ? gain[k0 + kk] : 1.f;
        scr[(4 * nn + 0) * 65 + kk] = v.x * gk; scr[(4 * nn + 1) * 65 + kk] = v.y * gk; scr[(4 * nn + 2) * 65 + kk] = v.z * gk; scr[(4 * nn + 3) * 65 + kk] = v.w * gk;
    }
    LDS_WAIT(); asm volatile("" ::: "memory");
    const int c = lane & 7;
#pragma unroll
    for (int j = 0; j < 4; ++j) {
        const int nl = (lane >> 3) + 8 * j, n = n0 + nl;
        float sc = 1.f; int dr = n;
        if (MODE == 1) dr = win_dst_row(layer, n, sc);
        if (MODE == 2) { const int f = n & 255, isb = n >> 8; dr = (f >> 7) * 256 + isb * 128 + (f & 127); }
        const LAS float* s = scr + nl * 65 + 8 * c;
        v4u o; o.x = pk2(s[0] * sc, s[1] * sc); o.y = pk2(s[2] * sc, s[3] * sc); o.z = pk2(s[4] * sc, s[5] * sc); o.w = pk2(s[6] * sc, s[7] * sc);
        if (n < N) *(GAS v4u*)(WT + (size_t)dr * K + k0 + 8 * c) = o;
    }
    LDS_WAIT(); asm volatile("" ::: "memory");
}
__device__ __forceinline__ void row_to_bf16(const float* xrow, bf16* orow, float* rinv, int lane) {
    const GAS f32x4* xr = (const GAS f32x4*)xrow + lane;
    f32x4 v[4]; float s = 0.f;
#pragma unroll
    for (int j = 0; j < 4; ++j) { v[j] = xr[64 * j]; s += (v[j].x * v[j].x + v[j].y * v[j].y) + (v[j].z * v[j].z + v[j].w * v[j].w); }
    s = wave_sum(s);
    GAS unsigned long long* o8 = (GAS unsigned long long*)orow + lane;
#pragma unroll
    for (int j = 0; j < 4; ++j) o8[64 * j] = (unsigned long long)pk2(v[j].x, v[j].y) | ((unsigned long long)pk2(v[j].z, v[j].w) << 32);
    if (lane == 0) *rinv = rsqrtf(s * (1.f / D) + EPS);
}
__device__ __forceinline__ void p0_prologue(const Args& a, int layer, LAS unsigned char* lds, int gw, int NGW, int wave, int lane) {
    unsigned char* ws = a.ws;
    LAS float* scr = (LAS float*)(lds + wave * 8448);
    const float* w_in = layer == 0 ? a.in[6] : a.in[10];
    const int NIN = layer == 0 ? GLA_IN : HG_IN;
    const int I_IN = 16 * ((NIN + 31) / 32), I_OUT = 16 * 32, I_KV = 16 * 16, I_UP = 16 * 16 * 16, I_DN = 16 * 4 * 32;
    const int NITEMS = I_IN + I_OUT + I_KV + I_UP + I_DN;
    for (int it = gw; it < NITEMS; it += NGW) {
        int r = it;
        if (r < I_IN) { p0_tr_item<1>(w_in, D, NIN, a.in[2] + layer * D, (bf16*)(ws + WS_WIN), layer, scr, r, lane); continue; } r -= I_IN;
        if (r < I_OUT) { p0_tr_item<0>(a.in[14] + (size_t)layer * D * D, D, D, nullptr, (bf16*)(ws + WS_WOUT), layer, scr, r, lane); continue; } r -= I_OUT;
        if (r < I_KV) { p0_tr_item<0>(a.in[13] + (size_t)layer * D * 512, D, 512, a.in[4] + layer * D, (bf16*)(ws + WS_WKV), layer, scr, r, lane); continue; } r -= I_KV;
        if (r < I_UP) { const int e = r / 256; p0_tr_item<2>(a.in[19] + ((size_t)layer * NE + e) * D * 512, D, 512, a.in[3] + layer * D, (bf16*)(ws + WS_WUP) + (size_t)e * 512 * D, layer, scr, r % 256, lane); continue; } r -= I_UP;
        { const int e = r / 128; p0_tr_item<0>(a.in[20] + ((size_t)layer * NE + e) * FF * D, FF, D, nullptr, (bf16*)(ws + WS_WDN) + (size_t)e * D * FF, layer, scr, r % 128, lane); }
    }
    if (layer == 1) { for (int m = gw; m < M; m += NGW) row_to_bf16(a.out + (size_t)m * D, (bf16*)(ws + WS_HBF) + (size_t)m * D, (float*)(ws + WS_RINV) + m, lane); }
    if (layer == 0) {
        for (int m = gw; m < M; m += NGW) row_to_bf16(a.in[0] + (size_t)m * D, (bf16*)(ws + WS_HBF) + (size_t)m * D, (float*)(ws + WS_RINV) + m, lane);
        for (int m = gw; m < MROWS; m += NGW) row_to_bf16(a.in[1] + (size_t)m * D, (bf16*)(ws + WS_MEMBF) + (size_t)m * D, (float*)(ws + WS_RINVM) + m, lane);
    }
}

template <int MIX> struct MixCfg;
template <> struct MixCfg<0> { static constexpr int H = GLA_H, DV = GLA_DV, LDP = GLA_LDP, CQ = GLA_CQ, CK = GLA_CK, CV = GLA_CV, CG = GLA_CG, CMQ = GLA_CMQ, VSTR = 416; };
template <> struct MixCfg<1> { static constexpr int H = HG_H, DV = HG_DV, LDP = HG_LDP, CQ = HG_CQ, CK = HG_CF, CV = HG_CV, CG = HG_CG, CMQ = HG_CMQ, VSTR = 288; };
constexpr int ISTR = 288;
constexpr int MX_G = 0, MX_T = 32768, MX_BL = 34816, MX_WG = 35328, MX_PREP_END = 43520;
constexpr int MXA_KD = 43520, MXA_V = 61952;
constexpr int MXB_ST = 0, MXB_QD = 55296, MXB_KD = 73728, MXB_V = 92160, MXB_RS = 118784;

__device__ __forceinline__ bf16x8 ld_row8(LAS unsigned char* base, int row, int col, int stride) { return *(const LAS bf16x8*)(base + row * stride + col * 2); }
__device__ __forceinline__ s16x4 ld_tr4(LAS unsigned char* p) { return __builtin_amdgcn_ds_read_tr16_b64_v4i16((LAS s16x4*)p); }
__device__ __forceinline__ bf16x8 ld_trfrag(LAS unsigned char* base, int row0, int col0, int stride, int lane) {
    const int g = lane >> 4, q = (lane & 15) >> 2, p = lane & 3;
    LAS unsigned char* a = base + (row0 + 4 * g + q) * stride + (col0 + 4 * p) * 2;
    const s16x4 lo = ld_tr4(a), hi = ld_tr4(a + 16 * stride);
    return __builtin_shufflevector(lo, hi, 0, 1, 2, 3, 4, 5, 6, 7);
}
__device__ __forceinline__ void unpack8(const v4u w, float (&f)[8]) {
    f[0] = __uint_as_float(w.x << 16); f[1] = __uint_as_float(w.x & 0xffff0000u); f[2] = __uint_as_float(w.y << 16); f[3] = __uint_as_float(w.y & 0xffff0000u);
    f[4] = __uint_as_float(w.z << 16); f[5] = __uint_as_float(w.z & 0xffff0000u); f[6] = __uint_as_float(w.w << 16); f[7] = __uint_as_float(w.w & 0xffff0000u);
}
__device__ __forceinline__ v4u pack8(const float (&f)[8]) { v4u w; w.x = pk2(f[0], f[1]); w.y = pk2(f[2], f[3]); w.z = pk2(f[4], f[5]); w.w = pk2(f[6], f[7]); return w; }

template <int MIX>
__device__ __forceinline__ void mixer_gates(const Args& a, const bf16* proj, LAS unsigned char* lds, int tid, int h, size_t tok0, float (&kx)[2][8]) {
    typedef MixCfg<MIX> C;
    const int co = tid & 15, tg = tid >> 4;
    LAS float* G = (LAS float*)(lds + MX_G); LAS float* T = (LAS float*)(lds + MX_T); LAS float* BL = (LAS float*)(lds + MX_BL);
    float gv[2][8];
    if (MIX == 0) {
        LAS float* WG = (LAS float*)(lds + MX_WG);
        { const int r = tid >> 5, c4 = (tid & 31) * 4; *(LAS f32x4*)(WG + r * 128 + c4) = *(const GAS f32x4*)(a.in[7] + r * GLA_KW + h * 128 + c4); }
        float rr[2][16];
#pragma unroll
        for (int s = 0; s < 2; ++s) {
            const bf16* rowp = proj + (tok0 + 2 * tg + s) * C::LDP;
            const v4u kw = *(const GAS v4u*)(rowp + C::CK + h * 128 + 8 * co); unpack8(kw, kx[s]);
            const v4u r0 = *(const GAS v4u*)(rowp + GLA_CR), r1 = *(const GAS v4u*)(rowp + GLA_CR + 8);
            float t0[8], t1[8]; unpack8(r0, t0); unpack8(r1, t1);
#pragma unroll
            for (int e = 0; e < 8; ++e) { rr[s][e] = t0[e]; rr[s][8 + e] = t1[e]; }
        }
        float bgv[8];
        { const f32x4 b0 = *(const GAS f32x4*)(a.in[8] + h * 128 + 8 * co), b1 = *(const GAS f32x4*)(a.in[8] + h * 128 + 8 * co + 4);
          bgv[0] = b0.x; bgv[1] = b0.y; bgv[2] = b0.z; bgv[3] = b0.w; bgv[4] = b1.x; bgv[5] = b1.y; bgv[6] = b1.z; bgv[7] = b1.w; }
        __syncthreads();
#pragma unroll
        for (int s = 0; s < 2; ++s)
#pragma unroll
            for (int e = 0; e < 8; ++e) gv[s][e] = bgv[e];
#pragma unroll
        for (int r = 0; r < 16; ++r) {
            const f32x4 w0 = *(const LAS f32x4*)(WG + r * 128 + 8 * co), w1 = *(const LAS f32x4*)(WG + r * 128 + 8 * co + 4);
            const float wv[8] = {w0.x, w0.y, w0.z, w0.w, w1.x, w1.y, w1.z, w1.w};
#pragma unroll
            for (int s = 0; s < 2; ++s)
#pragma unroll
                for (int e = 0; e < 8; ++e) gv[s][e] = fmaf(rr[s][r], wv[e], gv[s][e]);
        }
#pragma unroll
        for (int s = 0; s < 2; ++s)
#pragma unroll
            for (int e = 0; e < 8; ++e) { const float xg = gv[s][e]; gv[s][e] = (fminf(xg, 0.f) - __logf(1.f + __expf(-fabsf(xg)))) * (1.f / 16.f); }
    } else {
        float oml[8];
#pragma unroll
        for (int e = 0; e < 8; ++e) { const int c = h * 128 + 8 * co + e; const float dlt = a.in[11][MIXW + c] - a.in[11][c]; oml[e] = 1.f - __builtin_amdgcn_rcpf(1.f + __expf(-dlt)); }
#pragma unroll
        for (int s = 0; s < 2; ++s) {
            const bf16* rowp = proj + (tok0 + 2 * tg + s) * C::LDP;
            const v4u zw = *(const GAS v4u*)(rowp + C::CK + h * 128 + 8 * co); float z[8]; unpack8(zw, z);
#pragma unroll
            for (int e = 0; e < 8; ++e) { const float omf = oml[e] * __builtin_amdgcn_rcpf(1.f + __expf(z[e])); kx[s][e] = omf; gv[s][e] = __logf(1.f - omf); }
        }
    }
#pragma unroll
    for (int s = 0; s < 2; ++s) {
        LAS float* gp = G + (2 * tg + s) * 128 + 8 * co;
        *(LAS f32x4*)gp = (f32x4){gv[s][0], gv[s][1], gv[s][2], gv[s][3]}; *(LAS f32x4*)(gp + 4) = (f32x4){gv[s][4], gv[s][5], gv[s][6], gv[s][7]};
    }
    __syncthreads();
    {
        const int kk = tid & 127, seg = tid >> 7;
        float c[16]; float run = 0.f;
#pragma unroll
        for (int i = 0; i < 16; ++i) { run += G[(16 * seg + i) * 128 + kk]; c[i] = run; }
        T[seg * 128 + kk] = run;
        __syncthreads();
        float offs = 0.f, tot = 0.f;
#pragma unroll
        for (int s = 0; s < 4; ++s) { const float ts = T[s * 128 + kk]; tot += ts; if (s < seg) offs += ts; }
#pragma unroll
        for (int i = 0; i < 16; ++i) G[(16 * seg + i) * 128 + kk] = c[i] + offs;
        if (seg == 0) BL[kk] = tot;
    }
    __syncthreads();
}

template <int MIX>
__device__ __forceinline__ void mixer_phase_a(const Args& a, LAS unsigned char* lds, int vcu, int G_) {
    typedef MixCfg<MIX> C;
    int tid = threadIdx.x; asm volatile("" : "+v"(tid));
    const int lane = tid & 63, wave = __builtin_amdgcn_readfirstlane(tid >> 6);
    const bf16* proj = (const bf16*)(a.ws + WS_PROJ);
    constexpr int NIT = BATCH * C::H * NCH, NDT = C::DV / 16, VCH = C::DV / 8;
    for (int item = vcu; item < NIT; item += G_) {
        const int c = item % NCH, h = (item / NCH) % C::H, b = item / (NCH * C::H);
        const size_t tok0 = (size_t)b * SEQ + (size_t)c * CH;
#pragma unroll
        for (int i = 0; i < VCH * 64 / NTHREADS; ++i) { const int id = tid + NTHREADS * i, j = id / VCH, cv = id % VCH;
            *(LAS v4u*)(lds + MXA_V + j * C::VSTR + cv * 16) = *(const GAS v4u*)(proj + (tok0 + j) * C::LDP + C::CV + h * C::DV + 8 * cv); }
        float kx[2][8];
        mixer_gates<MIX>(a, proj, lds, tid, h, tok0, kx);
        {
            const int co = tid & 15, tg = tid >> 4;
            const LAS float* G = (const LAS float*)(lds + MX_G); const LAS float* BL = (const LAS float*)(lds + MX_BL);
            const f32x4 l0 = *(const LAS f32x4*)(BL + 8 * co), l1 = *(const LAS f32x4*)(BL + 8 * co + 4);
            const float bl[8] = {l0.x, l0.y, l0.z, l0.w, l1.x, l1.y, l1.z, l1.w};
#pragma unroll
            for (int s = 0; s < 2; ++s) { const int j = 2 * tg + s;
                const f32x4 b0 = *(const LAS f32x4*)(G + j * 128 + 8 * co), b1 = *(const LAS f32x4*)(G + j * 128 + 8 * co + 4);
                const float bb[8] = {b0.x, b0.y, b0.z, b0.w, b1.x, b1.y, b1.z, b1.w}; float o[8];
#pragma unroll
                for (int e = 0; e < 8; ++e) o[e] = kx[s][e] * __expf(bl[e] - bb[e]);
                *(LAS v4u*)(lds + MXA_KD + j * ISTR + 16 * co) = pack8(o); }
            if (tid < 128) ((float*)(a.ws + WS_DECAY))[(size_t)item * 128 + tid] = __expf(BL[tid]);
        }
        __syncthreads();
        f32x4 acc[NDT];
#pragma unroll
        for (int d = 0; d < NDT; ++d) acc[d] = (f32x4){0.f, 0.f, 0.f, 0.f};
#pragma unroll
        for (int ks = 0; ks < 2; ++ks) {
            const bf16x8 bfrag = ld_trfrag(lds + MXA_KD, 32 * ks, 16 * wave, ISTR, lane);
#pragma unroll
            for (int d = 0; d < NDT; ++d) { const bf16x8 afrag = ld_trfrag(lds + MXA_V, 32 * ks, 16 * d, C::VSTR, lane);
                acc[d] = __builtin_amdgcn_mfma_f32_16x16x32_bf16(afrag, bfrag, acc[d], 0, 0, 0); }
        }
        __syncthreads();
        {   const int g = lane >> 4, kk = 16 * wave + (lane & 15);
#pragma unroll
            for (int d = 0; d < NDT; ++d)
#pragma unroll
                for (int r = 0; r < 4; ++r) *(LAS bf16*)(lds + (16 * d + 4 * g + r) * 256 + kk * 2) = f2bf(acc[d][r]); }
        __syncthreads();
        {   bf16* st = (bf16*)(a.ws + WS_STATE) + (size_t)item * C::DV * 128;
#pragma unroll
            for (int i = 0; i < C::DV * 256 / 16 / NTHREADS; ++i) { const int id = tid + NTHREADS * i; *(GAS v4u*)(st + id * 8) = *(const LAS v4u*)(lds + id * 16); } }
        __syncthreads();
    }
}

template <int MIX>
__device__ __forceinline__ void mixer_scan(const Args& a, int vcu, int G_) {
    typedef MixCfg<MIX> C;
    int tid = threadIdx.x; asm volatile("" : "+v"(tid));
    constexpr int EPB = C::DV * 128 / 4;
    constexpr int NTASK = BATCH * C::H * EPB;
    const float* dec = (const float*)(a.ws + WS_DECAY);
    for (int task = vcu * NTHREADS + tid; task < NTASK; task += G_ * NTHREADS) {
        const int bh = task / EPB, e4 = task % EPB, kk = (4 * e4) & 127;
        v2u* sp = (v2u*)(a.ws + WS_STATE) + (size_t)bh * NCH * EPB + e4;
        const float* dp = dec + (size_t)bh * NCH * 128 + kk;
        float s0 = 0.f, s1 = 0.f, s2 = 0.f, s3 = 0.f;
#pragma unroll 16
        for (int c = 0; c < NCH; ++c) {
            const v2u lw = *(const GAS v2u*)(sp + (size_t)c * EPB);
            const f32x4 d = *(const GAS f32x4*)(dp + c * 128);
            v2u o; o.x = pk2(s0, s1); o.y = pk2(s2, s3);
            *(GAS v2u*)(sp + (size_t)c * EPB) = o;
            s0 = fmaf(s0, d.x, __uint_as_float(lw.x << 16)); s1 = fmaf(s1, d.y, __uint_as_float(lw.x & 0xffff0000u));
            s2 = fmaf(s2, d.z, __uint_as_float(lw.y << 16)); s3 = fmaf(s3, d.w, __uint_as_float(lw.y & 0xffff0000u));
        }
    }
}

template <int MIX>
__device__ __forceinline__ void mixer_phase_b(const Args& a, LAS unsigned char* lds, int vcu, int G_) {
    typedef MixCfg<MIX> C;
    int tid = threadIdx.x; asm volatile("" : "+v"(tid));
    const int lane = tid & 63, wave = __builtin_amdgcn_readfirstlane(tid >> 6);
    bf16* proj = (bf16*)(a.ws + WS_PROJ);
    constexpr int NIT = BATCH * C::H * NCH, NDT = C::DV / 16, NDH = NDT / 2, VCH = C::DV / 8, SCH = C::DV * 16 / NTHREADS;
    const float* onorm = MIX == 0 ? a.in[9] : a.in[12];
    for (int item = vcu; item < NIT; item += G_) {
        const int c = item % NCH, h = (item / NCH) % C::H, b = item / (NCH * C::H);
        const size_t tok0 = (size_t)b * SEQ + (size_t)c * CH;
        const int co = tid & 15, tg = tid >> 4;
        v4u sreg[SCH];
        { const bf16* st = (const bf16*)(a.ws + WS_STATE) + (size_t)item * C::DV * 128;
#pragma unroll
          for (int i = 0; i < SCH; ++i) sreg[i] = *(const GAS v4u*)(st + (tid + NTHREADS * i) * 8); }
#pragma unroll
        for (int i = 0; i < VCH * 64 / NTHREADS; ++i) { const int id = tid + NTHREADS * i, j = id / VCH, cv = id % VCH;
            *(LAS v4u*)(lds + MXB_V + j * C::VSTR + cv * 16) = *(const GAS v4u*)(proj + (tok0 + j) * C::LDP + C::CV + h * C::DV + 8 * cv); }
        float qx[2][8];
#pragma unroll
        for (int s = 0; s < 2; ++s) { const v4u qw = *(const GAS v4u*)(proj + (tok0 + 2 * tg + s) * C::LDP + C::CQ + h * 128 + 8 * co); unpack8(qw, qx[s]);
            if (MIX == 1) {
#pragma unroll
                for (int e = 0; e < 8; ++e) qx[s][e] = qx[s][e] * __builtin_amdgcn_rcpf(1.f + __expf(-qx[s][e])); } }
        float kx[2][8];
        mixer_gates<MIX>(a, proj, lds, tid, h, tok0, kx);
        {
            const LAS float* G = (const LAS float*)(lds + MX_G);
            float bb[2][8];
#pragma unroll
            for (int s = 0; s < 2; ++s) { const int j = 2 * tg + s;
                const f32x4 b0 = *(const LAS f32x4*)(G + j * 128 + 8 * co), b1 = *(const LAS f32x4*)(G + j * 128 + 8 * co + 4);
                bb[s][0] = b0.x; bb[s][1] = b0.y; bb[s][2] = b0.z; bb[s][3] = b0.w; bb[s][4] = b1.x; bb[s][5] = b1.y; bb[s][6] = b1.z; bb[s][7] = b1.w; }
            __syncthreads();
#pragma unroll
            for (int s = 0; s < 2; ++s) { const int j = 2 * tg + s; float oq[8], ok[8];
#pragma unroll
                for (int e = 0; e < 8; ++e) { const float ex = __expf(bb[s][e]); oq[e] = qx[s][e] * ex; ok[e] = kx[s][e] * __builtin_amdgcn_rcpf(ex); }
                *(LAS v4u*)(lds + MXB_QD + j * ISTR + 16 * co) = pack8(oq); *(LAS v4u*)(lds + MXB_KD + j * ISTR + 16 * co) = pack8(ok); }
#pragma unroll
            for (int i = 0; i < SCH; ++i) { const int id = tid + NTHREADS * i, row = id >> 4, ch = id & 15; *(LAS v4u*)(lds + MXB_ST + row * ISTR + ch * 16) = sreg[i]; }
        }
        __syncthreads();
        const int it = wave & 3, dh = wave >> 2, g = lane >> 4, li = lane & 15;
        bf16x8 qf[4];
#pragma unroll
        for (int ks = 0; ks < 4; ++ks) qf[ks] = ld_row8(lds + MXB_QD, 16 * it + li, 32 * ks + 8 * g, ISTR);
        f32x4 X[4];
#pragma unroll
        for (int jt = 0; jt < 4; ++jt) { X[jt] = (f32x4){0.f, 0.f, 0.f, 0.f};
            if (jt <= it) {
#pragma unroll
                for (int ks = 0; ks < 4; ++ks) { const bf16x8 kf = ld_row8(lds + MXB_KD, 16 * jt + li, 32 * ks + 8 * g, ISTR);
                    X[jt] = __builtin_amdgcn_mfma_f32_16x16x32_bf16(kf, qf[ks], X[jt], 0, 0, 0); }
                if (jt == it) {
#pragma unroll
                    for (int r = 0; r < 4; ++r) if (4 * g + r > li) X[jt][r] = 0.f; } } }
        bf16x8 pf[2];
#pragma unroll
        for (int k2 = 0; k2 < 2; ++k2) { v4u w; w.x = pk2(X[2 * k2][0], X[2 * k2][1]); w.y = pk2(X[2 * k2][2], X[2 * k2][3]); w.z = pk2(X[2 * k2 + 1][0], X[2 * k2 + 1][1]); w.w = pk2(X[2 * k2 + 1][2], X[2 * k2 + 1][3]);
            pf[k2] = __builtin_bit_cast(bf16x8, w); }
        f32x4 acc[NDH];
        float ssq = 0.f;
#pragma unroll
        for (int d = 0; d < NDH; ++d) { const int dt = dh * NDH + d; acc[d] = (f32x4){0.f, 0.f, 0.f, 0.f};
#pragma unroll
            for (int k2 = 0; k2 < 2; ++k2) if (2 * k2 <= it) { const bf16x8 vf = ld_trfrag(lds + MXB_V, 32 * k2, 16 * dt, C::VSTR, lane);
                acc[d] = __builtin_amdgcn_mfma_f32_16x16x32_bf16(vf, pf[k2], acc[d], 0, 0, 0); }
#pragma unroll
            for (int ks = 0; ks < 4; ++ks) { const bf16x8 sf = ld_row8(lds + MXB_ST, 16 * dt + li, 32 * ks + 8 * g, ISTR);
                acc[d] = __builtin_amdgcn_mfma_f32_16x16x32_bf16(sf, qf[ks], acc[d], 0, 0, 0); }
            ssq += (acc[d][0] * acc[d][0] + acc[d][1] * acc[d][1]) + (acc[d][2] * acc[d][2] + acc[d][3] * acc[d][3]); }
        ssq += __shfl_xor(ssq, 16); ssq += __shfl_xor(ssq, 32);
        LAS float* RS = (LAS float*)(lds + MXB_RS);
        if (g == 0) RS[dh * 64 + 16 * it + li] = ssq;
        __syncthreads();
        {   const float tot = RS[16 * it + li] + RS[64 + 16 * it + li];
            const float ri = rsqrtf(tot * (1.f / C::DV) + EPS);
            bf16* rowp = proj + (tok0 + 16 * it + li) * C::LDP;
#pragma unroll
            for (int d = 0; d < NDH; ++d) { const int dv = 16 * (dh * NDH + d) + 4 * g;
                const v2u gw = *(const GAS v2u*)(rowp + C::CG + h * C::DV + dv);
                const f32x4 gn = *(const GAS f32x4*)(onorm + dv);
                const float g0 = __uint_as_float(gw.x << 16), g1 = __uint_as_float(gw.x & 0xffff0000u), g2 = __uint_as_float(gw.y << 16), g3 = __uint_as_float(gw.y & 0xffff0000u);
                v2u o; o.x = pk2(acc[d][0] * ri * gn.x * (g0 * __builtin_amdgcn_rcpf(1.f + __expf(-g0))), acc[d][1] * ri * gn.y * (g1 * __builtin_amdgcn_rcpf(1.f + __expf(-g1))));
                o.y = pk2(acc[d][2] * ri * gn.z * (g2 * __builtin_amdgcn_rcpf(1.f + __expf(-g2))), acc[d][3] * ri * gn.w * (g3 * __builtin_amdgcn_rcpf(1.f + __expf(-g3))));
                *(GAS v2u*)(rowp + C::CV + h * C::DV + dv) = o; } }
        __syncthreads();
    }
}

constexpr int MA_STR = 160, MA_K = 0, MA_V = 40960, MA_Q = 81920;
template <int MIX>
__device__ __forceinline__ void memattn_phase(const Args& a, LAS unsigned char* lds, int vcu, int G_) {
    typedef MixCfg<MIX> C;
    int tid = threadIdx.x; asm volatile("" : "+v"(tid));
    const int lane = tid & 63, wave = __builtin_amdgcn_readfirstlane(tid >> 6), g = lane >> 4, li = lane & 15;
    bf16* proj = (bf16*)(a.ws + WS_PROJ);
    const bf16* kvm = (const bf16*)(a.ws + WS_KVMEM);
    constexpr int NIT = (M / 128) * 4;
    for (int item = vcu; item < NIT; item += G_) {
        const int hm = item & 3, tile = item >> 2; const size_t tok0 = (size_t)tile * 128; const int b = (int)(tok0 / SEQ);
#pragma unroll
        for (int i = 0; i < 4; ++i) { const int id = tid + NTHREADS * i, m = id >> 3, ch = id & 7;
            *(LAS v4u*)(lds + MA_K + m * MA_STR + ch * 16) = *(const GAS v4u*)(kvm + (size_t)(b * NMEM + m) * 512 + hm * 64 + 8 * ch);
            *(LAS v4u*)(lds + MA_V + m * MA_STR + ch * 16) = *(const GAS v4u*)(kvm + (size_t)(b * NMEM + m) * 512 + 256 + hm * 64 + 8 * ch); }
#pragma unroll
        for (int i = 0; i < 2; ++i) { const int id = tid + NTHREADS * i, t = id >> 3, ch = id & 7;
            *(LAS v4u*)(lds + MA_Q + t * MA_STR + ch * 16) = *(const GAS v4u*)(proj + (tok0 + t) * C::LDP + C::CMQ + hm * 64 + 8 * ch); }
        __syncthreads();
        bf16x8 qf[2];
#pragma unroll
        for (int ks = 0; ks < 2; ++ks) qf[ks] = ld_row8(lds + MA_Q, 16 * wave + li, 32 * ks + 8 * g, MA_STR);
        f32x4 X[16]; float mx = -3.0e38f;
#pragma unroll
        for (int kt = 0; kt < 16; ++kt) { X[kt] = (f32x4){0.f, 0.f, 0.f, 0.f};
#pragma unroll
            for (int ks = 0; ks < 2; ++ks) { const bf16x8 kf = ld_row8(lds + MA_K, 16 * kt + li, 32 * ks + 8 * g, MA_STR);
                X[kt] = __builtin_amdgcn_mfma_f32_16x16x32_bf16(kf, qf[ks], X[kt], 0, 0, 0); }
            mx = fmaxf(mx, fmaxf(fmaxf(X[kt][0], X[kt][1]), fmaxf(X[kt][2], X[kt][3]))); }
        mx = fmaxf(mx, __shfl_xor(mx, 16)); mx = fmaxf(mx, __shfl_xor(mx, 32));
        float sum = 0.f;
#pragma unroll
        for (int kt = 0; kt < 16; ++kt)
#pragma unroll
            for (int r = 0; r < 4; ++r) { const float p = __expf((X[kt][r] - mx) * 0.125f); X[kt][r] = p; sum += p; }
        sum += __shfl_xor(sum, 16); sum += __shfl_xor(sum, 32);
        const float inv = __builtin_amdgcn_rcpf(sum);
        f32x4 acc[4];
#pragma unroll
        for (int d = 0; d < 4; ++d) acc[d] = (f32x4){0.f, 0.f, 0.f, 0.f};
#pragma unroll
        for (int k2 = 0; k2 < 8; ++k2) {
            v4u w; w.x = pk2(X[2 * k2][0] * inv, X[2 * k2][1] * inv); w.y = pk2(X[2 * k2][2] * inv, X[2 * k2][3] * inv);
            w.z = pk2(X[2 * k2 + 1][0] * inv, X[2 * k2 + 1][1] * inv); w.w = pk2(X[2 * k2 + 1][2] * inv, X[2 * k2 + 1][3] * inv);
            const bf16x8 pf = __builtin_bit_cast(bf16x8, w);
#pragma unroll
            for (int d = 0; d < 4; ++d) { const bf16x8 vf = ld_trfrag(lds + MA_V, 32 * k2, 16 * d, MA_STR, lane);
                acc[d] = __builtin_amdgcn_mfma_f32_16x16x32_bf16(vf, pf, acc[d], 0, 0, 0); }
        }
        {   bf16* rowp = proj + (tok0 + 16 * wave + li) * C::LDP + C::CMQ + hm * 64;
#pragma unroll
            for (int d = 0; d < 4; ++d) { v2u o; o.x = pk2(acc[d][0], acc[d][1]); o.y = pk2(acc[d][2], acc[d][3]); *(GAS v2u*)(rowp + 16 * d + 4 * g) = o; } }
        __syncthreads();
    }
}
constexpr size_t WS_SLOT = WS_STATE;
constexpr size_t WS_HACT = WS_PROJ;
constexpr int NBK = 24;
constexpr int CW_CNT = 8192;
constexpr int TT_OFF = LDSCTL_OFF + 1024;
struct SlotRec { int token; float rinv, glo, ghi; };

namespace pg8 {
struct EpiResid {
    static constexpr bool PERM = false, AFTER_DRAIN = false;
    const float* base; float* out; int ldc;
    __device__ __forceinline__ void operator()(const f32x4 (&acc)[2][2][4][2], const Unit& u, int wr, int wc, int fr, int fq) const {
        const int row0 = u.pm * BM + wr * 64 + fr, col0 = u.pn * BM + wc * 32 + 4 * fq;
#pragma unroll
        for (int ai = 0; ai < 2; ++ai)
#pragma unroll
            for (int m = 0; m < 4; ++m) { const size_t off = (size_t)(row0 + ai * HALF + m * 16) * ldc + col0;
#pragma unroll
                for (int bj = 0; bj < 2; ++bj)
#pragma unroll
                    for (int n = 0; n < 2; ++n) { const f32x4 bs = *(const f32x4*)(base + off + bj * HALF + n * 16); *(f32x4*)(out + off + bj * HALF + n * 16) = bs + acc[ai][bj][m][n]; }
                asm volatile("" ::: "memory"); }
    }
};
template <int mode> struct MoeOrder {
    static constexpr bool GATHER = (mode == 0);
    const PG8_LAS int* tt; int G, c; const SlotRec* slots;
    __device__ __forceinline__ bool next(int i, Unit& u) const {
        const int L = i * G + c, NT = __builtin_amdgcn_readfirstlane(tt[NBK]);
        if (L >= NT * 4) return false;
        const int rt = L >> 2; int bk = 0;
        for (int b = 1; b < NBK; ++b) if (rt >= __builtin_amdgcn_readfirstlane(tt[b])) bk = b;
        const int tb = __builtin_amdgcn_readfirstlane(tt[bk]), cn = __builtin_amdgcn_readfirstlane(tt[25 + bk]);
        u.pm = rt; u.pn = L & 3; u.x0 = bk; const int first = (rt - tb) * BM; u.x1 = min(cn - first, BM); u.x2 = bk * M + first; u.x3 = 0;
        return true;
    }
    __device__ __forceinline__ void a_ready(const Unit&) const {}
    __device__ __forceinline__ void done(const Unit&) const {}
    __device__ __forceinline__ static void experts(int bk, int& ea, int& eb) { const int g = bk / 6, p = bk % 6; const int lo = p < 3 ? 0 : (p < 5 ? 1 : 2), hi = p < 3 ? p + 1 : (p < 5 ? p - 1 : 3); ea = 4 * g + lo; eb = 4 * g + hi; }
    __device__ __forceinline__ unsigned a_off(const Gemm& g, const Unit& u, int r) const {
        const int rr = r < u.x1 ? r : u.x1 - 1; const int tok = slots[u.x2 + rr].token; return (unsigned)(tok * g.lda) * 2u;
    }
    __device__ __forceinline__ size_t b_off(const Gemm& g, const Unit& u) const {
        int ea, eb; experts(u.x0, ea, eb);
        if (mode == 0) { const int e = (u.pn < 2) ? ea : eb; return ((size_t)e * 512 + (size_t)(u.pn & 1) * 256) * D * 2; }
        return ((size_t)ea * D + (size_t)u.pn * 256) * FF * 2;
    }
    __device__ __forceinline__ long b_delta(const Gemm& g, const Unit& u) const {
        if (mode == 0) return 0;
        int ea, eb; experts(u.x0, ea, eb); return (long)(eb - ea) * D * FF * 2 - (long)FF * 2;
    }
};
struct EpiMoeUp {
    static constexpr bool PERM = true, AFTER_DRAIN = false;
    bf16_t* hact; const SlotRec* slots;
    __device__ __forceinline__ void operator()(const f32x4 (&acc)[2][2][4][2], const Unit& u, int wr, int wc, int fr, int fq) const {
        const int colo = (u.pn >> 1) * 256 + (u.pn & 1) * 128 + wc * 32 + 8 * fq;
#pragma unroll
        for (int ai = 0; ai < 2; ++ai)
#pragma unroll
            for (int m = 0; m < 4; ++m) { const int r = ai * HALF + wr * 64 + m * 16 + fr;
                { const SlotRec sr = slots[u.x2 + (r < u.x1 ? r : u.x1 - 1)]; const float ri = sr.rinv, gt = (u.pn < 2) ? sr.glo : sr.ghi; asm volatile("" ::: "memory");
                    float o[8];
#pragma unroll
                    for (int n = 0; n < 2; ++n)
#pragma unroll
                        for (int j = 0; j < 4; ++j) { const float av = acc[ai][0][m][n][j] * ri, bv = acc[ai][1][m][n][j] * ri; o[4 * n + j] = av * __builtin_amdgcn_rcpf(1.f + __expf(-av)) * bv * gt; }
                    u32x4 w; w.x = cvt_pk_bf16(o[0], o[1]); w.y = cvt_pk_bf16(o[2], o[3]); w.z = cvt_pk_bf16(o[4], o[5]); w.w = cvt_pk_bf16(o[6], o[7]);
                    *(u32x4*)(hact + (size_t)(u.pm * BM + r) * 512 + colo) = w; } }
    }
};
struct EpiMoeDown {
    static constexpr bool PERM = false, AFTER_DRAIN = false;
    float* h; const SlotRec* slots; float* dummy;
    __device__ __forceinline__ void operator()(const f32x4 (&acc)[2][2][4][2], const Unit& u, int wr, int wc, int fr, int fq) const {
        const int col0 = u.pn * BM + wc * 32 + 4 * fq;
#pragma unroll
        for (int ai = 0; ai < 2; ++ai)
#pragma unroll
            for (int m = 0; m < 4; ++m) { const int r = ai * HALF + wr * 64 + m * 16 + fr;
                { const int tok = slots[u.x2 + (r < u.x1 ? r : u.x1 - 1)].token; float* rowp = (r < u.x1 ? h + (size_t)tok * D : dummy) + col0;
#pragma unroll
                    for (int bj = 0; bj < 2; ++bj)
#pragma unroll
                        for (int n = 0; n < 2; ++n) { const f32x4 bs = *(const f32x4*)(rowp + bj * HALF + n * 16); *(f32x4*)(rowp + bj * HALF + n * 16) = bs + acc[ai][bj][m][n]; } }
                asm volatile("" ::: "memory"); }
    }
};
}

__device__ __forceinline__ void route_phase(const Args& a, int layer, LAS unsigned char* lds, int gw, int NGW) {
    int tid = threadIdx.x; asm volatile("" : "+v"(tid));
    const int lane = tid & 63;
    LAS float* WR = (LAS float*)lds;
    const float* gain = a.in[3] + layer * D; const float* wg = a.in[15] + (size_t)layer * D * NG; const float* wr = a.in[17] + (size_t)layer * D * NE;
#pragma unroll
    for (int i = 0; i < 8; ++i) { const int idx = tid + NTHREADS * i, k = idx >> 2, c4 = (idx & 3) * 4; const f32x4 w = *(const GAS f32x4*)(wr + (size_t)idx * 4); const float gk = gain[k];
        WR[(4 + c4) * D + k] = w.x * gk; WR[(5 + c4) * D + k] = w.y * gk; WR[(6 + c4) * D + k] = w.z * gk; WR[(7 + c4) * D + k] = w.w * gk; }
#pragma unroll
    for (int i = 0; i < 2; ++i) { const int k = tid + NTHREADS * i; const f32x4 w = *(const GAS f32x4*)(wg + (size_t)k * 4); const float gk = gain[k];
        WR[0 * D + k] = w.x * gk; WR[1 * D + k] = w.y * gk; WR[2 * D + k] = w.z * gk; WR[3 * D + k] = w.w * gk; }
    __syncthreads();
    float* h = a.out; bf16* hbf = (bf16*)(a.ws + WS_HBF); SlotRec* slots = (SlotRec*)(a.ws + WS_SLOT);
    unsigned* cnt = (unsigned*)(a.ws + WS_CTL) + CW_CNT + layer * 512;
    const float* bgp = a.in[16] + layer * NG; const float* brp = a.in[18] + layer * NE;
    for (int m = gw; m < M; m += NGW) {
        LAS float* WRl = WR + 4 * lane; asm volatile("" : "+v"(WRl));
        const GAS f32x4* xr = (const GAS f32x4*)(h + (size_t)m * D) + lane;
        f32x4 v[4]; float s = 0.f;
#pragma unroll
        for (int j = 0; j < 4; ++j) { v[j] = xr[64 * j]; s += (v[j].x * v[j].x + v[j].y * v[j].y) + (v[j].z * v[j].z + v[j].w * v[j].w); }
        GAS unsigned long long* o8 = (GAS unsigned long long*)(hbf + (size_t)m * D) + lane;
#pragma unroll
        for (int j = 0; j < 4; ++j) o8[64 * j] = (unsigned long long)pk2(v[j].x, v[j].y) | ((unsigned long long)pk2(v[j].z, v[j].w) << 32);
        float lg[20];
#pragma unroll
        for (int c = 0; c < 20; ++c) { float acc = 0.f;
#pragma unroll
            for (int j = 0; j < 4; ++j) { const f32x4 w = *(const LAS f32x4*)(WRl + c * D + 256 * j); acc += (v[j].x * w.x + v[j].y * w.y) + (v[j].z * w.z + v[j].w * w.w); }
            lg[c] = acc; }
        s = wave_sum(s);
#pragma unroll
        for (int c = 0; c < 20; ++c) lg[c] = wave_sum(lg[c]);
        const float ri = rsqrtf(s * (1.f / D) + EPS);
#pragma unroll
        for (int c = 0; c < 4; ++c) lg[c] = lg[c] * ri + bgp[c];
#pragma unroll
        for (int c = 0; c < 16; ++c) lg[4 + c] = lg[4 + c] * ri + brp[c];
        int gi = 0; float gm = lg[0];
#pragma unroll
        for (int c = 1; c < 4; ++c) if (lg[c] > gm) { gm = lg[c]; gi = c; }
        float gs = 0.f;
#pragma unroll
        for (int c = 0; c < 4; ++c) gs += __expf(lg[c] - gm);
        const float gwt = 1.f / gs;
        float e[4];
#pragma unroll
        for (int c = 0; c < 4; ++c) e[c] = gi == 0 ? lg[4 + c] : (gi == 1 ? lg[8 + c] : (gi == 2 ? lg[12 + c] : lg[16 + c]));
        int i0 = 0;
#pragma unroll
        for (int c = 1; c < 4; ++c) if (e[c] > e[i0 == 0 ? 0 : (i0 == 1 ? 1 : (i0 == 2 ? 2 : 3))]) i0 = c;
        float e0 = i0 == 0 ? e[0] : (i0 == 1 ? e[1] : (i0 == 2 ? e[2] : e[3]));
        int i1 = -1; float e1 = -3.0e38f;
#pragma unroll
        for (int c = 0; c < 4; ++c) if (c != i0 && e[c] > e1) { e1 = e[c]; i1 = c; }
        const float p1 = __expf(e1 - e0), den = 1.f / (1.f + p1);
        const float w0 = gwt * den, w1 = gwt * p1 * den;
        const int lo = i0 < i1 ? i0 : i1, hi = i0 < i1 ? i1 : i0;
        const int pr = lo == 0 ? hi - 1 : (lo == 1 ? hi + 1 : 5);
        const int bk = gi * 6 + pr;
        if (lane == 0) {
            const unsigned pos = __hip_atomic_fetch_add(cnt + bk * 16, 1u, __ATOMIC_RELAXED, __HIP_MEMORY_SCOPE_AGENT);
            SlotRec sr; sr.token = m; sr.rinv = ri; sr.glo = i0 < i1 ? w0 : w1; sr.ghi = i0 < i1 ? w1 : w0;
            slots[(size_t)bk * M + pos] = sr;
        }
    }
}
__device__ __forceinline__ void moe_tile_table(const Args& a, int layer, LAS unsigned char* lds) {
    LAS int* tt = (LAS int*)(lds + TT_OFF);
    if (threadIdx.x == 0) {
        const unsigned* cnt = (const unsigned*)(a.ws + WS_CTL) + CW_CNT + layer * 512;
        int acc = 0;
        for (int b = 0; b < NBK; ++b) { const int c = (int)__hip_atomic_load(cnt + b * 16, __ATOMIC_RELAXED, __HIP_MEMORY_SCOPE_AGENT); tt[b] = acc; tt[25 + b] = c; acc += (c + 255) >> 8; }
        tt[NBK] = acc;
    }
    __syncthreads();
}
__device__ __forceinline__ void final_norm_phase(const Args& a, int gw, int NGW) {
    int tid = threadIdx.x; asm volatile("" : "+v"(tid));
    const int lane = tid & 63;
    const float* gain = a.in[5];
    for (int m = gw; m < M; m += NGW) {
        GAS f32x4* xr = (GAS f32x4*)(a.out + (size_t)m * D) + lane;
        f32x4 v[4]; float s = 0.f;
#pragma unroll
        for (int j = 0; j < 4; ++j) { v[j] = xr[64 * j]; s += (v[j].x * v[j].x + v[j].y * v[j].y) + (v[j].z * v[j].z + v[j].w * v[j].w); }
        s = wave_sum(s);
        const float ri = rsqrtf(s * (1.f / D) + EPS);
#pragma unroll
        for (int j = 0; j < 4; ++j) { const f32x4 gn = *((const GAS f32x4*)gain + lane + 64 * j); xr[64 * j] = v[j] * ri * gn; }
    }
}
__global__ void __launch_bounds__(NTHREADS, 2) fwd(Args args) {
    extern __shared__ __attribute__((aligned(16))) unsigned char lds_raw[];
    LAS unsigned char* lds = (LAS unsigned char*)lds_raw;
    const int tid = threadIdx.x, lane0 = tid & 63, wave = __builtin_amdgcn_readfirstlane(tid >> 6);
    const int G = gridDim.x; const int bx = blockIdx.x;
    const int vcu = (G % 8 == 0) ? (bx % 8) * (G / 8) + bx / 8 : bx;
    gu32* ctl = (gu32*)(args.ws + WS_CTL);
    volatile LAS unsigned* MISC = (volatile LAS unsigned*)(lds + MISC_OFF);
    for (int u = tid; u < (LDS_BYTES - LDSCTL_OFF) / 4; u += NTHREADS) ((LAS unsigned*)(lds + LDSCTL_OFF))[u] = 0u;
    __syncthreads();
    XcdBarrier bar; bar.bar = (unsigned*)(ctl + CW_BAR); bar.x = 0; bar.st = nullptr;
    if (args.use_bar) bar = xcd_barrier_post((unsigned*)(ctl + CW_BAR), MISC + 8);
    const int lo = args.ph_lo, hi = args.ph_hi;
#define IN(k) (lo <= (k) && (k) < hi)
#ifdef TIME_PHASE
#define STAMP(k) do { if (tid == 0) MISC[16 + (k)] = (unsigned)__builtin_amdgcn_s_memrealtime(); } while (0)
#else
#define STAMP(k) do { } while (0)
#endif
#define SEAM(k) do { if (IN(k) && IN((k) + 1)) xcd_barrier(bar); STAMP((k) + 1); } while (0)
    const int gw = vcu * NWAVES + wave, NGW = G * NWAVES;

    STAMP(0);
    for (int layer = 0; layer < 2; ++layer) {
        const int pb = layer * NPH;
        int lane = lane0; asm volatile("" : "+v"(lane));
        unsigned char* ws = args.ws; asm volatile("" : "+s"(ws));
        if (IN(pb + 0)) { p0_prologue(args, layer, lds, gw, NGW, wave, lane); }
        SEAM(pb + 0);
        if (IN(pb + 1)) {
            const int ldp = layer == 0 ? GLA_LDP : HG_LDP;
            { pg8::Gemm g{(const bf16*)(ws + WS_HBF), (const bf16*)(ws + WS_WIN), M, ldp, D, D, D}; pg8::StaticOrder S; S.init(M, ldp, G, bx);
              pg8::EpiRowScale E{(bf16*)(ws + WS_PROJ), ldp, (const float*)(ws + WS_RINV)};
              pg8::gemm_phase<pg8::EpiRowScale, pg8::StaticOrder, true>(lds, g, S, E); }
            { pg8::Gemm g{(const bf16*)(ws + WS_MEMBF), (const bf16*)(ws + WS_WKV), MROWS, 512, D, D, D}; pg8::StaticOrder S; S.init(MROWS, 512, G, bx);
              pg8::EpiRowScale E{(bf16*)(ws + WS_KVMEM), 512, (const float*)(ws + WS_RINVM)};
              pg8::gemm_phase<pg8::EpiRowScale, pg8::StaticOrder, true>(lds, g, S, E); }
        }
        SEAM(pb + 1);
        if (IN(pb + 2)) { if (layer == 0) mixer_phase_a<0>(args, lds, vcu, G); else mixer_phase_a<1>(args, lds, vcu, G); }
        SEAM(pb + 2);
        if (IN(pb + 3)) { if (layer == 0) mixer_scan<0>(args, vcu, G); else mixer_scan<1>(args, vcu, G); }
        SEAM(pb + 3);
        if (IN(pb + 4)) { if (layer == 0) { mixer_phase_b<0>(args, lds, vcu, G); memattn_phase<0>(args, lds, vcu, G); } else { mixer_phase_b<1>(args, lds, vcu, G); memattn_phase<1>(args, lds, vcu, G); } }
        SEAM(pb + 4);
        if (IN(pb + 5)) {
            const int ldp = layer == 0 ? GLA_LDP : HG_LDP, cv = layer == 0 ? GLA_CV : HG_CV;
            pg8::Gemm g{(const bf16*)(ws + WS_PROJ) + cv, (const bf16*)(ws + WS_WOUT), M, D, D, ldp, D}; pg8::StaticOrder S; S.init(M, D, G, bx);
            pg8::EpiResid E{layer == 0 ? args.in[0] : args.out, args.out, D};
            pg8::gemm_phase<pg8::EpiResid, pg8::StaticOrder, true>(lds, g, S, E);
        }
        SEAM(pb + 5);
        if (IN(pb + 6)) route_phase(args, layer, lds, gw, NGW);
        SEAM(pb + 6);
        if (IN(pb + 7)) {
            moe_tile_table(args, layer, lds);
            pg8::Gemm g{(const bf16*)(ws + WS_HBF), (const bf16*)(ws + WS_WUP), M, 1024, D, D, D};
            pg8::MoeOrder<0> S{(const LAS int*)(lds + TT_OFF), G, vcu, (const SlotRec*)(ws + WS_SLOT)};
            pg8::EpiMoeUp E{(bf16*)(ws + WS_HACT), (const SlotRec*)(ws + WS_SLOT)};
            pg8::gemm_phase<pg8::EpiMoeUp, pg8::MoeOrder<0>, true>(lds, g, S, E);
        }
        SEAM(pb + 7);
        if (IN(pb + 8)) {
            moe_tile_table(args, layer, lds);
            pg8::Gemm g{(const bf16*)(ws + WS_HACT), (const bf16*)(ws + WS_WDN), M, D, 2 * FF, 2 * FF, FF};
            pg8::MoeOrder<1> S{(const LAS int*)(lds + TT_OFF), G, vcu, (const SlotRec*)(ws + WS_SLOT)};
            pg8::EpiMoeDown E{args.out, (const SlotRec*)(ws + WS_SLOT), (float*)(ws + WS_DUMMY)};
            pg8::gemm_phase<pg8::EpiMoeDown, pg8::MoeOrder<1>, true>(lds, g, S, E);
        }
        SEAM(pb + 8);
    }
    if (IN(2 * NPH)) final_norm_phase(args, gw, NGW);
#ifdef TIME_PHASE
    STAMP(2 * NPH + 1);
    if (bx == 0 && tid == 0) { const unsigned span = (MISC[16 + TIME_PHASE_END] - MISC[16 + TIME_PHASE]) * TIME_AMP; const unsigned t0 = (unsigned)__builtin_amdgcn_s_memrealtime();
        while ((unsigned)__builtin_amdgcn_s_memrealtime() - t0 < span) __builtin_amdgcn_s_sleep(8); }
#endif
#undef IN
#undef SEAM
}
#ifndef N_LAUNCHES
#define N_LAUNCHES 1
#endif
constexpr int NPHASES = 2 * NPH + 1;
extern "C" void kernel_launch(void* const* d_in, const int* in_sizes, int n_in, void* d_out, int out_size, void* d_ws, size_t ws_size, hipStream_t stream) {
    static int grid = 0;
    if (grid == 0) {
        int dev = 0, cus = 0, per_cu = 0;
        if (n_in != 21 || out_size != M * D || ws_size < 256 * MiB) { fprintf(stderr, "kernel_launch: unexpected problem shape (n_in %d, out %d, ws %zu)\n", n_in, out_size, ws_size); grid = -1; return; }
        if (hipGetDevice(&dev) != hipSuccess || hipDeviceGetAttribute(&cus, hipDeviceAttributeMultiprocessorCount, dev) != hipSuccess) { fprintf(stderr, "kernel_launch: device query failed\n"); grid = -1; return; }
        if (hipFuncSetAttribute((const void*)fwd, hipFuncAttributeMaxDynamicSharedMemorySize, LDS_BYTES) != hipSuccess) { fprintf(stderr, "kernel_launch: hipFuncSetAttribute failed\n"); grid = -1; return; }
        if (hipOccupancyMaxActiveBlocksPerMultiprocessor(&per_cu, (const void*)fwd, NTHREADS, LDS_BYTES) != hipSuccess || per_cu < 1) { fprintf(stderr, "kernel_launch: occupancy query reports %d workgroups per CU; nothing launched\n", per_cu); (void)hipGetLastError(); grid = -1; return; }
        (void)hipGetLastError();
        grid = cus;
    }
    if (grid < 0) return;
    (void)hipMemsetAsync((char*)d_ws + WS_CTL, 0, CTL_ZERO_BYTES, stream);
    Args a{};
    for (int i = 0; i < 21; ++i) a.in[i] = (const float*)d_in[i];
    a.out = (float*)d_out; a.ws = (unsigned char*)d_ws;
    if (N_LAUNCHES == 1) { a.ph_lo = 0; a.ph_hi = NPHASES; a.use_bar = 1; hipLaunchKernelGGL(fwd, dim3(grid), dim3(NTHREADS), LDS_BYTES, stream, a); }
    else for (int p = 0; p < NPHASES; ++p) { a.ph_lo = p; a.ph_hi = p + 1; a.use_bar = 0; hipLaunchKernelGGL(fwd, dim3(grid), dim3(NTHREADS), LDS_BYTES, stream, a); }
}
```

```cpp
#include <hip/hip_runtime.h>
#include <cstdio>
#include <cstdint>

#define GAS __attribute__((address_space(1)))
#define LAS __attribute__((address_space(3)))
typedef unsigned short bf16;
typedef unsigned v4u __attribute__((ext_vector_type(4)));
typedef unsigned v2u __attribute__((ext_vector_type(2)));
typedef float f32x4 __attribute__((ext_vector_type(4)));
typedef short bf16x8 __attribute__((ext_vector_type(8)));
typedef short s16x4 __attribute__((ext_vector_type(4)));
typedef GAS unsigned gu32;
typedef GAS unsigned long long gu64;
#define RLX_AGENT __ATOMIC_RELAXED, __HIP_MEMORY_SCOPE_AGENT
#define LDS_WAIT() asm volatile("s_waitcnt lgkmcnt(0)" ::: "memory")
#define VM_WAIT() asm volatile("s_waitcnt vmcnt(0)" ::: "memory")

constexpr int D = 1024, BATCH = 4, SEQ = 4096, M = BATCH * SEQ, NMEM = 256, MROWS = BATCH * NMEM;
constexpr int MIXW = 768, MEMW = 256, CH = 64, NCH = SEQ / CH;
constexpr int GLA_H = 4, GLA_KW = 512, GLA_DK = 128, GLA_DV = 192, GLA_IN = 2832, GLA_RANK = 16;
constexpr int HG_H = 6, HG_DK = 128, HG_DV = 128, HG_IN = 3328;
constexpr int NG = 4, EPG = 4, NE = 16, FF = 256;
constexpr float EPS = 1e-6f;
constexpr int GLA_LDP = 3072, GLA_CQ = 0, GLA_CK = 512, GLA_CG = 1024, GLA_CV = 1792, GLA_CMQ = 2560, GLA_CR = 2816;
constexpr int HG_LDP = 3328, HG_CQ = 0, HG_CF = 768, HG_CG = 1536, HG_CV = 2304, HG_CMQ = 3072;

__device__ __forceinline__ float bf2f(bf16 b) { return __uint_as_float(((unsigned)b) << 16); }
__device__ __forceinline__ bf16 f2bf(float f) { return __builtin_bit_cast(unsigned short, (__bf16)f); }
__device__ __forceinline__ unsigned pk2(float lo, float hi) { return (unsigned)f2bf(lo) | ((unsigned)f2bf(hi) << 16); }
__device__ __forceinline__ float wave_sum(float v) {
#pragma unroll
    for (int o = 32; o >= 1; o >>= 1) v += __shfl_xor(v, o);
    return v;
}
__device__ __forceinline__ float wave_max(float v) {
#pragma unroll
    for (int o = 32; o >= 1; o >>= 1) v = fmaxf(v, __shfl_xor(v, o));
    return v;
}
__device__ __forceinline__ float sigmoidf_(float x) { return 1.f / (1.f + __expf(-x)); }
__device__ __forceinline__ float siluf_(float x) { return x / (1.f + __expf(-x)); }
__device__ __forceinline__ float logsigmoidf_(float x) { return fminf(x, 0.f) - log1pf(__expf(-fabsf(x))); }

#define N_LAUNCHES 1
namespace pg8 {
#define PG8_LAS __attribute__((address_space(3)))
typedef unsigned short bf16_t;
typedef short bf16x8 __attribute__((ext_vector_type(8)));
typedef float f32x4 __attribute__((ext_vector_type(4)));
typedef unsigned u32x4 __attribute__((ext_vector_type(4)));
constexpr int BM = 256, BK = 64, HALF = 128, HTB = HALF * BK * 2  , STAGE_BYTES = 8 * HTB, NXCD = 8, WGM = 8;

__host__ __device__ __forceinline__ int lds_byte(int r, int c) { const int st = (r >> 4) * 2 + (c >> 5), rr = r & 15, cc = c & 31, ob = rr * 64 + cc * 2; return st * 1024 + (ob ^ (((ob >> 9) & 1) << 5)); }
__host__ __device__ __forceinline__ void stage_rc(int b, int& R, int& C) { const int st = b / 1024, sb = b % 1024, swz = sb ^ (((sb >> 9) & 1) << 5); R = (st >> 1) * 16 + swz / 64; C = (st & 1) * 32 + (swz % 64) / 2; }
__host__ __device__ __forceinline__ int perm32(int rho) { const int n = rho >> 4, i = rho & 15; return 8 * (i >> 2) + 4 * n + (i & 3); }

struct Unit { int pm, pn; int x0, x1, x2, x3; };
struct Gemm { const bf16_t* A; const bf16_t* Bt; int M, N, K, lda, ldb; };

struct StaticOrder {
    int nM, nN, nwg, G, c;
    __host__ __device__ void init(int M, int N, int G_, int c_) { nM = M / BM; nN = N / BM; nwg = nM * nN; G = G_; c = c_; }
    __host__ __device__ bool next(int i, Unit& u) const {
        const long L = (long)i * G + c; if (L >= nwg) return false;
        int wgid = (int)L; { const int q = nwg / NXCD, r = nwg % NXCD, xcd = wgid % NXCD, off = wgid / NXCD; wgid = (xcd < r ? xcd * (q + 1) : r * (q + 1) + (xcd - r) * q) + off; }
        const int nig = WGM * nN, gid = wgid / nig, fm = gid * WGM, gsz = (nM - fm) < WGM ? (nM - fm) : WGM;
        u.pm = fm + ((wgid % nig) % gsz); u.pn = (wgid % nig) / gsz; return true;
    }
    __device__ __forceinline__ void a_ready(const Unit&) const {}
    __device__ __forceinline__ void done(const Unit&) const {}
    static constexpr bool GATHER = false;
    __device__ __forceinline__ unsigned a_off(const Gemm& g, const Unit& u, int r) const { return 0u; }
    __device__ __forceinline__ size_t b_off(const Gemm& g, const Unit& u) const { return (size_t)u.pn * BM * g.ldb * 2; }
    __device__ __forceinline__ long b_delta(const Gemm&, const Unit&) const { return 0; }
};
__device__ __forceinline__ unsigned cvt_pk_bf16(float lo, float hi) { unsigned r; asm volatile("v_cvt_pk_bf16_f32 %0, %1, %2" : "=v"(r) : "v"(lo), "v"(hi)); return r; }
template <class Epi, class Sched, bool ALIGN_EPI = false>
__device__ __forceinline__ void gemm_phase(PG8_LAS unsigned char* lds, const Gemm g, const Sched& S, const Epi& E) {
    int tid_ = threadIdx.x; asm volatile("" : "+v"(tid_));
    const int tid = tid_, wid = __builtin_amdgcn_readfirstlane(tid >> 6), lane = tid & 63, wr = wid >> 2, wc = wid & 3, fr = lane & 15, fq = lane >> 4;
    const int K = g.K, nt = K / BK;
    int Rst[2], Cst[2]; unsigned voffB[2];
#pragma unroll
    for (int i = 0; i < 2; ++i) { int R, C; stage_rc(tid * 16 + i * 8192, R, C); const int Rb = Epi::PERM ? ((R & ~31) + perm32(R & 31)) : R;
        Rst[i] = R; Cst[i] = C * 2; voffB[i] = (unsigned)(Rb * g.ldb + C) * 2u; }
    const unsigned kstep = (unsigned)(BK * 2);
    const size_t hstepB = (size_t)HALF * g.ldb * 2;
    const unsigned ldsw = (unsigned)wid * 1024u;
    const int aoff = lds_byte(wr * 64 + fr, fq * 8), boff = lds_byte(wc * 32 + fr, fq * 8);
#define PG8_SA(b, h) (((b) * 2 + (h)) * HTB)
#define PG8_SB(b, h) ((4 + (b) * 2 + (h)) * HTB)
#define PG8_STAGE_B(bufoff, gbase) do { _Pragma("unroll") for (int _i = 0; _i < 2; ++_i) \
        __builtin_amdgcn_global_load_lds((const unsigned*)((const char*)(gbase) + voffB[_i]), (PG8_LAS unsigned*)(lds + (bufoff) + ldsw + _i * 8192), 16, 0, 0); } while (0)
#define PG8_STAGE_A(bufoff, so, o0, o1) do { const char* _ab = (const char*)g.A + (so); \
        __builtin_amdgcn_global_load_lds((const unsigned*)(_ab + (o0)), (PG8_LAS unsigned*)(lds + (bufoff) + ldsw), 16, 0, 0); \
        __builtin_amdgcn_global_load_lds((const unsigned*)(_ab + (o1)), (PG8_LAS unsigned*)(lds + (bufoff) + ldsw + 8192), 16, 0, 0); } while (0)
#define PG8_LDA(dst, b, h) do { _Pragma("unroll") for (int m = 0; m < 4; ++m) _Pragma("unroll") for (int k = 0; k < 2; ++k) dst[m][k] = *(const PG8_LAS bf16x8*)(lds + PG8_SA(b, h) + aoff + m * 2048 + k * 1024); } while (0)
#define PG8_LDB(dst, b, h) do { _Pragma("unroll") for (int n = 0; n < 2; ++n) _Pragma("unroll") for (int k = 0; k < 2; ++k) dst[n][k] = *(const PG8_LAS bf16x8*)(lds + PG8_SB(b, h) + boff + n * 2048 + k * 1024); } while (0)
#define PG8_MMA(ai, bj, At, Bt) do { __builtin_amdgcn_s_setprio(1); _Pragma("unroll") for (int m = 0; m < 4; ++m) _Pragma("unroll") for (int n = 0; n < 2; ++n) _Pragma("unroll") for (int k = 0; k < 2; ++k) \
        acc[ai][bj][m][n] = __builtin_amdgcn_mfma_f32_16x16x32_bf16(Bt[n][k], At[m][k], acc[ai][bj][m][n], 0, 0, 0); __builtin_amdgcn_s_setprio(0); } while (0)
#define PG8_WAIT_V(n) asm volatile("s_waitcnt vmcnt(" #n ")" ::: "memory")
#define PG8_WAIT_L(n) asm volatile("s_waitcnt lgkmcnt(" #n ")" ::: "memory")
#define PG8_BAR __builtin_amdgcn_s_barrier()
#define PG8_SCHED __builtin_amdgcn_sched_barrier(0)
    Unit cur, nxt; int ui = 0;
    if (!S.next(0, cur)) return;
    f32x4 acc[2][2][4][2];
#pragma unroll
    for (int a = 0; a < 2; ++a)
#pragma unroll
        for (int b = 0; b < 2; ++b)
#pragma unroll
            for (int m = 0; m < 4; ++m)
#pragma unroll
                for (int n = 0; n < 2; ++n) acc[a][b][m][n] = (f32x4){0.f, 0.f, 0.f, 0.f};
    bf16x8 At[4][2], B0[2][2], B1[2][2];
    S.a_ready(cur);
    constexpr bool GA = Sched::GATHER;
    const unsigned voffA0 = (unsigned)(Rst[0] * g.lda) * 2u + Cst[0], voffA1 = (unsigned)(Rst[1] * g.lda) * 2u + Cst[1];
    const size_t hstepA = (size_t)HALF * g.lda * 2;
    unsigned vc00 = voffA0, vc01 = voffA1, vc10 = voffA0, vc11 = voffA1; size_t sc0 = 0, sc1 = 0;
    if constexpr (GA) { vc00 = S.a_off(g, cur, Rst[0]) + Cst[0]; vc01 = S.a_off(g, cur, Rst[1]) + Cst[1]; vc10 = S.a_off(g, cur, HALF + Rst[0]) + Cst[0]; vc11 = S.a_off(g, cur, HALF + Rst[1]) + Cst[1]; }
    else { sc0 = (size_t)cur.pm * 2 * hstepA; sc1 = sc0 + hstepA; }
    const char* cB = (const char*)g.Bt + S.b_off(g, cur); long cD = S.b_delta(g, cur);
    PG8_STAGE_B(PG8_SB(0, 0), cB); PG8_STAGE_B(PG8_SB(0, 1), cB + hstepB); PG8_STAGE_A(PG8_SA(0, 0), sc0, vc00, vc01); PG8_STAGE_A(PG8_SA(0, 1), sc1, vc10, vc11);
    if (wr == 1) PG8_BAR;
    PG8_WAIT_V(2); PG8_BAR;
    PG8_STAGE_B(PG8_SB(1, 0), cB + kstep); PG8_STAGE_A(PG8_SA(1, 0), sc0 + kstep, vc00, vc01); PG8_STAGE_B(PG8_SB(1, 1), cB + hstepB + kstep);
    PG8_WAIT_V(6); PG8_BAR;
    for (;;) {
        const bool has_next = S.next(ui + 1, nxt);
        unsigned vn00 = vc00, vn01 = vc01, vn10 = vc10, vn11 = vc11; size_t sn0 = sc0, sn1 = sc1; const char* nB = cB; long nD = cD;
        if (has_next) {
            if constexpr (GA) { vn00 = S.a_off(g, nxt, Rst[0]) + Cst[0]; vn01 = S.a_off(g, nxt, Rst[1]) + Cst[1]; vn10 = S.a_off(g, nxt, HALF + Rst[0]) + Cst[0]; vn11 = S.a_off(g, nxt, HALF + Rst[1]) + Cst[1]; }
            else { sn0 = (size_t)nxt.pm * 2 * hstepA; sn1 = sn0 + hstepA; }
            nB = (const char*)g.Bt + S.b_off(g, nxt); nD = S.b_delta(g, nxt); }
#pragma nounroll
        for (int t = 0; t < nt; t += 2) {
            const bool last = (t == nt - 2);
            const unsigned k1 = (unsigned)(t + 1) * kstep, k2 = (unsigned)(t + 2) * kstep;
            unsigned o00 = vc00, o01 = vc01, o10 = vc10, o11 = vc11;
            if constexpr (GA) { o00 = last ? vn00 : vc00; o01 = last ? vn01 : vc01; o10 = last ? vn10 : vc10; o11 = last ? vn11 : vc11; }
            const size_t s20 = last ? sn0 : sc0 + k2, s21 = last ? sn1 : sc1 + k2;
            const char* b2 = last ? nB : cB + k2 + ((t + 2) >= nt / 2 ? cD : 0); const char* b3 = b2 + kstep;
            if (last && has_next) S.a_ready(nxt);
            PG8_LDB(B0, 0, 0); PG8_LDB(B1, 0, 1); PG8_SCHED; PG8_LDA(At, 0, 0); PG8_STAGE_A(PG8_SA(1, 1), sc1 + k1, vc10, vc11);
            PG8_WAIT_V(8); PG8_WAIT_L(0); PG8_BAR; PG8_MMA(0, 0, At, B0); PG8_MMA(0, 1, At, B1); PG8_BAR; PG8_SCHED;
            PG8_LDA(At, 0, 1); PG8_STAGE_B(PG8_SB(0, 0), b2); PG8_STAGE_B(PG8_SB(0, 1), b2 + hstepB); PG8_STAGE_A(PG8_SA(0, 0), s20, o00, o01);
            PG8_WAIT_V(8); PG8_WAIT_L(0); PG8_BAR; PG8_MMA(1, 0, At, B0); PG8_MMA(1, 1, At, B1); PG8_BAR; PG8_SCHED;
            PG8_LDB(B0, 1, 0); PG8_LDB(B1, 1, 1); PG8_SCHED; PG8_LDA(At, 1, 0); PG8_STAGE_A(PG8_SA(0, 1), s21, o10, o11);
            PG8_WAIT_V(8); PG8_WAIT_L(0); PG8_BAR; PG8_MMA(0, 0, At, B0); PG8_MMA(0, 1, At, B1); PG8_BAR; PG8_SCHED;
            PG8_LDA(At, 1, 1); PG8_STAGE_B(PG8_SB(1, 0), b3); PG8_STAGE_B(PG8_SB(1, 1), b3 + hstepB); PG8_STAGE_A(PG8_SA(1, 0), s20 + kstep, o00, o01);
            PG8_WAIT_V(8); PG8_WAIT_L(0); PG8_BAR; PG8_MMA(1, 0, At, B0); PG8_MMA(1, 1, At, B1); PG8_BAR; PG8_SCHED;
        }
        if constexpr (ALIGN_EPI) { if (wr == 0) PG8_BAR; }
        if constexpr (!Epi::AFTER_DRAIN) { E(acc, cur, wr, wc, fr, fq); S.done(cur); }
        if (!has_next) break;
#pragma unroll
        for (int a = 0; a < 2; ++a)
#pragma unroll
            for (int b = 0; b < 2; ++b)
#pragma unroll
                for (int m = 0; m < 4; ++m)
#pragma unroll
                    for (int n = 0; n < 2; ++n) acc[a][b][m][n] = (f32x4){0.f, 0.f, 0.f, 0.f};
        cur = nxt; vc00 = vn00; vc01 = vn01; vc10 = vn10; vc11 = vn11; sc0 = sn0; sc1 = sn1; cB = nB; cD = nD; ++ui;
        if constexpr (ALIGN_EPI) { if (wr == 1) PG8_BAR; }
    }
    PG8_WAIT_V(0);
    if constexpr (!ALIGN_EPI) { if (wr == 0) PG8_BAR; }
    PG8_BAR;
    if constexpr (Epi::AFTER_DRAIN) { E.fused(acc, cur, wr, wc, fr, fq, lds, wid, lane); S.done(cur); }
#undef PG8_SA
#undef PG8_SB
#undef PG8_STAGE_A
#undef PG8_STAGE_B
#undef PG8_LDA
#undef PG8_LDB
#undef PG8_MMA
#undef PG8_WAIT_V
#undef PG8_WAIT_L
#undef PG8_BAR
#undef PG8_SCHED
}
}
#define XB_TMO      128
#define XB_XCNT(j)  (256  + 64 * (j))
#define XB_XSUB(j)  (1280 + 64 * (j))
#define XB_XGEN(j)  (2304 + 64 * (j))
#define XB_TOP      3328
#define XB_TOPGEN   3392
#define XCD_BAR_WORDS 3456
#define XB_SPIN_CAP (1u << 18)

__device__ __forceinline__ unsigned xb_ld(unsigned* p)              { return __hip_atomic_load(p, __ATOMIC_RELAXED, __HIP_MEMORY_SCOPE_AGENT); }
__device__ __forceinline__ unsigned xb_add(unsigned* p, unsigned v) { return __hip_atomic_fetch_add(p, v, __ATOMIC_RELAXED, __HIP_MEMORY_SCOPE_AGENT); }
__device__ __forceinline__ unsigned xb_xcc_id() { return (unsigned)__builtin_amdgcn_s_getreg((3 << 11) | 20) & 0xFu; }
#define XB_SPIN(cond, bar) do { unsigned _sp = 0; while (cond) { __builtin_amdgcn_s_sleep(1); \
    if ((++_sp & 255u) == 0u) { if (xb_ld(&(bar)[XB_TMO])) break; if (_sp > XB_SPIN_CAP) { atomicAdd(&(bar)[XB_TMO], 1u); break; } } } } while (0)

struct XcdBarrier {
    unsigned* bar; unsigned x;
    volatile LAS unsigned* st;
};

__device__ __forceinline__ XcdBarrier xcd_barrier_post(unsigned* bar, volatile LAS unsigned* st) {
    XcdBarrier b; b.bar = bar; b.x = xb_xcc_id(); b.st = st;
    if (threadIdx.x == 0) (void)xb_add(&bar[XB_XCNT(b.x)], 1u);
    return b;
}
__device__ __forceinline__ void xcd_barrier_complete(unsigned* bar, unsigned x, unsigned& nloc, unsigned& nx) {
    const unsigned G = gridDim.x * gridDim.y * gridDim.z;
    unsigned sum, cnt, mine, sp = 0u;
    for (;;) {
        sum = 0u; cnt = 0u; mine = 0u;
#pragma unroll
        for (unsigned j = 0; j < 16; ++j) { const unsigned c = xb_ld(&bar[XB_XCNT(j)]); sum += c; cnt += (c > 0u) ? 1u : 0u; mine = (j == x) ? c : mine; }
        if (sum == G) break;
        __builtin_amdgcn_s_sleep(1);
        if ((++sp & 255u) == 0u) { if (xb_ld(&bar[XB_TMO])) break; if (sp > XB_SPIN_CAP) { atomicAdd(&bar[XB_TMO], 1u); break; } }
    }
    nloc = mine > 0u ? mine : 1u; nx = cnt > 0u ? cnt : 1u;
}

__device__ __forceinline__ void xcd_barrier(const XcdBarrier& b) {
    asm volatile("s_waitcnt vmcnt(0)" ::: "memory");
    __syncthreads();
    if (threadIdx.x == 0) {
        unsigned* bar = b.bar;
        __builtin_amdgcn_s_waitcnt(0);
        unsigned nloc = b.st[0], nx = b.st[1];
        if (nloc == 0u) { xcd_barrier_complete(bar, b.x, nloc, nx); b.st[0] = nloc; b.st[1] = nx; }
        const unsigned old = xb_add(&bar[XB_XSUB(b.x)], 1u);
        const unsigned gen = old / nloc;
        if (old + 1u == (gen + 1u) * nloc) {
            __builtin_amdgcn_fence(__ATOMIC_RELEASE, "agent");
            asm volatile("s_waitcnt vmcnt(0)" ::: "memory");
            const unsigned og = xb_add(&bar[XB_TOP], 1u);
            const unsigned tg = og / nx;
            if (og + 1u == (tg + 1u) * nx) xb_add(&bar[XB_TOPGEN], 1u);
            else XB_SPIN(xb_ld(&bar[XB_TOPGEN]) == tg, bar);
            __builtin_amdgcn_fence(__ATOMIC_ACQUIRE, "agent");
            xb_add(&bar[XB_XGEN(b.x)], 1u);
            asm volatile("s_waitcnt vmcnt(0)" ::: "memory");
        } else {
            XB_SPIN(xb_ld(&bar[XB_XGEN(b.x)]) == gen, bar);
            __builtin_amdgcn_fence(__ATOMIC_ACQUIRE, "agent");
            asm volatile("s_waitcnt vmcnt(0)" ::: "memory");
        }
    }
    __syncthreads();
}
constexpr size_t MiB = 1u << 20;
constexpr size_t WS_CTL = 0, CTL_ZERO_BYTES = 1 * MiB;
constexpr size_t WS_WIN = 1 * MiB;
constexpr size_t WS_WOUT = WS_WIN + 13 * MiB / 2;
constexpr size_t WS_WKV = WS_WOUT + 2 * MiB;
constexpr size_t WS_WUP = WS_WKV + 1 * MiB;
constexpr size_t WS_WDN = WS_WUP + 16 * MiB;
constexpr size_t WS_HBF = 35 * MiB;
constexpr size_t WS_MEMBF = WS_HBF + 32 * MiB;
constexpr size_t WS_PROJ = 69 * MiB;
constexpr size_t WS_STATE = 173 * MiB;
constexpr size_t WS_MISC = 250 * MiB;
constexpr size_t WS_RINV = WS_MISC;
constexpr size_t WS_RINVM = WS_RINV + 64 * 1024;
constexpr size_t WS_KVMEM = WS_RINVM + 4096;
constexpr size_t WS_DECAY = WS_KVMEM + 1 * MiB;
constexpr size_t WS_DUMMY = WS_DECAY + 1 * MiB;
constexpr size_t WS_END_OPT = WS_DUMMY + 4096;
static_assert(WS_WDN + 8 * MiB <= WS_HBF && WS_END_OPT <= 256 * MiB, "ws map");
constexpr int CW_BAR = 4096;

constexpr int RING_BYTES = 131072;
constexpr int LDSCTL_OFF = RING_BYTES, MISC_OFF = LDSCTL_OFF + 320;
constexpr int LDS_BYTES = 147456;
constexpr int NWAVES = 8, NTHREADS = 512;
constexpr int NPH = 9;

struct Args {
    const float* in[21]; float* out; unsigned char* ws;
    int ph_lo, ph_hi, use_bar, pad;
};

namespace pg8 {
struct EpiRowScale {
    static constexpr bool PERM = true, AFTER_DRAIN = false;
    bf16_t* O; int ldc; const float* rs;
    __device__ __forceinline__ void operator()(const f32x4 (&acc)[2][2][4][2], const Unit& u, int wr, int wc, int fr, int fq) const {
        const int row0 = u.pm * BM + wr * 64 + fr, col0 = u.pn * BM + wc * 32 + 8 * fq;
#pragma unroll
        for (int ai = 0; ai < 2; ++ai)
#pragma unroll
            for (int m = 0; m < 4; ++m) { const int row = row0 + ai * HALF + m * 16; const float s = rs[row]; bf16_t* rowp = O + (size_t)row * ldc + col0;
#pragma unroll
                for (int bj = 0; bj < 2; ++bj) { const f32x4 v0 = acc[ai][bj][m][0] * s, v1 = acc[ai][bj][m][1] * s;
                    u32x4 w; w.x = cvt_pk_bf16(v0[0], v0[1]); w.y = cvt_pk_bf16(v0[2], v0[3]); w.z = cvt_pk_bf16(v1[0], v1[1]); w.w = cvt_pk_bf16(v1[2], v1[3]);
                    *(u32x4*)(rowp + bj * HALF) = w; } }
    }
};
}

__device__ __forceinline__ int win_dst_row(int layer, int n, float& sc) {
    sc = 1.f;
    if (layer == 0) {
        if (n < 512) { sc = 0.08838834764831845f; return GLA_CQ + n; }
        if (n < 1024) return GLA_CK + (n - 512);
        if (n < 1792) return GLA_CV + (n - 1024);
        if (n < 2560) return GLA_CG + (n - 1792);
        if (n < 2576) return GLA_CR + (n - 2560);
        return GLA_CMQ + (n - 2576);
    } else {
        if (n < 768) return HG_CQ + n;
        if (n < 1536) return HG_CF + (n - 768);
        if (n < 2304) return HG_CV + (n - 1536);
        if (n < 3072) return HG_CG + (n - 2304);
        return HG_CMQ + (n - 3072);
    }
}
template <int MODE>
__device__ __forceinline__ void p0_tr_item(const float* W, int K, int N, const float* gain, bf16* WT, int layer, LAS float* scr, int item, int lane) {
    const int nblk = (N + 31) / 32, kb = item / nblk, nb = item % nblk, k0 = 64 * kb, n0 = 32 * nb;
    const int nn = lane & 7, kq = lane >> 3;
#pragma unroll 4
    for (int i = 0; i < 8; ++i) {
        const int kk = 8 * i + kq; const int n = n0 + 4 * nn;
        f32x4 v = {0.f, 0.f, 0.f, 0.f};
        if (n < N) v = *(const GAS f32x4*)(W + (size_t)(k0 + kk) * N + n);
        const float gk = gain ? gain[k0 + kk] : 1.f;
        scr[(4 * nn + 0) * 65 + kk] = v.x * gk; scr[(4 * nn + 1) * 65 + kk] = v.y * gk; scr[(4 * nn + 2) * 65 + kk] = v.z * gk; scr[(4 * nn + 3) * 65 + kk] = v.w * gk;
    }
    LDS_WAIT(); asm volatile("" ::: "memory");
    const int c = lane & 7;
#pragma unroll
    for (int j = 0; j < 4; ++j) {
        const int nl = (lane >> 3) + 8 * j, n = n0 + nl;
        float sc = 1.f; int dr = n;
        if (MODE == 1) dr = win_dst_row(layer, n, sc);
        if (MODE == 2) { const int f = n & 255, isb = n >> 8; dr = (f >> 7) * 256 + isb * 128 + (f & 127); }
        const LAS float* s = scr + nl * 65 + 8 * c;
        v4u o; o.x = pk2(s[0] * sc, s[1] * sc); o.y = pk2(s[2] * sc, s[3] * sc); o.z = pk2(s[4] * sc, s[5] * sc); o.w = pk2(s[6] * sc, s[7] * sc);
        if (n < N) *(GAS v4u*)(WT + (size_t)dr * K + k0 + 8 * c) = o;
    }
    LDS_WAIT(); asm volatile("" ::: "memory");
}
__device__ __forceinline__ void row_to_bf16(const float* xrow, bf16* orow, float* rinv, int lane) {
    const GAS f32x4* xr = (const GAS f32x4*)xrow + lane;
    f32x4 v[4]; float s = 0.f;
#pragma unroll
    for (int j = 0; j < 4; ++j) { v[j] = xr[64 * j]; s += (v[j].x * v[j].x + v[j].y * v[j].y) + (v[j].z * v[j].z + v[j].w * v[j].w); }
    s = wave_sum(s);
    GAS unsigned long long* o8 = (GAS unsigned long long*)orow + lane;
#pragma unroll
    for (int j = 0; j < 4; ++j) o8[64 * j] = (unsigned long long)pk2(v[j].x, v[j].y) | ((unsigned long long)pk2(v[j].z, v[j].w) << 32);
    if (lane == 0) *rinv = rsqrtf(s * (1.f / D) + EPS);
}
__device__ __forceinline__ void p0_prologue(const Args& a, int layer, LAS unsigned char* lds, int gw, int NGW, int wave, int lane) {
    unsigned char* ws = a.ws;
    LAS float* scr = (LAS float*)(lds + wave * 8448);
    const float* w_in = layer == 0 ? a.in[6] : a.in[10];
    const int NIN = layer == 0 ? GLA_IN : HG_IN;
    const int I_IN = 16 * ((NIN + 31) / 32), I_OUT = 16 * 32, I_KV = 16 * 16, I_UP = 16 * 16 * 16, I_DN = 16 * 4 * 32;
    const int NITEMS = I_IN + I_OUT + I_KV + I_UP + I_DN;
    for (int it = gw; it < NITEMS; it += NGW) {
        int r = it;
        if (r < I_IN) { p0_tr_item<1>(w_in, D, NIN, a.in[2] + layer * D, (bf16*)(ws + WS_WIN), layer, scr, r, lane); continue; } r -= I_IN;
        if (r < I_OUT) { p0_tr_item<0>(a.in[14] + (size_t)layer * D * D, D, D, nullptr, (bf16*)(ws + WS_WOUT), layer, scr, r, lane); continue; } r -= I_OUT;
        if (r < I_KV) { p0_tr_item<0>(a.in[13] + (size_t)layer * D * 512, D, 512, a.in[4] + layer * D, (bf16*)(ws + WS_WKV), layer, scr, r, lane); continue; } r -= I_KV;
        if (r < I_UP) { const int e = r / 256; p0_tr_item<2>(a.in[19] + ((size_t)layer * NE + e) * D * 512, D, 512, a.in[3] + layer * D, (bf16*)(ws + WS_WUP) + (size_t)e * 512 * D, layer, scr, r % 256, lane); continue; } r -= I_UP;
        { const int e = r / 128; p0_tr_item<0>(a.in[20] + ((size_t)layer * NE + e) * FF * D, FF, D, nullptr, (bf16*)(ws + WS_WDN) + (size_t)e * D * FF, layer, scr, r % 128, lane); }
    }
    if (layer == 1) {
        for (int m = gw; m < M; m += NGW) { const GAS v4u* xr = (const GAS v4u*)((const bf16*)(ws + WS_HBF) + (size_t)m * D) + lane; float s = 0.f;
#pragma unroll
            for (int j = 0; j < 2; ++j) { const v4u w = xr[64 * j]; const unsigned ww[4] = {w.x, w.y, w.z, w.w};
#pragma unroll
                for (int e = 0; e < 4; ++e) { const float lo = __uint_as_float(ww[e] << 16), hi = __uint_as_float(ww[e] & 0xffff0000u); s = fmaf(lo, lo, s); s = fmaf(hi, hi, s); } }
            s = wave_sum(s); if (lane == 0) ((float*)(ws + WS_RINV))[m] = rsqrtf(s * (1.f / D) + EPS); } }
    if (layer == 0) {
        for (int m = gw; m < M; m += NGW) row_to_bf16(a.in[0] + (size_t)m * D, (bf16*)(ws + WS_HBF) + (size_t)m * D, (float*)(ws + WS_RINV) + m, lane);
        for (int m = gw; m < MROWS; m += NGW) row_to_bf16(a.in[1] + (size_t)m * D, (bf16*)(ws + WS_MEMBF) + (size_t)m * D, (float*)(ws + WS_RINVM) + m, lane);
    }
}

template <int MIX> struct MixCfg;
template <> struct MixCfg<0> { static constexpr int H = GLA_H, DV = GLA_DV, LDP = GLA_LDP, CQ = GLA_CQ, CK = GLA_CK, CV = GLA_CV, CG = GLA_CG, CMQ = GLA_CMQ, VSTR = 416; };
template <> struct MixCfg<1> { static constexpr int H = HG_H, DV = HG_DV, LDP = HG_LDP, CQ = HG_CQ, CK = HG_CF, CV = HG_CV, CG = HG_CG, CMQ = HG_CMQ, VSTR = 288; };
constexpr int ISTR = 288;
constexpr int MX_G = 0, MX_T = 32768, MX_BL = 34816, MX_WG = 35328, MX_PREP_END = 43520;
constexpr int MXA_KD = 43520, MXA_V = 61952;
constexpr int MXB_ST = 0, MXB_QD = 55296, MXB_KD = 73728, MXB_V = 92160, MXB_RS = 118784;

__device__ __forceinline__ bf16x8 ld_row8(LAS unsigned char* base, int row, int col, int stride) { return *(const LAS bf16x8*)(base + row * stride + col * 2); }
__device__ __forceinline__ s16x4 ld_tr4(LAS unsigned char* p) { return __builtin_amdgcn_ds_read_tr16_b64_v4i16((LAS s16x4*)p); }
__device__ __forceinline__ bf16x8 ld_trfrag(LAS unsigned char* base, int row0, int col0, int stride, int lane) {
    const int g = lane >> 4, q = (lane & 15) >> 2, p = lane & 3;
    LAS unsigned char* a = base + (row0 + 4 * g + q) * stride + (col0 + 4 * p) * 2;
    const s16x4 lo = ld_tr4(a), hi = ld_tr4(a + 16 * stride);
    return __builtin_shufflevector(lo, hi, 0, 1, 2, 3, 4, 5, 6, 7);
}
__device__ __forceinline__ void unpack8(const v4u w, float (&f)[8]) {
    f[0] = __uint_as_float(w.x << 16); f[1] = __uint_as_float(w.x & 0xffff0000u); f[2] = __uint_as_float(w.y << 16); f[3] = __uint_as_float(w.y & 0xffff0000u);
    f[4] = __uint_as_float(w.z << 16); f[5] = __uint_as_float(w.z & 0xffff0000u); f[6] = __uint_as_float(w.w << 16); f[7] = __uint_as_float(w.w & 0xffff0000u);
}
__device__ __forceinline__ v4u pack8(const float (&f)[8]) { v4u w; w.x = pk2(f[0], f[1]); w.y = pk2(f[2], f[3]); w.z = pk2(f[4], f[5]); w.w = pk2(f[6], f[7]); return w; }

template <int MIX>
__device__ __forceinline__ void mixer_gates(const Args& a, const bf16* proj, LAS unsigned char* lds, int tid, int h, size_t tok0, float (&kx)[2][8]) {
    typedef MixCfg<MIX> C;
    const int co = tid & 15, tg = tid >> 4;
    LAS float* G = (LAS float*)(lds + MX_G); LAS float* T = (LAS float*)(lds + MX_T); LAS float* BL = (LAS float*)(lds + MX_BL);
    float gv[2][8];
    if (MIX == 0) {
        LAS float* WG = (LAS float*)(lds + MX_WG);
        { const int r = tid >> 5, c4 = (tid & 31) * 4; *(LAS f32x4*)(WG + r * 128 + c4) = *(const GAS f32x4*)(a.in[7] + r * GLA_KW + h * 128 + c4); }
        float rr[2][16];
#pragma unroll
        for (int s = 0; s < 2; ++s) {
            const bf16* rowp = proj + (tok0 + 2 * tg + s) * C::LDP;
            const v4u kw = *(const GAS v4u*)(rowp + C::CK + h * 128 + 8 * co); unpack8(kw, kx[s]);
            const v4u r0 = *(const GAS v4u*)(rowp + GLA_CR), r1 = *(const GAS v4u*)(rowp + GLA_CR + 8);
            float t0[8], t1[8]; unpack8(r0, t0); unpack8(r1, t1);
#pragma unroll
            for (int e = 0; e < 8; ++e) { rr[s][e] = t0[e]; rr[s][8 + e] = t1[e]; }
        }
        float bgv[8];
        { const f32x4 b0 = *(const GAS f32x4*)(a.in[8] + h * 128 + 8 * co), b1 = *(const GAS f32x4*)(a.in[8] + h * 128 + 8 * co + 4);
          bgv[0] = b0.x; bgv[1] = b0.y; bgv[2] = b0.z; bgv[3] = b0.w; bgv[4] = b1.x; bgv[5] = b1.y; bgv[6] = b1.z; bgv[7] = b1.w; }
        __syncthreads();
#pragma unroll
        for (int s = 0; s < 2; ++s)
#pragma unroll
            for (int e = 0; e < 8; ++e) gv[s][e] = bgv[e];
#pragma unroll
        for (int r = 0; r < 16; ++r) {
            const f32x4 w0 = *(const LAS f32x4*)(WG + r * 128 + 8 * co), w1 = *(const LAS f32x4*)(WG + r * 128 + 8 * co + 4);
            const float wv[8] = {w0.x, w0.y, w0.z, w0.w, w1.x, w1.y, w1.z, w1.w};
#pragma unroll
            for (int s = 0; s < 2; ++s)
#pragma unroll
                for (int e = 0; e < 8; ++e) gv[s][e] = fmaf(rr[s][r], wv[e], gv[s][e]);
        }
#pragma unroll
        for (int s = 0; s < 2; ++s)
#pragma unroll
            for (int e = 0; e < 8; ++e) { const float xg = gv[s][e]; gv[s][e] = (fminf(xg, 0.f) - __logf(1.f + __expf(-fabsf(xg)))) * (1.f / 16.f); }
    } else {
        float oml[8];
#pragma unroll
        for (int e = 0; e < 8; ++e) { const int c = h * 128 + 8 * co + e; const float dlt = a.in[11][MIXW + c] - a.in[11][c]; oml[e] = 1.f - __builtin_amdgcn_rcpf(1.f + __expf(-dlt)); }
#pragma unroll
        for (int s = 0; s < 2; ++s) {
            const bf16* rowp = proj + (tok0 + 2 * tg + s) * C::LDP;
            const v4u zw = *(const GAS v4u*)(rowp + C::CK + h * 128 + 8 * co); float z[8]; unpack8(zw, z);
#pragma unroll
            for (int e = 0; e < 8; ++e) { const float omf = oml[e] * __builtin_amdgcn_rcpf(1.f + __expf(z[e])); kx[s][e] = omf; gv[s][e] = __logf(1.f - omf); }
        }
    }
#pragma unroll
    for (int s = 0; s < 2; ++s) {
        LAS float* gp = G + (2 * tg + s) * 128 + 8 * co;
        *(LAS f32x4*)gp = (f32x4){gv[s][0], gv[s][1], gv[s][2], gv[s][3]}; *(LAS f32x4*)(gp + 4) = (f32x4){gv[s][4], gv[s][5], gv[s][6], gv[s][7]};
    }
    __syncthreads();
    {
        const int kk = tid & 127, seg = tid >> 7;
        float c[16]; float run = 0.f;
#pragma unroll
        for (int i = 0; i < 16; ++i) { run += G[(16 * seg + i) * 128 + kk]; c[i] = run; }
        T[seg * 128 + kk] = run;
        __syncthreads();
        float offs = 0.f, tot = 0.f;
#pragma unroll
        for (int s = 0; s < 4; ++s) { const float ts = T[s * 128 + kk]; tot += ts; if (s < seg) offs += ts; }
#pragma unroll
        for (int i = 0; i < 16; ++i) G[(16 * seg + i) * 128 + kk] = c[i] + offs;
        if (seg == 0) BL[kk] = tot;
    }
    __syncthreads();
}

template <int MIX>
__device__ __forceinline__ void mixer_phase_a(const Args& a, LAS unsigned char* lds, int vcu, int G_) {
    typedef MixCfg<MIX> C;
    int tid = threadIdx.x; asm volatile("" : "+v"(tid));
    const int lane = tid & 63, wave = __builtin_amdgcn_readfirstlane(tid >> 6);
    const bf16* proj = (const bf16*)(a.ws + WS_PROJ);
    constexpr int NIT = BATCH * C::H * NCH, NDT = C::DV / 16, VCH = C::DV / 8;
    for (int item = vcu; item < NIT; item += G_) {
        const int c = item % NCH, h = (item / NCH) % C::H, b = item / (NCH * C::H);
        const size_t tok0 = (size_t)b * SEQ + (size_t)c * CH;
#pragma unroll
        for (int i = 0; i < VCH * 64 / NTHREADS; ++i) { const int id = tid + NTHREADS * i, j = id / VCH, cv = id % VCH;
            *(LAS v4u*)(lds + MXA_V + j * C::VSTR + cv * 16) = *(const GAS v4u*)(proj + (tok0 + j) * C::LDP + C::CV + h * C::DV + 8 * cv); }
        float kx[2][8];
        mixer_gates<MIX>(a, proj, lds, tid, h, tok0, kx);
        {
            const int co = tid & 15, tg = tid >> 4;
            const LAS float* G = (const LAS float*)(lds + MX_G); const LAS float* BL = (const LAS float*)(lds + MX_BL);
            const f32x4 l0 = *(const LAS f32x4*)(BL + 8 * co), l1 = *(const LAS f32x4*)(BL + 8 * co + 4);
            const float bl[8] = {l0.x, l0.y, l0.z, l0.w, l1.x, l1.y, l1.z, l1.w};
#pragma unroll
            for (int s = 0; s < 2; ++s) { const int j = 2 * tg + s;
                const f32x4 b0 = *(const LAS f32x4*)(G + j * 128 + 8 * co), b1 = *(const LAS f32x4*)(G + j * 128 + 8 * co + 4);
                const float bb[8] = {b0.x, b0.y, b0.z, b0.w, b1.x, b1.y, b1.z, b1.w}; float o[8];
#pragma unroll
                for (int e = 0; e < 8; ++e) o[e] = kx[s][e] * __expf(bl[e] - bb[e]);
                *(LAS v4u*)(lds + MXA_KD + j * ISTR + 16 * co) = pack8(o); }
            if (tid < 128) ((float*)(a.ws + WS_DECAY))[(size_t)item * 128 + tid] = __expf(BL[tid]);
        }
        __syncthreads();
        f32x4 acc[NDT];
#pragma unroll
        for (int d = 0; d < NDT; ++d) acc[d] = (f32x4){0.f, 0.f, 0.f, 0.f};
#pragma unroll
        for (int ks = 0; ks < 2; ++ks) {
            const bf16x8 bfrag = ld_trfrag(lds + MXA_KD, 32 * ks, 16 * wave, ISTR, lane);
#pragma unroll
            for (int d = 0; d < NDT; ++d) { const bf16x8 afrag = ld_trfrag(lds + MXA_V, 32 * ks, 16 * d, C::VSTR, lane);
                acc[d] = __builtin_amdgcn_mfma_f32_16x16x32_bf16(afrag, bfrag, acc[d], 0, 0, 0); }
        }
        __syncthreads();
        {   const int g = lane >> 4, kk = 16 * wave + (lane & 15);
#pragma unroll
            for (int d = 0; d < NDT; ++d)
#pragma unroll
                for (int r = 0; r < 4; ++r) *(LAS bf16*)(lds + (16 * d + 4 * g + r) * 256 + kk * 2) = f2bf(acc[d][r]); }
        __syncthreads();
        {   bf16* st = (bf16*)(a.ws + WS_STATE) + (size_t)item * C::DV * 128;
#pragma unroll
            for (int i = 0; i < C::DV * 256 / 16 / NTHREADS; ++i) { const int id = tid + NTHREADS * i; *(GAS v4u*)(st + id * 8) = *(const LAS v4u*)(lds + id * 16); } }
        __syncthreads();
    }
}

template <int MIX>
__device__ __forceinline__ void mixer_scan(const Args& a, int vcu, int G_) {
    typedef MixCfg<MIX> C;
    int tid = threadIdx.x; asm volatile("" : "+v"(tid));
    constexpr int EPB = C::DV * 128 / 4;
    constexpr int NTASK = BATCH * C::H * EPB;
    const float* dec = (const float*)(a.ws + WS_DECAY);
    for (int task = vcu * NTHREADS + tid; task < NTASK; task += G_ * NTHREADS) {
        const int bh = task / EPB, e4 = task % EPB, kk = (4 * e4) & 127;
        v2u* sp = (v2u*)(a.ws + WS_STATE) + (size_t)bh * NCH * EPB + e4;
        const float* dp = dec + (size_t)bh * NCH * 128 + kk;
        float s0 = 0.f, s1 = 0.f, s2 = 0.f, s3 = 0.f;
#pragma unroll 16
        for (int c = 0; c < NCH; ++c) {
            const v2u lw = *(const GAS v2u*)(sp + (size_t)c * EPB);
            const f32x4 d = *(const GAS f32x4*)(dp + c * 128);
            v2u o; o.x = pk2(s0, s1); o.y = pk2(s2, s3);
            *(GAS v2u*)(sp + (size_t)c * EPB) = o;
            s0 = fmaf(s0, d.x, __uint_as_float(lw.x << 16)); s1 = fmaf(s1, d.y, __uint_as_float(lw.x & 0xffff0000u));
            s2 = fmaf(s2, d.z, __uint_as_float(lw.y << 16)); s3 = fmaf(s3, d.w, __uint_as_float(lw.y & 0xffff0000u));
        }
    }
}

template <int MIX>
__device__ __forceinline__ void mixer_phase_b(const Args& a, LAS unsigned char* lds, int vcu, int G_) {
    typedef MixCfg<MIX> C;
    int tid = threadIdx.x; asm volatile("" : "+v"(tid));
    const int lane = tid & 63, wave = __builtin_amdgcn_readfirstlane(tid >> 6);
    bf16* proj = (bf16*)(a.ws + WS_PROJ);
    constexpr int NIT = BATCH * C::H * NCH, NDT = C::DV / 16, NDH = NDT / 2, VCH = C::DV / 8, SCH = C::DV * 16 / NTHREADS;
    const float* onorm = MIX == 0 ? a.in[9] : a.in[12];
    for (int item = vcu; item < NIT; item += G_) {
        const int c = item % NCH, h = (item / NCH) % C::H, b = item / (NCH * C::H);
        const size_t tok0 = (size_t)b * SEQ + (size_t)c * CH;
        const int co = tid & 15, tg = tid >> 4;
        v4u sreg[SCH];
        { const bf16* st = (const bf16*)(a.ws + WS_STATE) + (size_t)item * C::DV * 128;
#pragma unroll
          for (int i = 0; i < SCH; ++i) sreg[i] = *(const GAS v4u*)(st + (tid + NTHREADS * i) * 8); }
#pragma unroll
        for (int i = 0; i < VCH * 64 / NTHREADS; ++i) { const int id = tid + NTHREADS * i, j = id / VCH, cv = id % VCH;
            *(LAS v4u*)(lds + MXB_V + j * C::VSTR + cv * 16) = *(const GAS v4u*)(proj + (tok0 + j) * C::LDP + C::CV + h * C::DV + 8 * cv); }
        float qx[2][8];
#pragma unroll
        for (int s = 0; s < 2; ++s) { const v4u qw = *(const GAS v4u*)(proj + (tok0 + 2 * tg + s) * C::LDP + C::CQ + h * 128 + 8 * co); unpack8(qw, qx[s]);
            if (MIX == 1) {
#pragma unroll
                for (int e = 0; e < 8; ++e) qx[s][e] = qx[s][e] * __builtin_amdgcn_rcpf(1.f + __expf(-qx[s][e])); } }
        float kx[2][8];
        mixer_gates<MIX>(a, proj, lds, tid, h, tok0, kx);
        {
            const LAS float* G = (const LAS float*)(lds + MX_G);
            float bb[2][8];
#pragma unroll
            for (int s = 0; s < 2; ++s) { const int j = 2 * tg + s;
                const f32x4 b0 = *(const LAS f32x4*)(G + j * 128 + 8 * co), b1 = *(const LAS f32x4*)(G + j * 128 + 8 * co + 4);
                bb[s][0] = b0.x; bb[s][1] = b0.y; bb[s][2] = b0.z; bb[s][3] = b0.w; bb[s][4] = b1.x; bb[s][5] = b1.y; bb[s][6] = b1.z; bb[s][7] = b1.w; }
            __syncthreads();
#pragma unroll
            for (int s = 0; s < 2; ++s) { const int j = 2 * tg + s; float oq[8], ok[8];
#pragma unroll
                for (int e = 0; e < 8; ++e) { const float ex = __expf(bb[s][e]); oq[e] = qx[s][e] * ex; ok[e] = kx[s][e] * __builtin_amdgcn_rcpf(ex); }
                *(LAS v4u*)(lds + MXB_QD + j * ISTR + 16 * co) = pack8(oq); *(LAS v4u*)(lds + MXB_KD + j * ISTR + 16 * co) = pack8(ok); }
#pragma unroll
            for (int i = 0; i < SCH; ++i) { const int id = tid + NTHREADS * i, row = id >> 4, ch = id & 15; *(LAS v4u*)(lds + MXB_ST + row * ISTR + ch * 16) = sreg[i]; }
        }
        __syncthreads();
        const int it = wave & 3, dh = wave >> 2, g = lane >> 4, li = lane & 15;
        bf16x8 qf[4];
#pragma unroll
        for (int ks = 0; ks < 4; ++ks) qf[ks] = ld_row8(lds + MXB_QD, 16 * it + li, 32 * ks + 8 * g, ISTR);
        f32x4 X[4];
#pragma unroll
        for (int jt = 0; jt < 4; ++jt) { X[jt] = (f32x4){0.f, 0.f, 0.f, 0.f};
            if (jt <= it) {
#pragma unroll
                for (int ks = 0; ks < 4; ++ks) { const bf16x8 kf = ld_row8(lds + MXB_KD, 16 * jt + li, 32 * ks + 8 * g, ISTR);
                    X[jt] = __builtin_amdgcn_mfma_f32_16x16x32_bf16(kf, qf[ks], X[jt], 0, 0, 0); }
                if (jt == it) {
#pragma unroll
                    for (int r = 0; r < 4; ++r) if (4 * g + r > li) X[jt][r] = 0.f; } } }
        bf16x8 pf[2];
#pragma unroll
        for (int k2 = 0; k2 < 2; ++k2) { v4u w; w.x = pk2(X[2 * k2][0], X[2 * k2][1]); w.y = pk2(X[2 * k2][2], X[2 * k2][3]); w.z = pk2(X[2 * k2 + 1][0], X[2 * k2 + 1][1]); w.w = pk2(X[2 * k2 + 1][2], X[2 * k2 + 1][3]);
            pf[k2] = __builtin_bit_cast(bf16x8, w); }
        f32x4 acc[NDH];
        float ssq = 0.f;
#pragma unroll
        for (int d = 0; d < NDH; ++d) { const int dt = dh * NDH + d; acc[d] = (f32x4){0.f, 0.f, 0.f, 0.f};
#pragma unroll
            for (int k2 = 0; k2 < 2; ++k2) if (2 * k2 <= it) { const bf16x8 vf = ld_trfrag(lds + MXB_V, 32 * k2, 16 * dt, C::VSTR, lane);
                acc[d] = __builtin_amdgcn_mfma_f32_16x16x32_bf16(vf, pf[k2], acc[d], 0, 0, 0); }
#pragma unroll
            for (int ks = 0; ks < 4; ++ks) { const bf16x8 sf = ld_row8(lds + MXB_ST, 16 * dt + li, 32 * ks + 8 * g, ISTR);
                acc[d] = __builtin_amdgcn_mfma_f32_16x16x32_bf16(sf, qf[ks], acc[d], 0, 0, 0); }
            ssq += (acc[d][0] * acc[d][0] + acc[d][1] * acc[d][1]) + (acc[d][2] * acc[d][2] + acc[d][3] * acc[d][3]); }
        ssq += __shfl_xor(ssq, 16); ssq += __shfl_xor(ssq, 32);
        LAS float* RS = (LAS float*)(lds + MXB_RS);
        if (g == 0) RS[dh * 64 + 16 * it + li] = ssq;
        __syncthreads();
        {   const float tot = RS[16 * it + li] + RS[64 + 16 * it + li];
            const float ri = rsqrtf(tot * (1.f / C::DV) + EPS);
            bf16* rowp = proj + (tok0 + 16 * it + li) * C::LDP;
#pragma unroll
            for (int d = 0; d < NDH; ++d) { const int dv = 16 * (dh * NDH + d) + 4 * g;
                const v2u gw = *(const GAS v2u*)(rowp + C::CG + h * C::DV + dv);
                const f32x4 gn = *(const GAS f32x4*)(onorm + dv);
                const float g0 = __uint_as_float(gw.x << 16), g1 = __uint_as_float(gw.x & 0xffff0000u), g2 = __uint_as_float(gw.y << 16), g3 = __uint_as_float(gw.y & 0xffff0000u);
                v2u o; o.x = pk2(acc[d][0] * ri * gn.x * (g0 * __builtin_amdgcn_rcpf(1.f + __expf(-g0))), acc[d][1] * ri * gn.y * (g1 * __builtin_amdgcn_rcpf(1.f + __expf(-g1))));
                o.y = pk2(acc[d][2] * ri * gn.z * (g2 * __builtin_amdgcn_rcpf(1.f + __expf(-g2))), acc[d][3] * ri * gn.w * (g3 * __builtin_amdgcn_rcpf(1.f + __expf(-g3))));
                *(GAS v2u*)(rowp + C::CV + h * C::DV + dv) = o; } }
        __syncthreads();
    }
}

constexpr int MA_STR = 160, MA_K = 0, MA_V = 40960, MA_Q = 81920;
template <int MIX>
__device__ __forceinline__ void memattn_phase(const Args& a, LAS unsigned char* lds, int vcu, int G_) {
    typedef MixCfg<MIX> C;
    int tid = threadIdx.x; asm volatile("" : "+v"(tid));
    const int lane = tid & 63, wave = __builtin_amdgcn_readfirstlane(tid >> 6), g = lane >> 4, li = lane & 15;
    bf16* proj = (bf16*)(a.ws + WS_PROJ);
    const bf16* kvm = (const bf16*)(a.ws + WS_KVMEM);
    constexpr int NIT = (M / 128) * 4;
    for (int item = vcu; item < NIT; item += G_) {
        const int hm = item & 3, tile = item >> 2; const size_t tok0 = (size_t)tile * 128; const int b = (int)(tok0 / SEQ);
#pragma unroll
        for (int i = 0; i < 4; ++i) { const int id = tid + NTHREADS * i, m = id >> 3, ch = id & 7;
            *(LAS v4u*)(lds + MA_K + m * MA_STR + ch * 16) = *(const GAS v4u*)(kvm + (size_t)(b * NMEM + m) * 512 + hm * 64 + 8 * ch);
            *(LAS v4u*)(lds + MA_V + m * MA_STR + ch * 16) = *(const GAS v4u*)(kvm + (size_t)(b * NMEM + m) * 512 + 256 + hm * 64 + 8 * ch); }
#pragma unroll
        for (int i = 0; i < 2; ++i) { const int id = tid + NTHREADS * i, t = id >> 3, ch = id & 7;
            *(LAS v4u*)(lds + MA_Q + t * MA_STR + ch * 16) = *(const GAS v4u*)(proj + (tok0 + t) * C::LDP + C::CMQ + hm * 64 + 8 * ch); }
        __syncthreads();
        bf16x8 qf[2];
#pragma unroll
        for (int ks = 0; ks < 2; ++ks) qf[ks] = ld_row8(lds + MA_Q, 16 * wave + li, 32 * ks + 8 * g, MA_STR);
        f32x4 X[16]; float mx = -3.0e38f;
#pragma unroll
        for (int kt = 0; kt < 16; ++kt) { X[kt] = (f32x4){0.f, 0.f, 0.f, 0.f};
#pragma unroll
            for (int ks = 0; ks < 2; ++ks) { const bf16x8 kf = ld_row8(lds + MA_K, 16 * kt + li, 32 * ks + 8 * g, MA_STR);
                X[kt] = __builtin_amdgcn_mfma_f32_16x16x32_bf16(kf, qf[ks], X[kt], 0, 0, 0); }
            mx = fmaxf(mx, fmaxf(fmaxf(X[kt][0], X[kt][1]), fmaxf(X[kt][2], X[kt][3]))); }
        mx = fmaxf(mx, __shfl_xor(mx, 16)); mx = fmaxf(mx, __shfl_xor(mx, 32));
        float sum = 0.f;
#pragma unroll
        for (int kt = 0; kt < 16; ++kt)
#pragma unroll
            for (int r = 0; r < 4; ++r) { const float p = __expf((X[kt][r] - mx) * 0.125f); X[kt][r] = p; sum += p; }
        sum += __shfl_xor(sum, 16); sum += __shfl_xor(sum, 32);
        const float inv = __builtin_amdgcn_rcpf(sum);
        f32x4 acc[4];
#pragma unroll
        for (int d = 0; d < 4; ++d) acc[d] = (f32x4){0.f, 0.f, 0.f, 0.f};
#pragma unroll
        for (int k2 = 0; k2 < 8; ++k2) {
            v4u w; w.x = pk2(X[2 * k2][0] * inv, X[2 * k2][1] * inv); w.y = pk2(X[2 * k2][2] * inv, X[2 * k2][3] * inv);
            w.z = pk2(X[2 * k2 + 1][0] * inv, X[2 * k2 + 1][1] * inv); w.w = pk2(X[2 * k2 + 1][2] * inv, X[2 * k2 + 1][3] * inv);
            const bf16x8 pf = __builtin_bit_cast(bf16x8, w);
#pragma unroll
            for (int d = 0; d < 4; ++d) { const bf16x8 vf = ld_trfrag(lds + MA_V, 32 * k2, 16 * d, MA_STR, lane);
                acc[d] = __builtin_amdgcn_mfma_f32_16x16x32_bf16(vf, pf, acc[d], 0, 0, 0); }
        }
        {   bf16* rowp = proj + (tok0 + 16 * wave + li) * C::LDP + C::CMQ + hm * 64;
#pragma unroll
            for (int d = 0; d < 4; ++d) { v2u o; o.x = pk2(acc[d][0], acc[d][1]); o.y = pk2(acc[d][2], acc[d][3]); *(GAS v2u*)(rowp + 16 * d + 4 * g) = o; } }
        __syncthreads();
    }
}
constexpr size_t WS_SLOT = WS_STATE;
constexpr size_t WS_HACT = WS_PROJ;
constexpr int NBK = 24;
constexpr int CW_CNT = 8192;
constexpr int TT_OFF = LDSCTL_OFF + 1024;
struct SlotRec { int token; float rinv, glo, ghi; };

namespace pg8 {
struct EpiResid {
    static constexpr bool PERM = true, AFTER_DRAIN = false;
    bf16_t* hb; int ldc;
    __device__ __forceinline__ void operator()(const f32x4 (&acc)[2][2][4][2], const Unit& u, int wr, int wc, int fr, int fq) const {
        const int row0 = u.pm * BM + wr * 64 + fr, col0 = u.pn * BM + wc * 32 + 8 * fq;
#pragma unroll
        for (int ai = 0; ai < 2; ++ai)
#pragma unroll
            for (int m = 0; m < 4; ++m) { bf16_t* rowp = hb + (size_t)(row0 + ai * HALF + m * 16) * ldc + col0;
#pragma unroll
                for (int bj = 0; bj < 2; ++bj) { const u32x4 b = *(const u32x4*)(rowp + bj * HALF); const f32x4 a0 = acc[ai][bj][m][0], a1 = acc[ai][bj][m][1];
                    u32x4 w; w.x = cvt_pk_bf16(__uint_as_float(b.x << 16) + a0[0], __uint_as_float(b.x & 0xffff0000u) + a0[1]); w.y = cvt_pk_bf16(__uint_as_float(b.y << 16) + a0[2], __uint_as_float(b.y & 0xffff0000u) + a0[3]);
                    w.z = cvt_pk_bf16(__uint_as_float(b.z << 16) + a1[0], __uint_as_float(b.z & 0xffff0000u) + a1[1]); w.w = cvt_pk_bf16(__uint_as_float(b.w << 16) + a1[2], __uint_as_float(b.w & 0xffff0000u) + a1[3]);
                    *(u32x4*)(rowp + bj * HALF) = w; }
                asm volatile("" ::: "memory"); }
    }
};
template <int mode> struct MoeOrder {
    static constexpr bool GATHER = (mode == 0);
    const PG8_LAS int* tt; int G, c; const SlotRec* slots;
    __device__ __forceinline__ bool next(int i, Unit& u) const {
        const int L = i * G + c, NT = __builtin_amdgcn_readfirstlane(tt[NBK]);
        if (L >= NT * 4) return false;
        const int rt = L >> 2; int bk = 0;
        for (int b = 1; b < NBK; ++b) if (rt >= __builtin_amdgcn_readfirstlane(tt[b])) bk = b;
        const int tb = __builtin_amdgcn_readfirstlane(tt[bk]), cn = __builtin_amdgcn_readfirstlane(tt[25 + bk]);
        u.pm = rt; u.pn = L & 3; u.x0 = bk; const int first = (rt - tb) * BM; u.x1 = min(cn - first, BM); u.x2 = bk * M + first; u.x3 = 0;
        return true;
    }
    __device__ __forceinline__ void a_ready(const Unit&) const {}
    __device__ __forceinline__ void done(const Unit&) const {}
    __device__ __forceinline__ static void experts(int bk, int& ea, int& eb) { const int g = bk / 6, p = bk % 6; const int lo = p < 3 ? 0 : (p < 5 ? 1 : 2), hi = p < 3 ? p + 1 : (p < 5 ? p - 1 : 3); ea = 4 * g + lo; eb = 4 * g + hi; }
    __device__ __forceinline__ unsigned a_off(const Gemm& g, const Unit& u, int r) const {
        const int rr = r < u.x1 ? r : u.x1 - 1; const int tok = slots[u.x2 + rr].token; return (unsigned)(tok * g.lda) * 2u;
    }
    __device__ __forceinline__ size_t b_off(const Gemm& g, const Unit& u) const {
        int ea, eb; experts(u.x0, ea, eb);
        if (mode == 0) { const int e = (u.pn < 2) ? ea : eb; return ((size_t)e * 512 + (size_t)(u.pn & 1) * 256) * D * 2; }
        return ((size_t)ea * D + (size_t)u.pn * 256) * FF * 2;
    }
    __device__ __forceinline__ long b_delta(const Gemm& g, const Unit& u) const {
        if (mode == 0) return 0;
        int ea, eb; experts(u.x0, ea, eb); return (long)(eb - ea) * D * FF * 2 - (long)FF * 2;
    }
};
struct EpiMoeUp {
    static constexpr bool PERM = true, AFTER_DRAIN = false;
    bf16_t* hact; const SlotRec* slots;
    __device__ __forceinline__ void operator()(const f32x4 (&acc)[2][2][4][2], const Unit& u, int wr, int wc, int fr, int fq) const {
        const int colo = (u.pn >> 1) * 256 + (u.pn & 1) * 128 + wc * 32 + 8 * fq;
#pragma unroll
        for (int ai = 0; ai < 2; ++ai)
#pragma unroll
            for (int m = 0; m < 4; ++m) { const int r = ai * HALF + wr * 64 + m * 16 + fr;
                { const SlotRec sr = slots[u.x2 + (r < u.x1 ? r : u.x1 - 1)]; const float ri = sr.rinv, gt = (u.pn < 2) ? sr.glo : sr.ghi; asm volatile("" ::: "memory");
                    float o[8];
#pragma unroll
                    for (int n = 0; n < 2; ++n)
#pragma unroll
                        for (int j = 0; j < 4; ++j) { const float av = acc[ai][0][m][n][j] * ri, bv = acc[ai][1][m][n][j] * ri; o[4 * n + j] = av * __builtin_amdgcn_rcpf(1.f + __expf(-av)) * bv * gt; }
                    u32x4 w; w.x = cvt_pk_bf16(o[0], o[1]); w.y = cvt_pk_bf16(o[2], o[3]); w.z = cvt_pk_bf16(o[4], o[5]); w.w = cvt_pk_bf16(o[6], o[7]);
                    *(u32x4*)(hact + (size_t)(u.pm * BM + r) * 512 + colo) = w; } }
    }
};
struct EpiMoeDown {
    static constexpr bool PERM = true, AFTER_DRAIN = false;
    bf16_t* hb; const SlotRec* slots; bf16_t* dummy;
    __device__ __forceinline__ void operator()(const f32x4 (&acc)[2][2][4][2], const Unit& u, int wr, int wc, int fr, int fq) const {
        const int col0 = u.pn * BM + wc * 32 + 8 * fq;
#pragma unroll
        for (int ai = 0; ai < 2; ++ai)
#pragma unroll
            for (int m = 0; m < 4; ++m) { const int r = ai * HALF + wr * 64 + m * 16 + fr;
                { const int tok = slots[u.x2 + (r < u.x1 ? r : u.x1 - 1)].token; bf16_t* rowp = (r < u.x1 ? hb + (size_t)tok * D : dummy) + col0;
#pragma unroll
                    for (int bj = 0; bj < 2; ++bj) { const u32x4 b = *(const u32x4*)(rowp + bj * HALF); const f32x4 a0 = acc[ai][bj][m][0], a1 = acc[ai][bj][m][1];
                        u32x4 w; w.x = cvt_pk_bf16(__uint_as_float(b.x << 16) + a0[0], __uint_as_float(b.x & 0xffff0000u) + a0[1]); w.y = cvt_pk_bf16(__uint_as_float(b.y << 16) + a0[2], __uint_as_float(b.y & 0xffff0000u) + a0[3]);
                        w.z = cvt_pk_bf16(__uint_as_float(b.z << 16) + a1[0], __uint_as_float(b.z & 0xffff0000u) + a1[1]); w.w = cvt_pk_bf16(__uint_as_float(b.w << 16) + a1[2], __uint_as_float(b.w & 0xffff0000u) + a1[3]);
                        *(u32x4*)(rowp + bj * HALF) = w; } }
                asm volatile("" ::: "memory"); }
    }
};
}

__device__ __forceinline__ void route_phase(const Args& a, int layer, LAS unsigned char* lds, int gw, int NGW) {
    int tid = threadIdx.x; asm volatile("" : "+v"(tid));
    const int lane = tid & 63;
    LAS float* WR = (LAS float*)lds;
    const float* gain = a.in[3] + layer * D; const float* wg = a.in[15] + (size_t)layer * D * NG; const float* wr = a.in[17] + (size_t)layer * D * NE;
#pragma unroll
    for (int i = 0; i < 8; ++i) { const int idx = tid + NTHREADS * i, k = idx >> 2, c4 = (idx & 3) * 4; const f32x4 w = *(const GAS f32x4*)(wr + (size_t)idx * 4); const float gk = gain[k];
        WR[(4 + c4) * D + k] = w.x * gk; WR[(5 + c4) * D + k] = w.y * gk; WR[(6 + c4) * D + k] = w.z * gk; WR[(7 + c4) * D + k] = w.w * gk; }
#pragma unroll
    for (int i = 0; i < 2; ++i) { const int k = tid + NTHREADS * i; const f32x4 w = *(const GAS f32x4*)(wg + (size_t)k * 4); const float gk = gain[k];
        WR[0 * D + k] = w.x * gk; WR[1 * D + k] = w.y * gk; WR[2 * D + k] = w.z * gk; WR[3 * D + k] = w.w * gk; }
    __syncthreads();
    const bf16* hbf = (const bf16*)(a.ws + WS_HBF); SlotRec* slots = (SlotRec*)(a.ws + WS_SLOT);
    unsigned* cnt = (unsigned*)(a.ws + WS_CTL) + CW_CNT + layer * 512;
    const float* bgp = a.in[16] + layer * NG; const float* brp = a.in[18] + layer * NE;
    for (int m = gw; m < M; m += NGW) {
        LAS float* WRl = WR + 8 * lane; asm volatile("" : "+v"(WRl));
        const GAS v4u* xr = (const GAS v4u*)(hbf + (size_t)m * D) + lane;
        float v[2][8]; float s = 0.f;
#pragma unroll
        for (int j = 0; j < 2; ++j) { unpack8(xr[64 * j], v[j]);
#pragma unroll
            for (int e = 0; e < 8; ++e) s = fmaf(v[j][e], v[j][e], s); }
        float lg[20];
#pragma unroll
        for (int c = 0; c < 20; ++c) { float acc = 0.f;
#pragma unroll
            for (int j = 0; j < 2; ++j) { const f32x4 w0 = *(const LAS f32x4*)(WRl + c * D + 512 * j), w1 = *(const LAS f32x4*)(WRl + c * D + 512 * j + 4);
                acc += (v[j][0] * w0.x + v[j][1] * w0.y) + (v[j][2] * w0.z + v[j][3] * w0.w) + (v[j][4] * w1.x + v[j][5] * w1.y) + (v[j][6] * w1.z + v[j][7] * w1.w); }
            lg[c] = acc; }
        s = wave_sum(s);
#pragma unroll
        for (int c = 0; c < 20; ++c) lg[c] = wave_sum(lg[c]);
        const float ri = rsqrtf(s * (1.f / D) + EPS);
#pragma unroll
        for (int c = 0; c < 4; ++c) lg[c] = lg[c] * ri + bgp[c];
#pragma unroll
        for (int c = 0; c < 16; ++c) lg[4 + c] = lg[4 + c] * ri + brp[c];
        int gi = 0; float gm = lg[0];
#pragma unroll
        for (int c = 1; c < 4; ++c) if (lg[c] > gm) { gm = lg[c]; gi = c; }
        float gs = 0.f;
#pragma unroll
        for (int c = 0; c < 4; ++c) gs += __expf(lg[c] - gm);
        const float gwt = 1.f / gs;
        float e[4];
#pragma unroll
        for (int c = 0; c < 4; ++c) e[c] = gi == 0 ? lg[4 + c] : (gi == 1 ? lg[8 + c] : (gi == 2 ? lg[12 + c] : lg[16 + c]));
        int i0 = 0;
#pragma unroll
        for (int c = 1; c < 4; ++c) if (e[c] > e[i0 == 0 ? 0 : (i0 == 1 ? 1 : (i0 == 2 ? 2 : 3))]) i0 = c;
        float e0 = i0 == 0 ? e[0] : (i0 == 1 ? e[1] : (i0 == 2 ? e[2] : e[3]));
        int i1 = -1; float e1 = -3.0e38f;
#pragma unroll
        for (int c = 0; c < 4; ++c) if (c != i0 && e[c] > e1) { e1 = e[c]; i1 = c; }
        const float p1 = __expf(e1 - e0), den = 1.f / (1.f + p1);
        const float w0 = gwt * den, w1 = gwt * p1 * den;
        const int lo = i0 < i1 ? i0 : i1, hi = i0 < i1 ? i1 : i0;
        const int pr = lo == 0 ? hi - 1 : (lo == 1 ? hi + 1 : 5);
        const int bk = gi * 6 + pr;
        if (lane == 0) {
            const unsigned pos = __hip_atomic_fetch_add(cnt + bk * 16, 1u, __ATOMIC_RELAXED, __HIP_MEMORY_SCOPE_AGENT);
            SlotRec sr; sr.token = m; sr.rinv = ri; sr.glo = i0 < i1 ? w0 : w1; sr.ghi = i0 < i1 ? w1 : w0;
            slots[(size_t)bk * M + pos] = sr;
        }
    }
}
__device__ __forceinline__ void moe_tile_table(const Args& a, int layer, LAS unsigned char* lds) {
    LAS int* tt = (LAS int*)(lds + TT_OFF);
    if (threadIdx.x == 0) {
        const unsigned* cnt = (const unsigned*)(a.ws + WS_CTL) + CW_CNT + layer * 512;
        int acc = 0;
        for (int b = 0; b < NBK; ++b) { const int c = (int)__hip_atomic_load(cnt + b * 16, __ATOMIC_RELAXED, __HIP_MEMORY_SCOPE_AGENT); tt[b] = acc; tt[25 + b] = c; acc += (c + 255) >> 8; }
        tt[NBK] = acc;
    }
    __syncthreads();
}
__device__ __forceinline__ void final_norm_phase(const Args& a, int gw, int NGW) {
    int tid = threadIdx.x; asm volatile("" : "+v"(tid));
    const int lane = tid & 63;
    const float* gain = a.in[5]; const bf16* hbf = (const bf16*)(a.ws + WS_HBF);
    for (int m = gw; m < M; m += NGW) {
        const GAS v4u* xr = (const GAS v4u*)(hbf + (size_t)m * D) + lane;
        float v[2][8]; float s = 0.f;
#pragma unroll
        for (int j = 0; j < 2; ++j) { unpack8(xr[64 * j], v[j]);
#pragma unroll
            for (int e = 0; e < 8; ++e) s = fmaf(v[j][e], v[j][e], s); }
        s = wave_sum(s);
        const float ri = rsqrtf(s * (1.f / D) + EPS);
        GAS f32x4* orow = (GAS f32x4*)(a.out + (size_t)m * D) + 2 * lane;
#pragma unroll
        for (int j = 0; j < 2; ++j) { const GAS f32x4* gp = (const GAS f32x4*)gain + 2 * lane + 128 * j;
            const f32x4 g0 = gp[0], g1 = gp[1];
            orow[128 * j] = (f32x4){v[j][0] * ri * g0.x, v[j][1] * ri * g0.y, v[j][2] * ri * g0.z, v[j][3] * ri * g0.w};
            orow[128 * j + 1] = (f32x4){v[j][4] * ri * g1.x, v[j][5] * ri * g1.y, v[j][6] * ri * g1.z, v[j][7] * ri * g1.w}; }
    }
}
__global__ void __launch_bounds__(NTHREADS, 2) fwd(Args args) {
    extern __shared__ __attribute__((aligned(16))) unsigned char lds_raw[];
    LAS unsigned char* lds = (LAS unsigned char*)lds_raw;
    const int tid = threadIdx.x, lane0 = tid & 63, wave = __builtin_amdgcn_readfirstlane(tid >> 6);
    const int G = gridDim.x; const int bx = blockIdx.x;
    const int vcu = (G % 8 == 0) ? (bx % 8) * (G / 8) + bx / 8 : bx;
    gu32* ctl = (gu32*)(args.ws + WS_CTL);
    volatile LAS unsigned* MISC = (volatile LAS unsigned*)(lds + MISC_OFF);
    for (int u = tid; u < (LDS_BYTES - LDSCTL_OFF) / 4; u += NTHREADS) ((LAS unsigned*)(lds + LDSCTL_OFF))[u] = 0u;
    __syncthreads();
    XcdBarrier bar; bar.bar = (unsigned*)(ctl + CW_BAR); bar.x = 0; bar.st = nullptr;
    if (args.use_bar) bar = xcd_barrier_post((unsigned*)(ctl + CW_BAR), MISC + 8);
    const int lo = args.ph_lo, hi = args.ph_hi;
#define IN(k) (lo <= (k) && (k) < hi)
#ifdef TIME_PHASE
#define STAMP(k) do { if (tid == 0) MISC[16 + (k)] = (unsigned)__builtin_amdgcn_s_memrealtime(); } while (0)
#else
#define STAMP(k) do { } while (0)
#endif
#define SEAM(k) do { if (IN(k) && IN((k) + 1)) xcd_barrier(bar); STAMP((k) + 1); } while (0)
    const int gw = vcu * NWAVES + wave, NGW = G * NWAVES;

    STAMP(0);
    for (int layer = 0; layer < 2; ++layer) {
        const int pb = layer * NPH;
        int lane = lane0; asm volatile("" : "+v"(lane));
        unsigned char* ws = args.ws; asm volatile("" : "+s"(ws));
        if (IN(pb + 0)) { p0_prologue(args, layer, lds, gw, NGW, wave, lane); }
        SEAM(pb + 0);
        if (IN(pb + 1)) {
            const int ldp = layer == 0 ? GLA_LDP : HG_LDP;
            { pg8::Gemm g{(const bf16*)(ws + WS_HBF), (const bf16*)(ws + WS_WIN), M, ldp, D, D, D}; pg8::StaticOrder S; S.init(M, ldp, G, bx);
              pg8::EpiRowScale E{(bf16*)(ws + WS_PROJ), ldp, (const float*)(ws + WS_RINV)};
              pg8::gemm_phase<pg8::EpiRowScale, pg8::StaticOrder, true>(lds, g, S, E); }
            { pg8::Gemm g{(const bf16*)(ws + WS_MEMBF), (const bf16*)(ws + WS_WKV), MROWS, 512, D, D, D}; pg8::StaticOrder S; S.init(MROWS, 512, G, bx);
              pg8::EpiRowScale E{(bf16*)(ws + WS_KVMEM), 512, (const float*)(ws + WS_RINVM)};
              pg8::gemm_phase<pg8::EpiRowScale, pg8::StaticOrder, true>(lds, g, S, E); }
        }
        SEAM(pb + 1);
        if (IN(pb + 2)) { if (layer == 0) mixer_phase_a<0>(args, lds, vcu, G); else mixer_phase_a<1>(args, lds, vcu, G); }
        SEAM(pb + 2);
        if (IN(pb + 3)) { if (layer == 0) mixer_scan<0>(args, vcu, G); else mixer_scan<1>(args, vcu, G); }
        SEAM(pb + 3);
        if (IN(pb + 4)) { if (layer == 0) { mixer_phase_b<0>(args, lds, vcu, G); memattn_phase<0>(args, lds, vcu, G); } else { mixer_phase_b<1>(args, lds, vcu, G); memattn_phase<1>(args, lds, vcu, G); } }
        SEAM(pb + 4);
        if (IN(pb + 5)) {
            const int ldp = layer == 0 ? GLA_LDP : HG_LDP, cv = layer == 0 ? GLA_CV : HG_CV;
            pg8::Gemm g{(const bf16*)(ws + WS_PROJ) + cv, (const bf16*)(ws + WS_WOUT), M, D, D, ldp, D}; pg8::StaticOrder S; S.init(M, D, G, bx);
            pg8::EpiResid E{(bf16*)(ws + WS_HBF), D};
            pg8::gemm_phase<pg8::EpiResid, pg8::StaticOrder, true>(lds, g, S, E);
        }
        SEAM(pb + 5);
        if (IN(pb + 6)) route_phase(args, layer, lds, gw, NGW);
        SEAM(pb + 6);
        if (IN(pb + 7)) {
            moe_tile_table(args, layer, lds);
            pg8::Gemm g{(const bf16*)(ws + WS_HBF), (const bf16*)(ws + WS_WUP), M, 1024, D, D, D};
            pg8::MoeOrder<0> S{(const LAS int*)(lds + TT_OFF), G, vcu, (const SlotRec*)(ws + WS_SLOT)};
            pg8::EpiMoeUp E{(bf16*)(ws + WS_HACT), (const SlotRec*)(ws + WS_SLOT)};
            pg8::gemm_phase<pg8::EpiMoeUp, pg8::MoeOrder<0>, true>(lds, g, S, E);
        }
        SEAM(pb + 7);
        if (IN(pb + 8)) {
            moe_tile_table(args, layer, lds);
            pg8::Gemm g{(const bf16*)(ws + WS_HACT), (const bf16*)(ws + WS_WDN), M, D, 2 * FF, 2 * FF, FF};
            pg8::MoeOrder<1> S{(const LAS int*)(lds + TT_OFF), G, vcu, (const SlotRec*)(ws + WS_SLOT)};
            pg8::EpiMoeDown E{(bf16*)(ws + WS_HBF), (const SlotRec*)(ws + WS_SLOT), (bf16*)(ws + WS_DUMMY)};
            pg8::gemm_phase<pg8::EpiMoeDown, pg8::MoeOrder<1>, true>(lds, g, S, E);
        }
        SEAM(pb + 8);
    }
    if (IN(2 * NPH)) final_norm_phase(args, gw, NGW);
#ifdef TIME_PHASE
    STAMP(2 * NPH + 1);
    if (bx == 0 && tid == 0) { const unsigned span = (MISC[16 + TIME_PHASE_END] - MISC[16 + TIME_PHASE]) * TIME_AMP; const unsigned t0 = (unsigned)__builtin_amdgcn_s_memrealtime();
        while ((unsigned)__builtin_amdgcn_s_memrealtime() - t0 < span) __builtin_amdgcn_s_sleep(8); }
#endif
#undef IN
#undef SEAM
}
#ifndef N_LAUNCHES
#define N_LAUNCHES 1
#endif
constexpr int NPHASES = 2 * NPH + 1;
extern "C" void kernel_launch(void* const* d_in, const int* in_sizes, int n_in, void* d_out, int out_size, void* d_ws, size_t ws_size, hipStream_t stream) {
    static int grid = 0;
    if (grid == 0) {
        int dev = 0, cus = 0, per_cu = 0;
        if (n_in != 21 || out_size != M * D || ws_size < 256 * MiB) { fprintf(stderr, "kernel_launch: unexpected problem shape (n_in %d, out %d, ws %zu)\n", n_in, out_size, ws_size); grid = -1; return; }
        if (hipGetDevice(&dev) != hipSuccess || hipDeviceGetAttribute(&cus, hipDeviceAttributeMultiprocessorCount, dev) != hipSuccess) { fprintf(stderr, "kernel_launch: device query failed\n"); grid = -1; return; }
        if (hipFuncSetAttribute((const void*)fwd, hipFuncAttributeMaxDynamicSharedMemorySize, LDS_BYTES) != hipSuccess) { fprintf(stderr, "kernel_launch: hipFuncSetAttribute failed\n"); grid = -1; return; }
        if (hipOccupancyMaxActiveBlocksPerMultiprocessor(&per_cu, (const void*)fwd, NTHREADS, LDS_BYTES) != hipSuccess || per_cu < 1) { fprintf(stderr, "kernel_launch: occupancy query reports %d workgroups per CU; nothing launched\n", per_cu); (void)hipGetLastError(); grid = -1; return; }
        (void)hipGetLastError();
        grid = cus;
    }
    if (grid < 0) return;
    (void)hipMemsetAsync((char*)d_ws + WS_CTL, 0, CTL_ZERO_BYTES, stream);
    Args a{};
    for (int i = 0; i < 21; ++i) a.in[i] = (const float*)d_in[i];
    a.out = (float*)d_out; a.ws = (unsigned char*)d_ws;
    if (N_LAUNCHES == 1) { a.ph_lo = 0; a.ph_hi = NPHASES; a.use_bar = 1; hipLaunchKernelGGL(fwd, dim3(grid), dim3(NTHREADS), LDS_BYTES, stream, a); }
    else for (int p = 0; p < NPHASES; ++p) { a.ph_lo = p; a.ph_hi = p + 1; a.use_bar = 0; hipLaunchKernelGGL(fwd, dim3(grid), dim3(NTHREADS), LDS_BYTES, stream, a); }
}
```

```cpp
#include <hip/hip_runtime.h>
#include <cstdio>
#include <cstdint>

#define GAS __attribute__((address_space(1)))
#define LAS __attribute__((address_space(3)))
typedef unsigned short bf16;
typedef unsigned v4u __attribute__((ext_vector_type(4)));
typedef unsigned v2u __attribute__((ext_vector_type(2)));
typedef float f32x4 __attribute__((ext_vector_type(4)));
typedef short bf16x8 __attribute__((ext_vector_type(8)));
typedef short s16x4 __attribute__((ext_vector_type(4)));
typedef GAS unsigned gu32;
typedef GAS unsigned long long gu64;
#define RLX_AGENT __ATOMIC_RELAXED, __HIP_MEMORY_SCOPE_AGENT
#define LDS_WAIT() asm volatile("s_waitcnt lgkmcnt(0)" ::: "memory")
#define VM_WAIT() asm volatile("s_waitcnt vmcnt(0)" ::: "memory")

constexpr int D = 1024, BATCH = 4, SEQ = 4096, M = BATCH * SEQ, NMEM = 256, MROWS = BATCH * NMEM;
constexpr int MIXW = 768, MEMW = 256, CH = 64, NCH = SEQ / CH;
constexpr int GLA_H = 4, GLA_KW = 512, GLA_DK = 128, GLA_DV = 192, GLA_IN = 2832, GLA_RANK = 16;
constexpr int HG_H = 6, HG_DK = 128, HG_DV = 128, HG_IN = 3328;
constexpr int NG = 4, EPG = 4, NE = 16, FF = 256;
constexpr float EPS = 1e-6f;
constexpr int GLA_LDP = 3072, GLA_CQ = 0, GLA_CK = 512, GLA_CG = 1024, GLA_CV = 1792, GLA_CMQ = 2560, GLA_CR = 2816;
constexpr int HG_LDP = 3328, HG_CQ = 0, HG_CF = 768, HG_CG = 1536, HG_CV = 2304, HG_CMQ = 3072;

__device__ __forceinline__ float bf2f(bf16 b) { return __uint_as_float(((unsigned)b) << 16); }
__device__ __forceinline__ bf16 f2bf(float f) { return __builtin_bit_cast(unsigned short, (__bf16)f); }
__device__ __forceinline__ unsigned pk2(float lo, float hi) { return (unsigned)f2bf(lo) | ((unsigned)f2bf(hi) << 16); }
__device__ __forceinline__ float wave_sum(float v) {
#pragma unroll
    for (int o = 32; o >= 1; o >>= 1) v += __shfl_xor(v, o);
    return v;
}
__device__ __forceinline__ float wave_max(float v) {
#pragma unroll
    for (int o = 32; o >= 1; o >>= 1) v = fmaxf(v, __shfl_xor(v, o));
    return v;
}
__device__ __forceinline__ float sigmoidf_(float x) { return 1.f / (1.f + __expf(-x)); }
__device__ __forceinline__ float siluf_(float x) { return x / (1.f + __expf(-x)); }
__device__ __forceinline__ float logsigmoidf_(float x) { return fminf(x, 0.f) - log1pf(__expf(-fabsf(x))); }

#define N_LAUNCHES 1
namespace pg8 {
#define PG8_LAS __attribute__((address_space(3)))
typedef unsigned short bf16_t;
typedef short bf16x8 __attribute__((ext_vector_type(8)));
typedef float f32x4 __attribute__((ext_vector_type(4)));
typedef unsigned u32x4 __attribute__((ext_vector_type(4)));
constexpr int BM = 256, BK = 64, HALF = 128, HTB = HALF * BK * 2  , STAGE_BYTES = 8 * HTB, NXCD = 8, WGM = 8;

__host__ __device__ __forceinline__ int lds_byte(int r, int c) { const int st = (r >> 4) * 2 + (c >> 5), rr = r & 15, cc = c & 31, ob = rr * 64 + cc * 2; return st * 1024 + (ob ^ (((ob >> 9) & 1) << 5)); }
__host__ __device__ __forceinline__ void stage_rc(int b, int& R, int& C) { const int st = b / 1024, sb = b % 1024, swz = sb ^ (((sb >> 9) & 1) << 5); R = (st >> 1) * 16 + swz / 64; C = (st & 1) * 32 + (swz % 64) / 2; }
__host__ __device__ __forceinline__ int perm32(int rho) { const int n = rho >> 4, i = rho & 15; return 8 * (i >> 2) + 4 * n + (i & 3); }

struct Unit { int pm, pn; int x0, x1, x2, x3; };
struct Gemm { const bf16_t* A; const bf16_t* Bt; int M, N, K, lda, ldb; };

struct StaticOrder {
    int nM, nN, nwg, G, c;
    __host__ __device__ void init(int M, int N, int G_, int c_) { nM = M / BM; nN = N / BM; nwg = nM * nN; G = G_; c = c_; }
    __host__ __device__ bool next(int i, Unit& u) const {
        const long L = (long)i * G + c; if (L >= nwg) return false;
        int wgid = (int)L; { const int q = nwg / NXCD, r = nwg % NXCD, xcd = wgid % NXCD, off = wgid / NXCD; wgid = (xcd < r ? xcd * (q + 1) : r * (q + 1) + (xcd - r) * q) + off; }
        const int nig = WGM * nN, gid = wgid / nig, fm = gid * WGM, gsz = (nM - fm) < WGM ? (nM - fm) : WGM;
        u.pm = fm + ((wgid % nig) % gsz); u.pn = (wgid % nig) / gsz; return true;
    }
    __device__ __forceinline__ void a_ready(const Unit&) const {}
    __device__ __forceinline__ void done(const Unit&) const {}
    static constexpr bool GATHER = false;
    __device__ __forceinline__ unsigned a_off(const Gemm& g, const Unit& u, int r) const { return 0u; }
    __device__ __forceinline__ size_t b_off(const Gemm& g, const Unit& u) const { return (size_t)u.pn * BM * g.ldb * 2; }
    __device__ __forceinline__ long b_delta(const Gemm&, const Unit&) const { return 0; }
};
__device__ __forceinline__ unsigned cvt_pk_bf16(float lo, float hi) { unsigned r; asm volatile("v_cvt_pk_bf16_f32 %0, %1, %2" : "=v"(r) : "v"(lo), "v"(hi)); return r; }
template <class Epi, class Sched, bool ALIGN_EPI = false>
__device__ __forceinline__ void gemm_phase(PG8_LAS unsigned char* lds, const Gemm g, const Sched& S, const Epi& E) {
    int tid_ = threadIdx.x; asm volatile("" : "+v"(tid_));
    const int tid = tid_, wid = __builtin_amdgcn_readfirstlane(tid >> 6), lane = tid & 63, wr = wid >> 2, wc = wid & 3, fr = lane & 15, fq = lane >> 4;
    const int K = g.K, nt = K / BK;
    int Rst[2], Cst[2]; unsigned voffB[2];
#pragma unroll
    for (int i = 0; i < 2; ++i) { int R, C; stage_rc(tid * 16 + i * 8192, R, C); const int Rb = Epi::PERM ? ((R & ~31) + perm32(R & 31)) : R;
        Rst[i] = R; Cst[i] = C * 2; voffB[i] = (unsigned)(Rb * g.ldb + C) * 2u; }
    const unsigned kstep = (unsigned)(BK * 2);
    const size_t hstepB = (size_t)HALF * g.ldb * 2;
    const unsigned ldsw = (unsigned)wid * 1024u;
    const int aoff = lds_byte(wr * 64 + fr, fq * 8), boff = lds_byte(wc * 32 + fr, fq * 8);
#define PG8_SA(b, h) (((b) * 2 + (h)) * HTB)
#define PG8_SB(b, h) ((4 + (b) * 2 + (h)) * HTB)
#define PG8_STAGE_B(bufoff, gbase) do { _Pragma("unroll") for (int _i = 0; _i < 2; ++_i) \
        __builtin_amdgcn_global_load_lds((const unsigned*)((const char*)(gbase) + voffB[_i]), (PG8_LAS unsigned*)(lds + (bufoff) + ldsw + _i * 8192), 16, 0, 0); } while (0)
#define PG8_STAGE_A(bufoff, so, o0, o1) do { const char* _ab = (const char*)g.A + (so); \
        __builtin_amdgcn_global_load_lds((const unsigned*)(_ab + (o0)), (PG8_LAS unsigned*)(lds + (bufoff) + ldsw), 16, 0, 0); \
        __builtin_amdgcn_global_load_lds((const unsigned*)(_ab + (o1)), (PG8_LAS unsigned*)(lds + (bufoff) + ldsw + 8192), 16, 0, 0); } while (0)
#define PG8_LDA(dst, b, h) do { _Pragma("unroll") for (int m = 0; m < 4; ++m) _Pragma("unroll") for (int k = 0; k < 2; ++k) dst[m][k] = *(const PG8_LAS bf16x8*)(lds + PG8_SA(b, h) + aoff + m * 2048 + k * 1024); } while (0)
#define PG8_LDB(dst, b, h) do { _Pragma("unroll") for (int n = 0; n < 2; ++n) _Pragma("unroll") for (int k = 0; k < 2; ++k) dst[n][k] = *(const PG8_LAS bf16x8*)(lds + PG8_SB(b, h) + boff + n * 2048 + k * 1024); } while (0)
#define PG8_MMA(ai, bj, At, Bt) do { __builtin_amdgcn_s_setprio(1); _Pragma("unroll") for (int m = 0; m < 4; ++m) _Pragma("unroll") for (int n = 0; n < 2; ++n) _Pragma("unroll") for (int k = 0; k < 2; ++k) \
        acc[ai][bj][m][n] = __builtin_amdgcn_mfma_f32_16x16x32_bf16(Bt[n][k], At[m][k], acc[ai][bj][m][n], 0, 0, 0); __builtin_amdgcn_s_setprio(0); } while (0)
#define PG8_WAIT_V(n) asm volatile("s_waitcnt vmcnt(" #n ")" ::: "memory")
#define PG8_WAIT_L(n) asm volatile("s_waitcnt lgkmcnt(" #n ")" ::: "memory")
#define PG8_BAR __builtin_amdgcn_s_barrier()
#define PG8_SCHED __builtin_amdgcn_sched_barrier(0)
    Unit cur, nxt; int ui = 0;
    if (!S.next(0, cur)) return;
    f32x4 acc[2][2][4][2];
#pragma unroll
    for (int a = 0; a < 2; ++a)
#pragma unroll
        for (int b = 0; b < 2; ++b)
#pragma unroll
            for (int m = 0; m < 4; ++m)
#pragma unroll
                for (int n = 0; n < 2; ++n) acc[a][b][m][n] = (f32x4){0.f, 0.f, 0.f, 0.f};
    bf16x8 At[4][2], B0[2][2], B1[2][2];
    S.a_ready(cur);
    constexpr bool GA = Sched::GATHER;
    const unsigned voffA0 = (unsigned)(Rst[0] * g.lda) * 2u + Cst[0], voffA1 = (unsigned)(Rst[1] * g.lda) * 2u + Cst[1];
    const size_t hstepA = (size_t)HALF * g.lda * 2;
    unsigned vc00 = voffA0, vc01 = voffA1, vc10 = voffA0, vc11 = voffA1; size_t sc0 = 0, sc1 = 0;
    if constexpr (GA) { vc00 = S.a_off(g, cur, Rst[0]) + Cst[0]; vc01 = S.a_off(g, cur, Rst[1]) + Cst[1]; vc10 = S.a_off(g, cur, HALF + Rst[0]) + Cst[0]; vc11 = S.a_off(g, cur, HALF + Rst[1]) + Cst[1]; }
    else { sc0 = (size_t)cur.pm * 2 * hstepA; sc1 = sc0 + hstepA; }
    const char* cB = (const char*)g.Bt + S.b_off(g, cur); long cD = S.b_delta(g, cur);
    PG8_STAGE_B(PG8_SB(0, 0), cB); PG8_STAGE_B(PG8_SB(0, 1), cB + hstepB); PG8_STAGE_A(PG8_SA(0, 0), sc0, vc00, vc01); PG8_STAGE_A(PG8_SA(0, 1), sc1, vc10, vc11);
    if (wr == 1) PG8_BAR;
    PG8_WAIT_V(2); PG8_BAR;
    PG8_STAGE_B(PG8_SB(1, 0), cB + kstep); PG8_STAGE_A(PG8_SA(1, 0), sc0 + kstep, vc00, vc01); PG8_STAGE_B(PG8_SB(1, 1), cB + hstepB + kstep);
    PG8_WAIT_V(6); PG8_BAR;
    for (;;) {
        const bool has_next = S.next(ui + 1, nxt);
        unsigned vn00 = vc00, vn01 = vc01, vn10 = vc10, vn11 = vc11; size_t sn0 = sc0, sn1 = sc1; const char* nB = cB; long nD = cD;
        if (has_next) {
            if constexpr (GA) { vn00 = S.a_off(g, nxt, Rst[0]) + Cst[0]; vn01 = S.a_off(g, nxt, Rst[1]) + Cst[1]; vn10 = S.a_off(g, nxt, HALF + Rst[0]) + Cst[0]; vn11 = S.a_off(g, nxt, HALF + Rst[1]) + Cst[1]; }
            else { sn0 = (size_t)nxt.pm * 2 * hstepA; sn1 = sn0 + hstepA; }
            nB = (const char*)g.Bt + S.b_off(g, nxt); nD = S.b_delta(g, nxt); }
#pragma nounroll
        for (int t = 0; t < nt; t += 2) {
            const bool last = (t == nt - 2);
            const unsigned k1 = (unsigned)(t + 1) * kstep, k2 = (unsigned)(t + 2) * kstep;
            unsigned o00 = vc00, o01 = vc01, o10 = vc10, o11 = vc11;
            if constexpr (GA) { o00 = last ? vn00 : vc00; o01 = last ? vn01 : vc01; o10 = last ? vn10 : vc10; o11 = last ? vn11 : vc11; }
            const size_t s20 = last ? sn0 : sc0 + k2, s21 = last ? sn1 : sc1 + k2;
            const char* b2 = last ? nB : cB + k2 + ((t + 2) >= nt / 2 ? cD : 0); const char* b3 = b2 + kstep;
            if (last && has_next) S.a_ready(nxt);
            PG8_LDB(B0, 0, 0); PG8_LDB(B1, 0, 1); PG8_SCHED; PG8_LDA(At, 0, 0); PG8_STAGE_A(PG8_SA(1, 1), sc1 + k1, vc10, vc11);
            PG8_WAIT_V(8); PG8_WAIT_L(0); PG8_BAR; PG8_MMA(0, 0, At, B0); PG8_MMA(0, 1, At, B1); PG8_BAR; PG8_SCHED;
            PG8_LDA(At, 0, 1); PG8_STAGE_B(PG8_SB(0, 0), b2); PG8_STAGE_B(PG8_SB(0, 1), b2 + hstepB); PG8_STAGE_A(PG8_SA(0, 0), s20, o00, o01);
            PG8_WAIT_V(8); PG8_WAIT_L(0); PG8_BAR; PG8_MMA(1, 0, At, B0); PG8_MMA(1, 1, At, B1); PG8_BAR; PG8_SCHED;
            PG8_LDB(B0, 1, 0); PG8_LDB(B1, 1, 1); PG8_SCHED; PG8_LDA(At, 1, 0); PG8_STAGE_A(PG8_SA(0, 1), s21, o10, o11);
            PG8_WAIT_V(8); PG8_WAIT_L(0); PG8_BAR; PG8_MMA(0, 0, At, B0); PG8_MMA(0, 1, At, B1); PG8_BAR; PG8_SCHED;
            PG8_LDA(At, 1, 1); PG8_STAGE_B(PG8_SB(1, 0), b3); PG8_STAGE_B(PG8_SB(1, 1), b3 + hstepB); PG8_STAGE_A(PG8_SA(1, 0), s20 + kstep, o00, o01);
            PG8_WAIT_V(8); PG8_WAIT_L(0); PG8_BAR; PG8_MMA(1, 0, At, B0); PG8_MMA(1, 1, At, B1); PG8_BAR; PG8_SCHED;
        }
        if constexpr (ALIGN_EPI) { if (wr == 0) PG8_BAR; }
        if constexpr (!Epi::AFTER_DRAIN) { E(acc, cur, wr, wc, fr, fq); S.done(cur); }
        if (!has_next) break;
#pragma unroll
        for (int a = 0; a < 2; ++a)
#pragma unroll
            for (int b = 0; b < 2; ++b)
#pragma unroll
                for (int m = 0; m < 4; ++m)
#pragma unroll
                    for (int n = 0; n < 2; ++n) acc[a][b][m][n] = (f32x4){0.f, 0.f, 0.f, 0.f};
        cur = nxt; vc00 = vn00; vc01 = vn01; vc10 = vn10; vc11 = vn11; sc0 = sn0; sc1 = sn1; cB = nB; cD = nD; ++ui;
        if constexpr (ALIGN_EPI) { if (wr == 1) PG8_BAR; }
    }
    PG8_WAIT_V(0);
    if constexpr (!ALIGN_EPI) { if (wr == 0) PG8_BAR; }
    PG8_BAR;
    if constexpr (Epi::AFTER_DRAIN) { E.fused(acc, cur, wr, wc, fr, fq, lds, wid, lane); S.done(cur); }
#undef PG8_SA
#undef PG8_SB
#undef PG8_STAGE_A
#undef PG8_STAGE_B
#undef PG8_LDA
#undef PG8_LDB
#undef PG8_MMA
#undef PG8_WAIT_V
#undef PG8_WAIT_L
#undef PG8_BAR
#undef PG8_SCHED
}
}
#define XB_TMO      128
#define XB_XCNT(j)  (256  + 64 * (j))
#define XB_XSUB(j)  (1280 + 64 * (j))
#define XB_XGEN(j)  (2304 + 64 * (j))
#define XB_TOP      3328
#define XB_TOPGEN   3392
#define XCD_BAR_WORDS 3456
#define XB_SPIN_CAP (1u << 18)

__device__ __forceinline__ unsigned xb_ld(unsigned* p)              { return __hip_atomic_load(p, __ATOMIC_RELAXED, __HIP_MEMORY_SCOPE_AGENT); }
__device__ __forceinline__ unsigned xb_add(unsigned* p, unsigned v) { return __hip_atomic_fetch_add(p, v, __ATOMIC_RELAXED, __HIP_MEMORY_SCOPE_AGENT); }
__device__ __forceinline__ unsigned xb_xcc_id() { return (unsigned)__builtin_amdgcn_s_getreg((3 << 11) | 20) & 0xFu; }
#define XB_SPIN(cond, bar) do { unsigned _sp = 0; while (cond) { __builtin_amdgcn_s_sleep(1); \
    if ((++_sp & 255u) == 0u) { if (xb_ld(&(bar)[XB_TMO])) break; if (_sp > XB_SPIN_CAP) { atomicAdd(&(bar)[XB_TMO], 1u); break; } } } } while (0)

struct XcdBarrier {
    unsigned* bar; unsigned x;
    volatile LAS unsigned* st;
};

__device__ __forceinline__ XcdBarrier xcd_barrier_post(unsigned* bar, volatile LAS unsigned* st) {
    XcdBarrier b; b.bar = bar; b.x = xb_xcc_id(); b.st = st;
    if (threadIdx.x == 0) (void)xb_add(&bar[XB_XCNT(b.x)], 1u);
    return b;
}
__device__ __forceinline__ void xcd_barrier_complete(unsigned* bar, unsigned x, unsigned& nloc, unsigned& nx) {
    const unsigned G = gridDim.x * gridDim.y * gridDim.z;
    unsigned sum, cnt, mine, sp = 0u;
    for (;;) {
        sum = 0u; cnt = 0u; mine = 0u;
#pragma unroll
        for (unsigned j = 0; j < 16; ++j) { const unsigned c = xb_ld(&bar[XB_XCNT(j)]); sum += c; cnt += (c > 0u) ? 1u : 0u; mine = (j == x) ? c : mine; }
        if (sum == G) break;
        __builtin_amdgcn_s_sleep(1);
        if ((++sp & 255u) == 0u) { if (xb_ld(&bar[XB_TMO])) break; if (sp > XB_SPIN_CAP) { atomicAdd(&bar[XB_TMO], 1u); break; } }
    }
    nloc = mine > 0u ? mine : 1u; nx = cnt > 0u ? cnt : 1u;
}

__device__ __forceinline__ void xcd_barrier(const XcdBarrier& b) {
    asm volatile("s_waitcnt vmcnt(0)" ::: "memory");
    __syncthreads();
    if (threadIdx.x == 0) {
        unsigned* bar = b.bar;
        __builtin_amdgcn_s_waitcnt(0);
        unsigned nloc = b.st[0], nx = b.st[1];
        if (nloc == 0u) { xcd_barrier_complete(bar, b.x, nloc, nx); b.st[0] = nloc; b.st[1] = nx; }
        const unsigned old = xb_add(&bar[XB_XSUB(b.x)], 1u);
        const unsigned gen = old / nloc;
        if (old + 1u == (gen + 1u) * nloc) {
            __builtin_amdgcn_fence(__ATOMIC_RELEASE, "agent");
            asm volatile("s_waitcnt vmcnt(0)" ::: "memory");
            const unsigned og = xb_add(&bar[XB_TOP], 1u);
            const unsigned tg = og / nx;
            if (og + 1u == (tg + 1u) * nx) xb_add(&bar[XB_TOPGEN], 1u);
            else XB_SPIN(xb_ld(&bar[XB_TOPGEN]) == tg, bar);
            __builtin_amdgcn_fence(__ATOMIC_ACQUIRE, "agent");
            xb_add(&bar[XB_XGEN(b.x)], 1u);
            asm volatile("s_waitcnt vmcnt(0)" ::: "memory");
        } else {
            XB_SPIN(xb_ld(&bar[XB_XGEN(b.x)]) == gen, bar);
            __builtin_amdgcn_fence(__ATOMIC_ACQUIRE, "agent");
            asm volatile("s_waitcnt vmcnt(0)" ::: "memory");
        }
    }
    __syncthreads();
}
constexpr size_t MiB = 1u << 20;
constexpr size_t WS_CTL = 0, CTL_ZERO_BYTES = 1 * MiB;
constexpr size_t WS_W0 = 1 * MiB;
constexpr size_t REL_WIN = 0;
constexpr size_t REL_WOUT = REL_WIN + 13 * MiB / 2;
constexpr size_t REL_WKV = REL_WOUT + 2 * MiB;
constexpr size_t REL_WUP = REL_WKV + 1 * MiB;
constexpr size_t REL_WDN = REL_WUP + 16 * MiB;
constexpr size_t REL_WEND = REL_WDN + 8 * MiB;
constexpr size_t WS_HBF = 35 * MiB;
constexpr size_t WS_MEMBF = WS_HBF + 32 * MiB;
constexpr size_t WS_PROJ = 69 * MiB;
constexpr size_t WS_STATE = 173 * MiB;
constexpr size_t WS_MISC = 250 * MiB;
constexpr size_t WS_RINV = WS_MISC;
constexpr size_t WS_RINVM = WS_RINV + 64 * 1024;
constexpr size_t WS_KVMEM = WS_RINVM + 4096;
constexpr size_t WS_DECAY = WS_KVMEM + 2 * MiB;
constexpr size_t WS_DUMMY = WS_DECAY + 1 * MiB;
constexpr size_t WS_ROWSS = WS_DUMMY + 4096;
constexpr size_t WS_END_OPT = WS_ROWSS + 1 * MiB;
static_assert(WS_W0 + REL_WEND <= WS_HBF && REL_WEND <= (size_t)M * D * 4 && WS_END_OPT <= 256 * MiB, "ws map");
constexpr int CW_ROWSS = 16384;
constexpr int CW_BAR = 4096;

constexpr int RING_BYTES = 131072;
constexpr int LDSCTL_OFF = RING_BYTES, MISC_OFF = LDSCTL_OFF + 320;
constexpr int LDS_BYTES = 147456;
constexpr int NWAVES = 8, NTHREADS = 512;
constexpr int NPH = 8;

struct Args {
    const float* in[21]; float* out; unsigned char* ws;
    int ph_lo, ph_hi, use_bar, pad;
};

namespace pg8 {
struct EpiRowScale {
    static constexpr bool PERM = true, AFTER_DRAIN = false;
    bf16_t* O; int ldc; const float* rs; int ssmode;
    __device__ __forceinline__ void operator()(const f32x4 (&acc)[2][2][4][2], const Unit& u, int wr, int wc, int fr, int fq) const {
        const int row0 = u.pm * BM + wr * 64 + fr, col0 = u.pn * BM + wc * 32 + 8 * fq;
#pragma unroll
        for (int ai = 0; ai < 2; ++ai)
#pragma unroll
            for (int m = 0; m < 4; ++m) { const int row = row0 + ai * HALF + m * 16; float s;
                if (ssmode) { const f32x4* pp = (const f32x4*)(rs + (size_t)row * 16); const f32x4 p0 = pp[0], p1 = pp[1], p2 = pp[2], p3 = pp[3];
                    s = rsqrtf((((p0.x + p0.y) + (p0.z + p0.w)) + ((p1.x + p1.y) + (p1.z + p1.w)) + ((p2.x + p2.y) + (p2.z + p2.w)) + ((p3.x + p3.y) + (p3.z + p3.w))) * (1.f / D) + EPS); }
                else s = rs[row]; bf16_t* rowp = O + (size_t)row * ldc + col0;
#pragma unroll
                for (int bj = 0; bj < 2; ++bj) { const f32x4 v0 = acc[ai][bj][m][0] * s, v1 = acc[ai][bj][m][1] * s;
                    u32x4 w; w.x = cvt_pk_bf16(v0[0], v0[1]); w.y = cvt_pk_bf16(v0[2], v0[3]); w.z = cvt_pk_bf16(v1[0], v1[1]); w.w = cvt_pk_bf16(v1[2], v1[3]);
                    *(u32x4*)(rowp + bj * HALF) = w; } }
    }
};
}

__device__ __forceinline__ int win_dst_row(int layer, int n, float& sc) {
    sc = 1.f;
    if (layer == 0) {
        if (n < 512) { sc = 0.08838834764831845f; return GLA_CQ + n; }
        if (n < 1024) return GLA_CK + (n - 512);
        if (n < 1792) return GLA_CV + (n - 1024);
        if (n < 2560) return GLA_CG + (n - 1792);
        if (n < 2576) return GLA_CR + (n - 2560);
        return GLA_CMQ + (n - 2576);
    } else {
        if (n < 768) return HG_CQ + n;
        if (n < 1536) return HG_CF + (n - 768);
        if (n < 2304) return HG_CV + (n - 1536);
        if (n < 3072) return HG_CG + (n - 2304);
        return HG_CMQ + (n - 3072);
    }
}
__device__ __forceinline__ void row_to_bf16(const float* xrow, bf16* orow, float* rinv, int lane) {
    const GAS f32x4* xr = (const GAS f32x4*)xrow + lane;
    f32x4 v[4]; float s = 0.f;
#pragma unroll
    for (int j = 0; j < 4; ++j) { v[j] = xr[64 * j]; s += (v[j].x * v[j].x + v[j].y * v[j].y) + (v[j].z * v[j].z + v[j].w * v[j].w); }
    s = wave_sum(s);
    GAS unsigned long long* o8 = (GAS unsigned long long*)orow + lane;
#pragma unroll
    for (int j = 0; j < 4; ++j) o8[64 * j] = (unsigned long long)pk2(v[j].x, v[j].y) | ((unsigned long long)pk2(v[j].z, v[j].w) << 32);
    if (lane == 0) *rinv = rsqrtf(s * (1.f / D) + EPS);
}
struct P0Item { const float* W; const float* gain; bf16* WT; int K, N, mode, item; };
__device__ __forceinline__ P0Item p0_decode(const Args& a, int layer, int r) {
    unsigned char* wb = layer == 0 ? a.ws + WS_W0 : (unsigned char*)a.out;
    const int NIN = layer == 0 ? GLA_IN : HG_IN;
    const int I_IN = 16 * ((NIN + 31) / 32), I_OUT = 16 * 32, I_KV = 16 * 16, I_UP = 16 * 16 * 16;
    P0Item it;
    if (r < I_IN) { it.W = layer == 0 ? a.in[6] : a.in[10]; it.gain = a.in[2] + layer * D; it.WT = (bf16*)(wb + REL_WIN); it.K = D; it.N = NIN; it.mode = 1; it.item = r; return it; } r -= I_IN;
    if (r < I_OUT) { it.W = a.in[14] + (size_t)layer * D * D; it.gain = nullptr; it.WT = (bf16*)(wb + REL_WOUT); it.K = D; it.N = D; it.mode = 0; it.item = r; return it; } r -= I_OUT;
    if (r < I_KV) { it.W = a.in[13] + (size_t)layer * D * 512; it.gain = a.in[4] + layer * D; it.WT = (bf16*)(wb + REL_WKV); it.K = D; it.N = 512; it.mode = 0; it.item = r; return it; } r -= I_KV;
    if (r < I_UP) { const int e = r / 256; it.W = a.in[19] + ((size_t)layer * NE + e) * D * 512; it.gain = a.in[3] + layer * D; it.WT = (bf16*)(wb + REL_WUP) + (size_t)e * 512 * D; it.K = D; it.N = 512; it.mode = 2; it.item = r % 256; return it; } r -= I_UP;
    { const int e = r / 128; it.W = a.in[20] + ((size_t)layer * NE + e) * FF * D; it.gain = nullptr; it.WT = (bf16*)(wb + REL_WDN) + (size_t)e * D * FF; it.K = FF; it.N = D; it.mode = 0; it.item = r % 128; return it; }
}
__device__ __forceinline__ int p0_nitems(int layer) { const int NIN = layer == 0 ? GLA_IN : HG_IN; return 16 * ((NIN + 31) / 32) + 16 * 32 + 16 * 16 + 16 * 16 * 16 + 16 * 4 * 32; }
__device__ __forceinline__ void p0_load(const P0Item& it, int lane, f32x4 (&v)[8]) {
    const int nblk = (it.N + 31) / 32, kb = it.item / nblk, nb = it.item % nblk, k0 = 64 * kb, n0 = 32 * nb, nn = lane & 7, kq = lane >> 3;
#pragma unroll
    for (int i = 0; i < 8; ++i) { const int kk = 8 * i + kq, n = n0 + 4 * nn; v[i] = (f32x4){0.f, 0.f, 0.f, 0.f};
        if (n < it.N) v[i] = *(const GAS f32x4*)(it.W + (size_t)(k0 + kk) * it.N + n);
        if (it.gain) v[i] = v[i] * it.gain[k0 + kk]; }
}
__device__ __forceinline__ void p0_store(const P0Item& it, int layer, int lane, const f32x4 (&v)[8], LAS float* scr) {
    const int nblk = (it.N + 31) / 32, kb = it.item / nblk, nb = it.item % nblk, k0 = 64 * kb, n0 = 32 * nb, nn = lane & 7, kq = lane >> 3;
#pragma unroll
    for (int i = 0; i < 8; ++i) { const int kk = 8 * i + kq;
        scr[(4 * nn + 0) * 65 + kk] = v[i].x; scr[(4 * nn + 1) * 65 + kk] = v[i].y; scr[(4 * nn + 2) * 65 + kk] = v[i].z; scr[(4 * nn + 3) * 65 + kk] = v[i].w; }
    LDS_WAIT(); asm volatile("" ::: "memory");
    const int c = lane & 7;
#pragma unroll
    for (int j = 0; j < 4; ++j) {
        const int nl = (lane >> 3) + 8 * j, n = n0 + nl;
        float sc = 1.f; int dr = n;
        if (it.mode == 1) dr = win_dst_row(layer, n, sc);
        if (it.mode == 2) { const int f = n & 255, isb = n >> 8; dr = (f >> 7) * 256 + isb * 128 + (f & 127); }
        const LAS float* s = scr + nl * 65 + 8 * c;
        v4u o; o.x = pk2(s[0] * sc, s[1] * sc); o.y = pk2(s[2] * sc, s[3] * sc); o.z = pk2(s[4] * sc, s[5] * sc); o.w = pk2(s[6] * sc, s[7] * sc);
        if (n < it.N) *(GAS v4u*)(it.WT + (size_t)dr * it.K + k0 + 8 * c) = o;
    }
    LDS_WAIT(); asm volatile("" ::: "memory");
}
__device__ __forceinline__ void p0_prologue(const Args& a, LAS unsigned char* lds, int gw, int NGW, int wave, int lane) {
    unsigned char* ws = a.ws;
    LAS float* scr = (LAS float*)(lds + wave * 8448);
    for (int m = gw; m < M; m += NGW) row_to_bf16(a.in[0] + (size_t)m * D, (bf16*)(ws + WS_HBF) + (size_t)m * D, (float*)(ws + WS_RINV) + m, lane);
    for (int m = gw; m < MROWS; m += NGW) row_to_bf16(a.in[1] + (size_t)m * D, (bf16*)(ws + WS_MEMBF) + (size_t)m * D, (float*)(ws + WS_RINVM) + m, lane);
    const int n0 = p0_nitems(0), ntot = n0 + p0_nitems(1);
    int it = gw;
    if (it < ntot) {
        f32x4 va[8], vb[8];
        P0Item ca = p0_decode(a, it < n0 ? 0 : 1, it < n0 ? it : it - n0); int la = it < n0 ? 0 : 1;
        p0_load(ca, lane, va);
        for (;;) {
            const int itb = it + NGW; const bool hb = itb < ntot; P0Item cb = ca; int lb = la;
            if (hb) { lb = itb < n0 ? 0 : 1; cb = p0_decode(a, lb, itb < n0 ? itb : itb - n0); p0_load(cb, lane, vb); }
            p0_store(ca, la, lane, va, scr);
            if (!hb) break;
            const int itc = itb + NGW; const bool hc = itc < ntot;
            if (hc) { la = itc < n0 ? 0 : 1; ca = p0_decode(a, la, itc < n0 ? itc : itc - n0); p0_load(ca, lane, va); }
            p0_store(cb, lb, lane, vb, scr);
            if (!hc) break;
            it = itc;
        }
    }
}
template <int MIX> struct MixCfg;
template <> struct MixCfg<0> { static constexpr int H = GLA_H, DV = GLA_DV, LDP = GLA_LDP, CQ = GLA_CQ, CK = GLA_CK, CV = GLA_CV, CG = GLA_CG, CMQ = GLA_CMQ, VSTR = 416; };
template <> struct MixCfg<1> { static constexpr int H = HG_H, DV = HG_DV, LDP = HG_LDP, CQ = HG_CQ, CK = HG_CF, CV = HG_CV, CG = HG_CG, CMQ = HG_CMQ, VSTR = 288; };
constexpr int ISTR = 288;
constexpr int MX_G = 0, MX_T = 32768, MX_BL = 34816, MX_WG = 35328, MX_PREP_END = 43520;
constexpr int MXA_KD = 43520, MXA_V = 61952;
constexpr int MXB_ST = 0, MXB_QD = 55296, MXB_KD = 73728, MXB_V = 92160, MXB_RS = 118784;

__device__ __forceinline__ bf16x8 ld_row8(LAS unsigned char* base, int row, int col, int stride) { return *(const LAS bf16x8*)(base + row * stride + col * 2); }
__device__ __forceinline__ s16x4 ld_tr4(LAS unsigned char* p) { return __builtin_amdgcn_ds_read_tr16_b64_v4i16((LAS s16x4*)p); }
__device__ __forceinline__ bf16x8 ld_trfrag(LAS unsigned char* base, int row0, int col0, int stride, int lane) {
    const int g = lane >> 4, q = (lane & 15) >> 2, p = lane & 3;
    LAS unsigned char* a = base + (row0 + 4 * g + q) * stride + (col0 + 4 * p) * 2;
    const s16x4 lo = ld_tr4(a), hi = ld_tr4(a + 16 * stride);
    return __builtin_shufflevector(lo, hi, 0, 1, 2, 3, 4, 5, 6, 7);
}
__device__ __forceinline__ void unpack8(const v4u w, float (&f)[8]) {
    f[0] = __uint_as_float(w.x << 16); f[1] = __uint_as_float(w.x & 0xffff0000u); f[2] = __uint_as_float(w.y << 16); f[3] = __uint_as_float(w.y & 0xffff0000u);
    f[4] = __uint_as_float(w.z << 16); f[5] = __uint_as_float(w.z & 0xffff0000u); f[6] = __uint_as_float(w.w << 16); f[7] = __uint_as_float(w.w & 0xffff0000u);
}
__device__ __forceinline__ v4u pack8(const float (&f)[8]) { v4u w; w.x = pk2(f[0], f[1]); w.y = pk2(f[2], f[3]); w.z = pk2(f[4], f[5]); w.w = pk2(f[6], f[7]); return w; }

template <int MIX>
__device__ __forceinline__ void mixer_gates(const Args& a, const bf16* proj, LAS unsigned char* lds, int tid, int h, size_t tok0, float (&kx)[2][8]) {
    typedef MixCfg<MIX> C;
    const int co = tid & 15, tg = tid >> 4;
    LAS float* G = (LAS float*)(lds + MX_G); LAS float* T = (LAS float*)(lds + MX_T); LAS float* BL = (LAS float*)(lds + MX_BL);
    float gv[2][8];
    if (MIX == 0) {
        LAS float* WG = (LAS float*)(lds + MX_WG);
        { const int r = tid >> 5, c4 = (tid & 31) * 4; *(LAS f32x4*)(WG + r * 128 + c4) = *(const GAS f32x4*)(a.in[7] + r * GLA_KW + h * 128 + c4); }
        float rr[2][16];
#pragma unroll
        for (int s = 0; s < 2; ++s) {
            const bf16* rowp = proj + (tok0 + 2 * tg + s) * C::LDP;
            const v4u kw = *(const GAS v4u*)(rowp + C::CK + h * 128 + 8 * co); unpack8(kw, kx[s]);
            const v4u r0 = *(const GAS v4u*)(rowp + GLA_CR), r1 = *(const GAS v4u*)(rowp + GLA_CR + 8);
            float t0[8], t1[8]; unpack8(r0, t0); unpack8(r1, t1);
#pragma unroll
            for (int e = 0; e < 8; ++e) { rr[s][e] = t0[e]; rr[s][8 + e] = t1[e]; }
        }
        float bgv[8];
        { const f32x4 b0 = *(const GAS f32x4*)(a.in[8] + h * 128 + 8 * co), b1 = *(const GAS f32x4*)(a.in[8] + h * 128 + 8 * co + 4);
          bgv[0] = b0.x; bgv[1] = b0.y; bgv[2] = b0.z; bgv[3] = b0.w; bgv[4] = b1.x; bgv[5] = b1.y; bgv[6] = b1.z; bgv[7] = b1.w; }
        __syncthreads();
#pragma unroll
        for (int s = 0; s < 2; ++s)
#pragma unroll
            for (int e = 0; e < 8; ++e) gv[s][e] = bgv[e];
#pragma unroll
        for (int r = 0; r < 16; ++r) {
            const f32x4 w0 = *(const LAS f32x4*)(WG + r * 128 + 8 * co), w1 = *(const LAS f32x4*)(WG + r * 128 + 8 * co + 4);
            const float wv[8] = {w0.x, w0.y, w0.z, w0.w, w1.x, w1.y, w1.z, w1.w};
#pragma unroll
            for (int s = 0; s < 2; ++s)
#pragma unroll
                for (int e = 0; e < 8; ++e) gv[s][e] = fmaf(rr[s][r], wv[e], gv[s][e]);
        }
#pragma unroll
        for (int s = 0; s < 2; ++s)
#pragma unroll
            for (int e = 0; e < 8; ++e) { const float xg = gv[s][e]; gv[s][e] = (fminf(xg, 0.f) - __logf(1.f + __expf(-fabsf(xg)))) * (1.f / 16.f); }
    } else {
        float oml[8];
#pragma unroll
        for (int e = 0; e < 8; ++e) { const int c = h * 128 + 8 * co + e; const float dlt = a.in[11][MIXW + c] - a.in[11][c]; oml[e] = 1.f - __builtin_amdgcn_rcpf(1.f + __expf(-dlt)); }
#pragma unroll
        for (int s = 0; s < 2; ++s) {
            const bf16* rowp = proj + (tok0 + 2 * tg + s) * C::LDP;
            const v4u zw = *(const GAS v4u*)(rowp + C::CK + h * 128 + 8 * co); float z[8]; unpack8(zw, z);
#pragma unroll
            for (int e = 0; e < 8; ++e) { const float omf = oml[e] * __builtin_amdgcn_rcpf(1.f + __expf(z[e])); kx[s][e] = omf; gv[s][e] = __logf(1.f - omf); }
        }
    }
#pragma unroll
    for (int s = 0; s < 2; ++s) {
        LAS float* gp = G + (2 * tg + s) * 128 + 8 * co;
        *(LAS f32x4*)gp = (f32x4){gv[s][0], gv[s][1], gv[s][2], gv[s][3]}; *(LAS f32x4*)(gp + 4) = (f32x4){gv[s][4], gv[s][5], gv[s][6], gv[s][7]};
    }
    __syncthreads();
    {
        const int kk = tid & 127, seg = tid >> 7;
        float c[16]; float run = 0.f;
#pragma unroll
        for (int i = 0; i < 16; ++i) { run += G[(16 * seg + i) * 128 + kk]; c[i] = run; }
        T[seg * 128 + kk] = run;
        __syncthreads();
        float offs = 0.f, tot = 0.f;
#pragma unroll
        for (int s = 0; s < 4; ++s) { const float ts = T[s * 128 + kk]; tot += ts; if (s < seg) offs += ts; }
#pragma unroll
        for (int i = 0; i < 16; ++i) G[(16 * seg + i) * 128 + kk] = c[i] + offs;
        if (seg == 0) BL[kk] = tot;
    }
    __syncthreads();
}

template <int MIX>
__device__ __forceinline__ void mixer_phase_a(const Args& a, LAS unsigned char* lds, int vcu, int G_) {
    typedef MixCfg<MIX> C;
    int tid = threadIdx.x; asm volatile("" : "+v"(tid));
    const int lane = tid & 63, wave = __builtin_amdgcn_readfirstlane(tid >> 6);
    const bf16* proj = (const bf16*)(a.ws + WS_PROJ);
    constexpr int NIT = BATCH * C::H * NCH, NDT = C::DV / 16, VCH = C::DV / 8;
    for (int item = vcu; item < NIT; item += G_) {
        const int c = item % NCH, h = (item / NCH) % C::H, b = item / (NCH * C::H);
        const size_t tok0 = (size_t)b * SEQ + (size_t)c * CH;
#pragma unroll
        for (int i = 0; i < VCH * 64 / NTHREADS; ++i) { const int id = tid + NTHREADS * i, j = id / VCH, cv = id % VCH;
            *(LAS v4u*)(lds + MXA_V + j * C::VSTR + cv * 16) = *(const GAS v4u*)(proj + (tok0 + j) * C::LDP + C::CV + h * C::DV + 8 * cv); }
        float kx[2][8];
        mixer_gates<MIX>(a, proj, lds, tid, h, tok0, kx);
        {
            const int co = tid & 15, tg = tid >> 4;
            const LAS float* G = (const LAS float*)(lds + MX_G); const LAS float* BL = (const LAS float*)(lds + MX_BL);
            const f32x4 l0 = *(const LAS f32x4*)(BL + 8 * co), l1 = *(const LAS f32x4*)(BL + 8 * co + 4);
            const float bl[8] = {l0.x, l0.y, l0.z, l0.w, l1.x, l1.y, l1.z, l1.w};
#pragma unroll
            for (int s = 0; s < 2; ++s) { const int j = 2 * tg + s;
                const f32x4 b0 = *(const LAS f32x4*)(G + j * 128 + 8 * co), b1 = *(const LAS f32x4*)(G + j * 128 + 8 * co + 4);
                const float bb[8] = {b0.x, b0.y, b0.z, b0.w, b1.x, b1.y, b1.z, b1.w}; float o[8];
#pragma unroll
                for (int e = 0; e < 8; ++e) o[e] = kx[s][e] * __expf(bl[e] - bb[e]);
                *(LAS v4u*)(lds + MXA_KD + j * ISTR + 16 * co) = pack8(o); }
            if (tid < 128) ((float*)(a.ws + WS_DECAY))[(size_t)item * 128 + tid] = __expf(BL[tid]);
        }
        __syncthreads();
        f32x4 acc[NDT];
#pragma unroll
        for (int d = 0; d < NDT; ++d) acc[d] = (f32x4){0.f, 0.f, 0.f, 0.f};
#pragma unroll
        for (int ks = 0; ks < 2; ++ks) {
            const bf16x8 bfrag = ld_trfrag(lds + MXA_KD, 32 * ks, 16 * wave, ISTR, lane);
#pragma unroll
            for (int d = 0; d < NDT; ++d) { const bf16x8 afrag = ld_trfrag(lds + MXA_V, 32 * ks, 16 * d, C::VSTR, lane);
                acc[d] = __builtin_amdgcn_mfma_f32_16x16x32_bf16(afrag, bfrag, acc[d], 0, 0, 0); }
        }
        __syncthreads();
        {   const int g = lane >> 4, kk = 16 * wave + (lane & 15);
#pragma unroll
            for (int d = 0; d < NDT; ++d)
#pragma unroll
                for (int r = 0; r < 4; ++r) *(LAS bf16*)(lds + (16 * d + 4 * g + r) * 256 + kk * 2) = f2bf(acc[d][r]); }
        __syncthreads();
        {   bf16* st = (bf16*)(a.ws + WS_STATE) + (size_t)item * C::DV * 128;
#pragma unroll
            for (int i = 0; i < C::DV * 256 / 16 / NTHREADS; ++i) { const int id = tid + NTHREADS * i; *(GAS v4u*)(st + id * 8) = *(const LAS v4u*)(lds + id * 16); } }
        __syncthreads();
    }
}

template <int MIX>
__device__ __forceinline__ void mixer_scan(const Args& a, int vcu, int G_) {
    typedef MixCfg<MIX> C;
    int tid = threadIdx.x; asm volatile("" : "+v"(tid));
    constexpr int EPB = C::DV * 128 / 4;
    constexpr int NTASK = BATCH * C::H * EPB;
    const float* dec = (const float*)(a.ws + WS_DECAY);
    for (int task = vcu * NTHREADS + tid; task < NTASK; task += G_ * NTHREADS) {
        const int bh = task / EPB, e4 = task % EPB, kk = (4 * e4) & 127;
        v2u* sp = (v2u*)(a.ws + WS_STATE) + (size_t)bh * NCH * EPB + e4;
        const float* dp = dec + (size_t)bh * NCH * 128 + kk;
        float s0 = 0.f, s1 = 0.f, s2 = 0.f, s3 = 0.f;
#pragma unroll 16
        for (int c = 0; c < NCH; ++c) {
            const v2u lw = *(const GAS v2u*)(sp + (size_t)c * EPB);
            const f32x4 d = *(const GAS f32x4*)(dp + c * 128);
            v2u o; o.x = pk2(s0, s1); o.y = pk2(s2, s3);
            *(GAS v2u*)(sp + (size_t)c * EPB) = o;
            s0 = fmaf(s0, d.x, __uint_as_float(lw.x << 16)); s1 = fmaf(s1, d.y, __uint_as_float(lw.x & 0xffff0000u));
            s2 = fmaf(s2, d.z, __uint_as_float(lw.y << 16)); s3 = fmaf(s3, d.w, __uint_as_float(lw.y & 0xffff0000u));
        }
    }
}

template <int MIX>
__device__ __forceinline__ void mixer_phase_b(const Args& a, LAS unsigned char* lds, int vcu, int G_) {
    typedef MixCfg<MIX> C;
    int tid = threadIdx.x; asm volatile("" : "+v"(tid));
    const int lane = tid & 63, wave = __builtin_amdgcn_readfirstlane(tid >> 6);
    bf16* proj = (bf16*)(a.ws + WS_PROJ);
    constexpr int NIT = BATCH * C::H * NCH, NDT = C::DV / 16, NDH = NDT / 2, VCH = C::DV / 8, SCH = C::DV * 16 / NTHREADS;
    const float* onorm = MIX == 0 ? a.in[9] : a.in[12];
    for (int item = vcu; item < NIT; item += G_) {
        const int c = item % NCH, h = (item / NCH) % C::H, b = item / (NCH * C::H);
        const size_t tok0 = (size_t)b * SEQ + (size_t)c * CH;
        const int co = tid & 15, tg = tid >> 4;
        v4u sreg[SCH];
        { const bf16* st = (const bf16*)(a.ws + WS_STATE) + (size_t)item * C::DV * 128;
#pragma unroll
          for (int i = 0; i < SCH; ++i) sreg[i] = *(const GAS v4u*)(st + (tid + NTHREADS * i) * 8); }
#pragma unroll
        for (int i = 0; i < VCH * 64 / NTHREADS; ++i) { const int id = tid + NTHREADS * i, j = id / VCH, cv = id % VCH;
            *(LAS v4u*)(lds + MXB_V + j * C::VSTR + cv * 16) = *(const GAS v4u*)(proj + (tok0 + j) * C::LDP + C::CV + h * C::DV + 8 * cv); }
        float qx[2][8];
#pragma unroll
        for (int s = 0; s < 2; ++s) { const v4u qw = *(const GAS v4u*)(proj + (tok0 + 2 * tg + s) * C::LDP + C::CQ + h * 128 + 8 * co); unpack8(qw, qx[s]);
            if (MIX == 1) {
#pragma unroll
                for (int e = 0; e < 8; ++e) qx[s][e] = qx[s][e] * __builtin_amdgcn_rcpf(1.f + __expf(-qx[s][e])); } }
        float kx[2][8];
        mixer_gates<MIX>(a, proj, lds, tid, h, tok0, kx);
        {
            const LAS float* G = (const LAS float*)(lds + MX_G);
            float bb[2][8];
#pragma unroll
            for (int s = 0; s < 2; ++s) { const int j = 2 * tg + s;
                const f32x4 b0 = *(const LAS f32x4*)(G + j * 128 + 8 * co), b1 = *(const LAS f32x4*)(G + j * 128 + 8 * co + 4);
                bb[s][0] = b0.x; bb[s][1] = b0.y; bb[s][2] = b0.z; bb[s][3] = b0.w; bb[s][4] = b1.x; bb[s][5] = b1.y; bb[s][6] = b1.z; bb[s][7] = b1.w; }
            __syncthreads();
#pragma unroll
            for (int s = 0; s < 2; ++s) { const int j = 2 * tg + s; float oq[8], ok[8];
#pragma unroll
                for (int e = 0; e < 8; ++e) { const float ex = __expf(bb[s][e]); oq[e] = qx[s][e] * ex; ok[e] = kx[s][e] * __builtin_amdgcn_rcpf(ex); }
                *(LAS v4u*)(lds + MXB_QD + j * ISTR + 16 * co) = pack8(oq); *(LAS v4u*)(lds + MXB_KD + j * ISTR + 16 * co) = pack8(ok); }
#pragma unroll
            for (int i = 0; i < SCH; ++i) { const int id = tid + NTHREADS * i, row = id >> 4, ch = id & 15; *(LAS v4u*)(lds + MXB_ST + row * ISTR + ch * 16) = sreg[i]; }
        }
        __syncthreads();
        const int it = wave & 3, dh = wave >> 2, g = lane >> 4, li = lane & 15;
        bf16x8 qf[4];
#pragma unroll
        for (int ks = 0; ks < 4; ++ks) qf[ks] = ld_row8(lds + MXB_QD, 16 * it + li, 32 * ks + 8 * g, ISTR);
        f32x4 X[4];
#pragma unroll
        for (int jt = 0; jt < 4; ++jt) { X[jt] = (f32x4){0.f, 0.f, 0.f, 0.f};
            if (jt <= it) {
#pragma unroll
                for (int ks = 0; ks < 4; ++ks) { const bf16x8 kf = ld_row8(lds + MXB_KD, 16 * jt + li, 32 * ks + 8 * g, ISTR);
                    X[jt] = __builtin_amdgcn_mfma_f32_16x16x32_bf16(kf, qf[ks], X[jt], 0, 0, 0); }
                if (jt == it) {
#pragma unroll
                    for (int r = 0; r < 4; ++r) if (4 * g + r > li) X[jt][r] = 0.f; } } }
        bf16x8 pf[2];
#pragma unroll
        for (int k2 = 0; k2 < 2; ++k2) { v4u w; w.x = pk2(X[2 * k2][0], X[2 * k2][1]); w.y = pk2(X[2 * k2][2], X[2 * k2][3]); w.z = pk2(X[2 * k2 + 1][0], X[2 * k2 + 1][1]); w.w = pk2(X[2 * k2 + 1][2], X[2 * k2 + 1][3]);
            pf[k2] = __builtin_bit_cast(bf16x8, w); }
        f32x4 acc[NDH];
        float ssq = 0.f;
#pragma unroll
        for (int d = 0; d < NDH; ++d) { const int dt = dh * NDH + d; acc[d] = (f32x4){0.f, 0.f, 0.f, 0.f};
#pragma unroll
            for (int k2 = 0; k2 < 2; ++k2) if (2 * k2 <= it) { const bf16x8 vf = ld_trfrag(lds + MXB_V, 32 * k2, 16 * dt, C::VSTR, lane);
                acc[d] = __builtin_amdgcn_mfma_f32_16x16x32_bf16(vf, pf[k2], acc[d], 0, 0, 0); }
#pragma unroll
            for (int ks = 0; ks < 4; ++ks) { const bf16x8 sf = ld_row8(lds + MXB_ST, 16 * dt + li, 32 * ks + 8 * g, ISTR);
                acc[d] = __builtin_amdgcn_mfma_f32_16x16x32_bf16(sf, qf[ks], acc[d], 0, 0, 0); }
            ssq += (acc[d][0] * acc[d][0] + acc[d][1] * acc[d][1]) + (acc[d][2] * acc[d][2] + acc[d][3] * acc[d][3]); }
        ssq += __shfl_xor(ssq, 16); ssq += __shfl_xor(ssq, 32);
        LAS float* RS = (LAS float*)(lds + MXB_RS);
        if (g == 0) RS[dh * 64 + 16 * it + li] = ssq;
        __syncthreads();
        {   const float tot = RS[16 * it + li] + RS[64 + 16 * it + li];
            const float ri = rsqrtf(tot * (1.f / C::DV) + EPS);
            bf16* rowp = proj + (tok0 + 16 * it + li) * C::LDP;
#pragma unroll
            for (int d = 0; d < NDH; ++d) { const int dv = 16 * (dh * NDH + d) + 4 * g;
                const v2u gw = *(const GAS v2u*)(rowp + C::CG + h * C::DV + dv);
                const f32x4 gn = *(const GAS f32x4*)(onorm + dv);
                const float g0 = __uint_as_float(gw.x << 16), g1 = __uint_as_float(gw.x & 0xffff0000u), g2 = __uint_as_float(gw.y << 16), g3 = __uint_as_float(gw.y & 0xffff0000u);
                v2u o; o.x = pk2(acc[d][0] * ri * gn.x * (g0 * __builtin_amdgcn_rcpf(1.f + __expf(-g0))), acc[d][1] * ri * gn.y * (g1 * __builtin_amdgcn_rcpf(1.f + __expf(-g1))));
                o.y = pk2(acc[d][2] * ri * gn.z * (g2 * __builtin_amdgcn_rcpf(1.f + __expf(-g2))), acc[d][3] * ri * gn.w * (g3 * __builtin_amdgcn_rcpf(1.f + __expf(-g3))));
                *(GAS v2u*)(rowp + C::CV + h * C::DV + dv) = o; } }
        __syncthreads();
    }
}

constexpr int MA_STR = 160, MA_K = 0, MA_V = 40960, MA_Q = 81920;
template <int MIX>
__device__ __forceinline__ void memattn_phase(const Args& a, LAS unsigned char* lds, int vcu, int G_) {
    typedef MixCfg<MIX> C;
    int tid = threadIdx.x; asm volatile("" : "+v"(tid));
    const int lane = tid & 63, wave = __builtin_amdgcn_readfirstlane(tid >> 6), g = lane >> 4, li = lane & 15;
    bf16* proj = (bf16*)(a.ws + WS_PROJ);
    const bf16* kvm = (const bf16*)(a.ws + WS_KVMEM) + (size_t)MIX * MROWS * 512;
    constexpr int NIT = (M / 128) * 4;
    for (int item = vcu; item < NIT; item += G_) {
        const int hm = item & 3, tile = item >> 2; const size_t tok0 = (size_t)tile * 128; const int b = (int)(tok0 / SEQ);
#pragma unroll
        for (int i = 0; i < 4; ++i) { const int id = tid + NTHREADS * i, m = id >> 3, ch = id & 7;
            *(LAS v4u*)(lds + MA_K + m * MA_STR + ch * 16) = *(const GAS v4u*)(kvm + (size_t)(b * NMEM + m) * 512 + hm * 64 + 8 * ch);
            *(LAS v4u*)(lds + MA_V + m * MA_STR + ch * 16) = *(const GAS v4u*)(kvm + (size_t)(b * NMEM + m) * 512 + 256 + hm * 64 + 8 * ch); }
#pragma unroll
        for (int i = 0; i < 2; ++i) { const int id = tid + NTHREADS * i, t = id >> 3, ch = id & 7;
            *(LAS v4u*)(lds + MA_Q + t * MA_STR + ch * 16) = *(const GAS v4u*)(proj + (tok0 + t) * C::LDP + C::CMQ + hm * 64 + 8 * ch); }
        __syncthreads();
        bf16x8 qf[2];
#pragma unroll
        for (int ks = 0; ks < 2; ++ks) qf[ks] = ld_row8(lds + MA_Q, 16 * wave + li, 32 * ks + 8 * g, MA_STR);
        f32x4 X[16]; float mx = -3.0e38f;
#pragma unroll
        for (int kt = 0; kt < 16; ++kt) { X[kt] = (f32x4){0.f, 0.f, 0.f, 0.f};
#pragma unroll
            for (int ks = 0; ks < 2; ++ks) { const bf16x8 kf = ld_row8(lds + MA_K, 16 * kt + li, 32 * ks + 8 * g, MA_STR);
                X[kt] = __builtin_amdgcn_mfma_f32_16x16x32_bf16(kf, qf[ks], X[kt], 0, 0, 0); }
            mx = fmaxf(mx, fmaxf(fmaxf(X[kt][0], X[kt][1]), fmaxf(X[kt][2], X[kt][3]))); }
        mx = fmaxf(mx, __shfl_xor(mx, 16)); mx = fmaxf(mx, __shfl_xor(mx, 32));
        float sum = 0.f;
#pragma unroll
        for (int kt = 0; kt < 16; ++kt)
#pragma unroll
            for (int r = 0; r < 4; ++r) { const float p = __expf((X[kt][r] - mx) * 0.125f); X[kt][r] = p; sum += p; }
        sum += __shfl_xor(sum, 16); sum += __shfl_xor(sum, 32);
        const float inv = __builtin_amdgcn_rcpf(sum);
        f32x4 acc[4];
#pragma unroll
        for (int d = 0; d < 4; ++d) acc[d] = (f32x4){0.f, 0.f, 0.f, 0.f};
#pragma unroll
        for (int k2 = 0; k2 < 8; ++k2) {
            v4u w; w.x = pk2(X[2 * k2][0] * inv, X[2 * k2][1] * inv); w.y = pk2(X[2 * k2][2] * inv, X[2 * k2][3] * inv);
            w.z = pk2(X[2 * k2 + 1][0] * inv, X[2 * k2 + 1][1] * inv); w.w = pk2(X[2 * k2 + 1][2] * inv, X[2 * k2 + 1][3] * inv);
            const bf16x8 pf = __builtin_bit_cast(bf16x8, w);
#pragma unroll
            for (int d = 0; d < 4; ++d) { const bf16x8 vf = ld_trfrag(lds + MA_V, 32 * k2, 16 * d, MA_STR, lane);
                acc[d] = __builtin_amdgcn_mfma_f32_16x16x32_bf16(vf, pf, acc[d], 0, 0, 0); }
        }
        {   bf16* rowp = proj + (tok0 + 16 * wave + li) * C::LDP + C::CMQ + hm * 64;
#pragma unroll
            for (int d = 0; d < 4; ++d) { v2u o; o.x = pk2(acc[d][0], acc[d][1]); o.y = pk2(acc[d][2], acc[d][3]); *(GAS v2u*)(rowp + 16 * d + 4 * g) = o; } }
        __syncthreads();
    }
}

__device__ __forceinline__ void memkv_tiles(const Args& a, int vcu, int G_) {
    int tid = threadIdx.x; asm volatile("" : "+v"(tid));
    const int lane = tid & 63, wave = __builtin_amdgcn_readfirstlane(tid >> 6), g = lane >> 4, li = lane & 15, wi = wave & 3, wj = wave >> 2;
    const bf16* membf = (const bf16*)(a.ws + WS_MEMBF); const float* rinvm = (const float*)(a.ws + WS_RINVM);
    for (int t = vcu; t < 256; t += G_) {
        const int l = t >> 7, rt = (t & 127) >> 3, ct = t & 7;
        const bf16* wkv = (const bf16*)((l == 0 ? a.ws + WS_W0 : (unsigned char*)a.out) + REL_WKV);
        const int row = rt * 64 + 16 * wi + li, col0 = ct * 64 + 32 * wj;
        const bf16* ap = membf + (size_t)row * D + 8 * g;
        const bf16* bp = wkv + (size_t)(col0 + li) * D + 8 * g;
        f32x4 acc0 = {0.f, 0.f, 0.f, 0.f}, acc1 = {0.f, 0.f, 0.f, 0.f};
#pragma unroll 8
        for (int ks = 0; ks < 32; ++ks) {
            const bf16x8 af = *(const GAS bf16x8*)(ap + 32 * ks), b0 = *(const GAS bf16x8*)(bp + 32 * ks), b1 = *(const GAS bf16x8*)(bp + 16 * D + 32 * ks);
            acc0 = __builtin_amdgcn_mfma_f32_16x16x32_bf16(b0, af, acc0, 0, 0, 0);
            acc1 = __builtin_amdgcn_mfma_f32_16x16x32_bf16(b1, af, acc1, 0, 0, 0);
        }
        const float s = rinvm[row];
        bf16* op = (bf16*)(a.ws + WS_KVMEM) + (size_t)l * MROWS * 512 + (size_t)row * 512 + col0 + 4 * g;
        v2u o0, o1; o0.x = pk2(acc0[0] * s, acc0[1] * s); o0.y = pk2(acc0[2] * s, acc0[3] * s); o1.x = pk2(acc1[0] * s, acc1[1] * s); o1.y = pk2(acc1[2] * s, acc1[3] * s);
        *(GAS v2u*)op = o0; *(GAS v2u*)(op + 16) = o1;
    }
}
constexpr size_t WS_SLOT = WS_STATE;
constexpr size_t WS_HACT = WS_PROJ;
constexpr int NBK = 24;
constexpr int CW_CNT = 8192;
constexpr int TT_OFF = LDSCTL_OFF + 1024;
struct SlotRec { int token; float rinv, glo, ghi; };

namespace pg8 {
struct EpiResid {
    static constexpr bool PERM = true, AFTER_DRAIN = false;
    bf16_t* hb; int ldc;
    __device__ __forceinline__ void operator()(const f32x4 (&acc)[2][2][4][2], const Unit& u, int wr, int wc, int fr, int fq) const {
        const int row0 = u.pm * BM + wr * 64 + fr, col0 = u.pn * BM + wc * 32 + 8 * fq;
#pragma unroll
        for (int ai = 0; ai < 2; ++ai)
#pragma unroll
            for (int m = 0; m < 4; ++m) { bf16_t* rowp = hb + (size_t)(row0 + ai * HALF + m * 16) * ldc + col0;
#pragma unroll
                for (int bj = 0; bj < 2; ++bj) { const u32x4 b = *(const u32x4*)(rowp + bj * HALF); const f32x4 a0 = acc[ai][bj][m][0], a1 = acc[ai][bj][m][1];
                    u32x4 w; w.x = cvt_pk_bf16(__uint_as_float(b.x << 16) + a0[0], __uint_as_float(b.x & 0xffff0000u) + a0[1]); w.y = cvt_pk_bf16(__uint_as_float(b.y << 16) + a0[2], __uint_as_float(b.y & 0xffff0000u) + a0[3]);
                    w.z = cvt_pk_bf16(__uint_as_float(b.z << 16) + a1[0], __uint_as_float(b.z & 0xffff0000u) + a1[1]); w.w = cvt_pk_bf16(__uint_as_float(b.w << 16) + a1[2], __uint_as_float(b.w & 0xffff0000u) + a1[3]);
                    *(u32x4*)(rowp + bj * HALF) = w; }
                asm volatile("" ::: "memory"); }
    }
};
template <int mode> struct MoeOrder {
    static constexpr bool GATHER = (mode == 0);
    const PG8_LAS int* tt; int G, c; const SlotRec* slots;
    __device__ __forceinline__ bool next(int i, Unit& u) const {
        const int L = i * G + c, NT = __builtin_amdgcn_readfirstlane(tt[NBK]);
        if (L >= NT * 4) return false;
        const int rt = L >> 2; int bk = 0;
        for (int b = 1; b < NBK; ++b) if (rt >= __builtin_amdgcn_readfirstlane(tt[b])) bk = b;
        const int tb = __builtin_amdgcn_readfirstlane(tt[bk]), cn = __builtin_amdgcn_readfirstlane(tt[25 + bk]);
        u.pm = rt; u.pn = L & 3; u.x0 = bk; const int first = (rt - tb) * BM; u.x1 = min(cn - first, BM); u.x2 = bk * M + first; u.x3 = 0;
        return true;
    }
    __device__ __forceinline__ void a_ready(const Unit&) const {}
    __device__ __forceinline__ void done(const Unit&) const {}
    __device__ __forceinline__ static void experts(int bk, int& ea, int& eb) { const int g = bk / 6, p = bk % 6; const int lo = p < 3 ? 0 : (p < 5 ? 1 : 2), hi = p < 3 ? p + 1 : (p < 5 ? p - 1 : 3); ea = 4 * g + lo; eb = 4 * g + hi; }
    __device__ __forceinline__ unsigned a_off(const Gemm& g, const Unit& u, int r) const {
        const int rr = r < u.x1 ? r : u.x1 - 1; const int tok = slots[u.x2 + rr].token; return (unsigned)(tok * g.lda) * 2u;
    }
    __device__ __forceinline__ size_t b_off(const Gemm& g, const Unit& u) const {
        int ea, eb; experts(u.x0, ea, eb);
        if (mode == 0) { const int e = (u.pn < 2) ? ea : eb; return ((size_t)e * 512 + (size_t)(u.pn & 1) * 256) * D * 2; }
        return ((size_t)ea * D + (size_t)u.pn * 256) * FF * 2;
    }
    __device__ __forceinline__ long b_delta(const Gemm& g, const Unit& u) const {
        if (mode == 0) return 0;
        int ea, eb; experts(u.x0, ea, eb); return (long)(eb - ea) * D * FF * 2 - (long)FF * 2;
    }
};
struct EpiMoeUp {
    static constexpr bool PERM = true, AFTER_DRAIN = false;
    bf16_t* hact; const SlotRec* slots;
    __device__ __forceinline__ void operator()(const f32x4 (&acc)[2][2][4][2], const Unit& u, int wr, int wc, int fr, int fq) const {
        const int colo = (u.pn >> 1) * 256 + (u.pn & 1) * 128 + wc * 32 + 8 * fq;
#pragma unroll
        for (int ai = 0; ai < 2; ++ai)
#pragma unroll
            for (int m = 0; m < 4; ++m) { const int r = ai * HALF + wr * 64 + m * 16 + fr;
                { const SlotRec sr = slots[u.x2 + (r < u.x1 ? r : u.x1 - 1)]; const float ri = sr.rinv, gt = (u.pn < 2) ? sr.glo : sr.ghi; asm volatile("" ::: "memory");
                    float o[8];
#pragma unroll
                    for (int n = 0; n < 2; ++n)
#pragma unroll
                        for (int j = 0; j < 4; ++j) { const float av = acc[ai][0][m][n][j] * ri, bv = acc[ai][1][m][n][j] * ri; o[4 * n + j] = av * __builtin_amdgcn_rcpf(1.f + __expf(-av)) * bv * gt; }
                    u32x4 w; w.x = cvt_pk_bf16(o[0], o[1]); w.y = cvt_pk_bf16(o[2], o[3]); w.z = cvt_pk_bf16(o[4], o[5]); w.w = cvt_pk_bf16(o[6], o[7]);
                    *(u32x4*)(hact + (size_t)(u.pm * BM + r) * 512 + colo) = w; } }
    }
};
struct EpiMoeDown {
    static constexpr bool PERM = true, AFTER_DRAIN = false;
    bf16_t* hb; const SlotRec* slots; bf16_t* dummy; float* rowss;
    __device__ __forceinline__ void operator()(const f32x4 (&acc)[2][2][4][2], const Unit& u, int wr, int wc, int fr, int fq) const {
        const int col0 = u.pn * BM + wc * 32 + 8 * fq;
#pragma unroll
        for (int ai = 0; ai < 2; ++ai)
#pragma unroll
            for (int m = 0; m < 4; ++m) { const int r = ai * HALF + wr * 64 + m * 16 + fr;
                { const int tok = slots[u.x2 + (r < u.x1 ? r : u.x1 - 1)].token; bf16_t* rowp = (r < u.x1 ? hb + (size_t)tok * D : dummy) + col0; float ss = 0.f;
#pragma unroll
                    for (int bj = 0; bj < 2; ++bj) { const u32x4 b = *(const u32x4*)(rowp + bj * HALF); const f32x4 a0 = acc[ai][bj][m][0], a1 = acc[ai][bj][m][1];
                        u32x4 w; w.x = cvt_pk_bf16(__uint_as_float(b.x << 16) + a0[0], __uint_as_float(b.x & 0xffff0000u) + a0[1]); w.y = cvt_pk_bf16(__uint_as_float(b.y << 16) + a0[2], __uint_as_float(b.y & 0xffff0000u) + a0[3]);
                        w.z = cvt_pk_bf16(__uint_as_float(b.z << 16) + a1[0], __uint_as_float(b.z & 0xffff0000u) + a1[1]); w.w = cvt_pk_bf16(__uint_as_float(b.w << 16) + a1[2], __uint_as_float(b.w & 0xffff0000u) + a1[3]);
                        *(u32x4*)(rowp + bj * HALF) = w;
                        if (rowss) { const unsigned ww[4] = {w.x, w.y, w.z, w.w};
#pragma unroll
                            for (int e = 0; e < 4; ++e) { const float lo = __uint_as_float(ww[e] << 16), hi = __uint_as_float(ww[e] & 0xffff0000u); ss = fmaf(lo, lo, ss); ss = fmaf(hi, hi, ss); } } }
                    if (rowss) { ss += __shfl_xor(ss, 16); ss += __shfl_xor(ss, 32); if (fq == 0 && r < u.x1) rowss[(size_t)tok * 16 + u.pn * 4 + wc] = ss; } }
                asm volatile("" ::: "memory"); }
    }
};
}

__device__ __forceinline__ void route_phase(const Args& a, int layer, LAS unsigned char* lds, int gw, int NGW) {
    int tid = threadIdx.x; asm volatile("" : "+v"(tid));
    const int lane = tid & 63;
    LAS float* WR = (LAS float*)lds;
    const float* gain = a.in[3] + layer * D; const float* wg = a.in[15] + (size_t)layer * D * NG; const float* wr = a.in[17] + (size_t)layer * D * NE;
#pragma unroll
    for (int i = 0; i < 8; ++i) { const int idx = tid + NTHREADS * i, k = idx >> 2, c4 = (idx & 3) * 4; const f32x4 w = *(const GAS f32x4*)(wr + (size_t)idx * 4); const float gk = gain[k];
        WR[(4 + c4) * D + k] = w.x * gk; WR[(5 + c4) * D + k] = w.y * gk; WR[(6 + c4) * D + k] = w.z * gk; WR[(7 + c4) * D + k] = w.w * gk; }
#pragma unroll
    for (int i = 0; i < 2; ++i) { const int k = tid + NTHREADS * i; const f32x4 w = *(const GAS f32x4*)(wg + (size_t)k * 4); const float gk = gain[k];
        WR[0 * D + k] = w.x * gk; WR[1 * D + k] = w.y * gk; WR[2 * D + k] = w.z * gk; WR[3 * D + k] = w.w * gk; }
    __syncthreads();
    const bf16* hbf = (const bf16*)(a.ws + WS_HBF); SlotRec* slots = (SlotRec*)(a.ws + WS_SLOT);
    unsigned* cnt = (unsigned*)(a.ws + WS_CTL) + CW_CNT + layer * 512;
    const float* bgp = a.in[16] + layer * NG; const float* brp = a.in[18] + layer * NE;
    for (int m = gw; m < M; m += NGW) {
        LAS float* WRl = WR + 8 * lane; asm volatile("" : "+v"(WRl));
        const GAS v4u* xr = (const GAS v4u*)(hbf + (size_t)m * D) + lane;
        float v[2][8]; float s = 0.f;
#pragma unroll
        for (int j = 0; j < 2; ++j) { unpack8(xr[64 * j], v[j]);
#pragma unroll
            for (int e = 0; e < 8; ++e) s = fmaf(v[j][e], v[j][e], s); }
        float lg[20];
#pragma unroll
        for (int c = 0; c < 20; ++c) { float acc = 0.f;
#pragma unroll
            for (int j = 0; j < 2; ++j) { const f32x4 w0 = *(const LAS f32x4*)(WRl + c * D + 512 * j), w1 = *(const LAS f32x4*)(WRl + c * D + 512 * j + 4);
                acc += (v[j][0] * w0.x + v[j][1] * w0.y) + (v[j][2] * w0.z + v[j][3] * w0.w) + (v[j][4] * w1.x + v[j][5] * w1.y) + (v[j][6] * w1.z + v[j][7] * w1.w); }
            lg[c] = acc; }
        s = wave_sum(s);
#pragma unroll
        for (int c = 0; c < 20; ++c) lg[c] = wave_sum(lg[c]);
        const float ri = rsqrtf(s * (1.f / D) + EPS);
#pragma unroll
        for (int c = 0; c < 4; ++c) lg[c] = lg[c] * ri + bgp[c];
#pragma unroll
        for (int c = 0; c < 16; ++c) lg[4 + c] = lg[4 + c] * ri + brp[c];
        int gi = 0; float gm = lg[0];
#pragma unroll
        for (int c = 1; c < 4; ++c) if (lg[c] > gm) { gm = lg[c]; gi = c; }
        float gs = 0.f;
#pragma unroll
        for (int c = 0; c < 4; ++c) gs += __expf(lg[c] - gm);
        const float gwt = 1.f / gs;
        float e[4];
#pragma unroll
        for (int c = 0; c < 4; ++c) e[c] = gi == 0 ? lg[4 + c] : (gi == 1 ? lg[8 + c] : (gi == 2 ? lg[12 + c] : lg[16 + c]));
        int i0 = 0;
#pragma unroll
        for (int c = 1; c < 4; ++c) if (e[c] > e[i0 == 0 ? 0 : (i0 == 1 ? 1 : (i0 == 2 ? 2 : 3))]) i0 = c;
        float e0 = i0 == 0 ? e[0] : (i0 == 1 ? e[1] : (i0 == 2 ? e[2] : e[3]));
        int i1 = -1; float e1 = -3.0e38f;
#pragma unroll
        for (int c = 0; c < 4; ++c) if (c != i0 && e[c] > e1) { e1 = e[c]; i1 = c; }
        const float p1 = __expf(e1 - e0), den = 1.f / (1.f + p1);
        const float w0 = gwt * den, w1 = gwt * p1 * den;
        const int lo = i0 < i1 ? i0 : i1, hi = i0 < i1 ? i1 : i0;
        const int pr = lo == 0 ? hi - 1 : (lo == 1 ? hi + 1 : 5);
        const int bk = gi * 6 + pr;
        if (lane == 0) {
            const unsigned pos = __hip_atomic_fetch_add(cnt + bk * 16, 1u, __ATOMIC_RELAXED, __HIP_MEMORY_SCOPE_AGENT);
            SlotRec sr; sr.token = m; sr.rinv = ri; sr.glo = i0 < i1 ? w0 : w1; sr.ghi = i0 < i1 ? w1 : w0;
            slots[(size_t)bk * M + pos] = sr;
        }
    }
}
__device__ __forceinline__ void moe_tile_table(const Args& a, int layer, LAS unsigned char* lds) {
    LAS int* tt = (LAS int*)(lds + TT_OFF);
    if (threadIdx.x == 0) {
        const unsigned* cnt = (const unsigned*)(a.ws + WS_CTL) + CW_CNT + layer * 512;
        int acc = 0;
        for (int b = 0; b < NBK; ++b) { const int c = (int)__hip_atomic_load(cnt + b * 16, __ATOMIC_RELAXED, __HIP_MEMORY_SCOPE_AGENT); tt[b] = acc; tt[25 + b] = c; acc += (c + 255) >> 8; }
        tt[NBK] = acc;
    }
    __syncthreads();
}
__device__ __forceinline__ void final_norm_phase(const Args& a, int gw, int NGW) {
    int tid = threadIdx.x; asm volatile("" : "+v"(tid));
    const int lane = tid & 63;
    const float* gain = a.in[5]; const bf16* hbf = (const bf16*)(a.ws + WS_HBF);
    for (int m = gw; m < M; m += NGW) {
        const GAS v4u* xr = (const GAS v4u*)(hbf + (size_t)m * D) + lane;
        float v[2][8]; float s = 0.f;
#pragma unroll
        for (int j = 0; j < 2; ++j) { unpack8(xr[64 * j], v[j]);
#pragma unroll
            for (int e = 0; e < 8; ++e) s = fmaf(v[j][e], v[j][e], s); }
        s = wave_sum(s);
        const float ri = rsqrtf(s * (1.f / D) + EPS);
        GAS f32x4* orow = (GAS f32x4*)(a.out + (size_t)m * D) + 2 * lane;
#pragma unroll
        for (int j = 0; j < 2; ++j) { const GAS f32x4* gp = (const GAS f32x4*)gain + 2 * lane + 128 * j;
            const f32x4 g0 = gp[0], g1 = gp[1];
            orow[128 * j] = (f32x4){v[j][0] * ri * g0.x, v[j][1] * ri * g0.y, v[j][2] * ri * g0.z, v[j][3] * ri * g0.w};
            orow[128 * j + 1] = (f32x4){v[j][4] * ri * g1.x, v[j][5] * ri * g1.y, v[j][6] * ri * g1.z, v[j][7] * ri * g1.w}; }
    }
}
__global__ void __launch_bounds__(NTHREADS, 2) fwd(Args args) {
    extern __shared__ __attribute__((aligned(16))) unsigned char lds_raw[];
    LAS unsigned char* lds = (LAS unsigned char*)lds_raw;
    const int tid = threadIdx.x, lane0 = tid & 63, wave = __builtin_amdgcn_readfirstlane(tid >> 6);
    const int G = gridDim.x; const int bx = blockIdx.x;
    const int vcu = (G % 8 == 0) ? (bx % 8) * (G / 8) + bx / 8 : bx;
    gu32* ctl = (gu32*)(args.ws + WS_CTL);
    volatile LAS unsigned* MISC = (volatile LAS unsigned*)(lds + MISC_OFF);
    for (int u = tid; u < (LDS_BYTES - LDSCTL_OFF) / 4; u += NTHREADS) ((LAS unsigned*)(lds + LDSCTL_OFF))[u] = 0u;
    __syncthreads();
    XcdBarrier bar; bar.bar = (unsigned*)(ctl + CW_BAR); bar.x = 0; bar.st = nullptr;
    if (args.use_bar) bar = xcd_barrier_post((unsigned*)(ctl + CW_BAR), MISC + 8);
    const int lo = args.ph_lo, hi = args.ph_hi;
#define IN(k) (lo <= (k) && (k) < hi)
#ifdef TIME_PHASE
#define STAMP(k) do { if (tid == 0) MISC[16 + (k)] = (unsigned)__builtin_amdgcn_s_memrealtime(); } while (0)
#else
#define STAMP(k) do { } while (0)
#endif
#define SEAM(k) do { if (IN(k) && IN((k) + 1)) xcd_barrier(bar); STAMP((k) + 1); } while (0)
    const int gw = vcu * NWAVES + wave, NGW = G * NWAVES;

    STAMP(0);
    if (IN(0)) p0_prologue(args, lds, gw, NGW, wave, lane0);
    SEAM(0);
    for (int layer = 0; layer < 2; ++layer) {
        const int pb = 1 + layer * NPH;
        int lane = lane0; asm volatile("" : "+v"(lane));
        unsigned char* ws = args.ws; asm volatile("" : "+s"(ws));
        unsigned char* wb = layer == 0 ? ws + WS_W0 : (unsigned char*)args.out;
        if (IN(pb + 0)) {
            const int ldp = layer == 0 ? GLA_LDP : HG_LDP;
            pg8::Gemm g{(const bf16*)(ws + WS_HBF), (const bf16*)(wb + REL_WIN), M, ldp, D, D, D}; pg8::StaticOrder S; S.init(M, ldp, G, bx);
            pg8::EpiRowScale E{(bf16*)(ws + WS_PROJ), ldp, layer == 0 ? (const float*)(ws + WS_RINV) : (const float*)(ws + WS_ROWSS), layer};
            pg8::gemm_phase<pg8::EpiRowScale, pg8::StaticOrder, true>(lds, g, S, E);
        }
        SEAM(pb + 0);
        if (IN(pb + 1)) { if (layer == 0) { mixer_phase_a<0>(args, lds, vcu, G); memkv_tiles(args, vcu, G); } else mixer_phase_a<1>(args, lds, vcu, G); }
        SEAM(pb + 1);
        if (IN(pb + 2)) { if (layer == 0) mixer_scan<0>(args, vcu, G); else mixer_scan<1>(args, vcu, G); }
        SEAM(pb + 2);
        if (IN(pb + 3)) { if (layer == 0) { mixer_phase_b<0>(args, lds, vcu, G); memattn_phase<0>(args, lds, vcu, G); } else { mixer_phase_b<1>(args, lds, vcu, G); memattn_phase<1>(args, lds, vcu, G); } }
        SEAM(pb + 3);
        if (IN(pb + 4)) {
            const int ldp = layer == 0 ? GLA_LDP : HG_LDP, cv = layer == 0 ? GLA_CV : HG_CV;
            pg8::Gemm g{(const bf16*)(ws + WS_PROJ) + cv, (const bf16*)(wb + REL_WOUT), M, D, D, ldp, D}; pg8::StaticOrder S; S.init(M, D, G, bx);
            pg8::EpiResid E{(bf16*)(ws + WS_HBF), D};
            pg8::gemm_phase<pg8::EpiResid, pg8::StaticOrder, true>(lds, g, S, E);
        }
        SEAM(pb + 4);
        if (IN(pb + 5)) route_phase(args, layer, lds, gw, NGW);
        SEAM(pb + 5);
        if (IN(pb + 6)) {
            moe_tile_table(args, layer, lds);
            pg8::Gemm g{(const bf16*)(ws + WS_HBF), (const bf16*)(wb + REL_WUP), M, 1024, D, D, D};
            pg8::MoeOrder<0> S{(const LAS int*)(lds + TT_OFF), G, vcu, (const SlotRec*)(ws + WS_SLOT)};
            pg8::EpiMoeUp E{(bf16*)(ws + WS_HACT), (const SlotRec*)(ws + WS_SLOT)};
            pg8::gemm_phase<pg8::EpiMoeUp, pg8::MoeOrder<0>, true>(lds, g, S, E);
        }
        SEAM(pb + 6);
        if (IN(pb + 7)) {
            moe_tile_table(args, layer, lds);
            pg8::Gemm g{(const bf16*)(ws + WS_HACT), (const bf16*)(wb + REL_WDN), M, D, 2 * FF, 2 * FF, FF};
            pg8::MoeOrder<1> S{(const LAS int*)(lds + TT_OFF), G, vcu, (const SlotRec*)(ws + WS_SLOT)};
            pg8::EpiMoeDown E{(bf16*)(ws + WS_HBF), (const SlotRec*)(ws + WS_SLOT), (bf16*)(ws + WS_DUMMY), layer == 0 ? (float*)(ws + WS_ROWSS) : nullptr};
            pg8::gemm_phase<pg8::EpiMoeDown, pg8::MoeOrder<1>, true>(lds, g, S, E);
        }
        SEAM(pb + 7);
    }
    if (IN(1 + 2 * NPH)) final_norm_phase(args, gw, NGW);
#ifdef TIME_PHASE
    STAMP(2 * NPH + 2);
    if (bx == 0 && tid == 0) { const unsigned span = (MISC[16 + TIME_PHASE_END] - MISC[16 + TIME_PHASE]) * TIME_AMP; const unsigned t0 = (unsigned)__builtin_amdgcn_s_memrealtime();
        while ((unsigned)__builtin_amdgcn_s_memrealtime() - t0 < span) __builtin_amdgcn_s_sleep(8); }
#endif
#undef IN
#undef SEAM
}
#ifndef N_LAUNCHES
#define N_LAUNCHES 1
#endif
constexpr int NPHASES = 2 * NPH + 2;
extern "C" void kernel_launch(void* const* d_in, const int* in_sizes, int n_in, void* d_out, int out_size, void* d_ws, size_t ws_size, hipStream_t stream) {
    static int grid = 0;
    if (grid == 0) {
        int dev = 0, cus = 0, per_cu = 0;
        if (n_in != 21 || out_size != M * D || ws_size < 256 * MiB) { fprintf(stderr, "kernel_launch: unexpected problem shape (n_in %d, out %d, ws %zu)\n", n_in, out_size, ws_size); grid = -1; return; }
        if (hipGetDevice(&dev) != hipSuccess || hipDeviceGetAttribute(&cus, hipDeviceAttributeMultiprocessorCount, dev) != hipSuccess) { fprintf(stderr, "kernel_launch: device query failed\n"); grid = -1; return; }
        if (hipFuncSetAttribute((const void*)fwd, hipFuncAttributeMaxDynamicSharedMemorySize, LDS_BYTES) != hipSuccess) { fprintf(stderr, "kernel_launch: hipFuncSetAttribute failed\n"); grid = -1; return; }
        if (hipOccupancyMaxActiveBlocksPerMultiprocessor(&per_cu, (const void*)fwd, NTHREADS, LDS_BYTES) != hipSuccess || per_cu < 1) { fprintf(stderr, "kernel_launch: occupancy query reports %d workgroups per CU; nothing launched\n", per_cu); (void)hipGetLastError(); grid = -1; return; }
        (void)hipGetLastError();
        grid = cus;
    }
    if (grid < 0) return;
    (void)hipMemsetAsync((char*)d_ws + WS_CTL, 0, CTL_ZERO_BYTES, stream);
    Args a{};
    for (int i = 0; i < 21; ++i) a.in[i] = (const float*)d_in[i];
    a.out = (float*)d_out; a.ws = (unsigned char*)d_ws;
    if (N_LAUNCHES == 1) { a.ph_lo = 0; a.ph_hi = NPHASES; a.use_bar = 1; hipLaunchKernelGGL(fwd, dim3(grid), dim3(NTHREADS), LDS_BYTES, stream, a); }
    else for (int p = 0; p < NPHASES; ++p) { a.ph_lo = p; a.ph_hi = p + 1; a.use_bar = 0; hipLaunchKernelGGL(fwd, dim3(grid), dim3(NTHREADS), LDS_BYTES, stream, a); }
}
```

```cpp
#include <hip/hip_runtime.h>
#include <cstdio>
#include <cstdint>

#define GAS __attribute__((address_space(1)))
#define LAS __attribute__((address_space(3)))
typedef unsigned short bf16;
typedef unsigned v4u __attribute__((ext_vector_type(4)));
typedef unsigned v2u __attribute__((ext_vector_type(2)));
typedef float f32x4 __attribute__((ext_vector_type(4)));
typedef short bf16x8 __attribute__((ext_vector_type(8)));
typedef short s16x4 __attribute__((ext_vector_type(4)));
typedef GAS unsigned gu32;
typedef GAS unsigned long long gu64;
#define RLX_AGENT __ATOMIC_RELAXED, __HIP_MEMORY_SCOPE_AGENT
#define LDS_WAIT() asm volatile("s_waitcnt lgkmcnt(0)" ::: "memory")
#define VM_WAIT() asm volatile("s_waitcnt vmcnt(0)" ::: "memory")

constexpr int D = 1024, BATCH = 4, SEQ = 4096, M = BATCH * SEQ, NMEM = 256, MROWS = BATCH * NMEM;
constexpr int MIXW = 768, MEMW = 256, CH = 64, NCH = SEQ / CH;
constexpr int GLA_H = 4, GLA_KW = 512, GLA_DK = 128, GLA_DV = 192, GLA_IN = 2832, GLA_RANK = 16;
constexpr int HG_H = 6, HG_DK = 128, HG_DV = 128, HG_IN = 3328;
constexpr int NG = 4, EPG = 4, NE = 16, FF = 256;
constexpr float EPS = 1e-6f;
constexpr int GLA_LDP = 3072, GLA_CQ = 0, GLA_CK = 512, GLA_CG = 1024, GLA_CV = 1792, GLA_CMQ = 2560, GLA_CR = 2816;
constexpr int HG_LDP = 3328, HG_CQ = 0, HG_CF = 768, HG_CG = 1536, HG_CV = 2304, HG_CMQ = 3072;

__device__ __forceinline__ float bf2f(bf16 b) { return __uint_as_float(((unsigned)b) << 16); }
__device__ __forceinline__ bf16 f2bf(float f) { return __builtin_bit_cast(unsigned short, (__bf16)f); }
__device__ __forceinline__ unsigned pk2(float lo, float hi) { return (unsigned)f2bf(lo) | ((unsigned)f2bf(hi) << 16); }
__device__ __forceinline__ float wave_sum(float v) {
#pragma unroll
    for (int o = 32; o >= 1; o >>= 1) v += __shfl_xor(v, o);
    return v;
}
__device__ __forceinline__ float wave_max(float v) {
#pragma unroll
    for (int o = 32; o >= 1; o >>= 1) v = fmaxf(v, __shfl_xor(v, o));
    return v;
}
__device__ __forceinline__ float sigmoidf_(float x) { return 1.f / (1.f + __expf(-x)); }
__device__ __forceinline__ float siluf_(float x) { return x / (1.f + __expf(-x)); }
__device__ __forceinline__ float logsigmoidf_(float x) { return fminf(x, 0.f) - log1pf(__expf(-fabsf(x))); }

#define N_LAUNCHES 1
namespace pg8 {
#define PG8_LAS __attribute__((address_space(3)))
typedef unsigned short bf16_t;
typedef short bf16x8 __attribute__((ext_vector_type(8)));
typedef float f32x4 __attribute__((ext_vector_type(4)));
typedef unsigned u32x4 __attribute__((ext_vector_type(4)));
constexpr int BM = 256, BK = 64, HALF = 128, HTB = HALF * BK * 2  , STAGE_BYTES = 8 * HTB, NXCD = 8, WGM = 8;

__host__ __device__ __forceinline__ int lds_byte(int r, int c) { const int st = (r >> 4) * 2 + (c >> 5), rr = r & 15, cc = c & 31, ob = rr * 64 + cc * 2; return st * 1024 + (ob ^ (((ob >> 9) & 1) << 5)); }
__host__ __device__ __forceinline__ void stage_rc(int b, int& R, int& C) { const int st = b / 1024, sb = b % 1024, swz = sb ^ (((sb >> 9) & 1) << 5); R = (st >> 1) * 16 + swz / 64; C = (st & 1) * 32 + (swz % 64) / 2; }
__host__ __device__ __forceinline__ int perm32(int rho) { const int n = rho >> 4, i = rho & 15; return 8 * (i >> 2) + 4 * n + (i & 3); }

struct Unit { int pm, pn; int x0, x1, x2, x3; };
struct Gemm { const bf16_t* A; const bf16_t* Bt; int M, N, K, lda, ldb; };

struct StaticOrder {
    int nM, nN, nwg, G, c;
    __host__ __device__ void init(int M, int N, int G_, int c_) { nM = M / BM; nN = N / BM; nwg = nM * nN; G = G_; c = c_; }
    __host__ __device__ bool next(int i, Unit& u) const {
        const long L = (long)i * G + c; if (L >= nwg) return false;
        int wgid = (int)L; { const int q = nwg / NXCD, r = nwg % NXCD, xcd = wgid % NXCD, off = wgid / NXCD; wgid = (xcd < r ? xcd * (q + 1) : r * (q + 1) + (xcd - r) * q) + off; }
        const int nig = WGM * nN, gid = wgid / nig, fm = gid * WGM, gsz = (nM - fm) < WGM ? (nM - fm) : WGM;
        u.pm = fm + ((wgid % nig) % gsz); u.pn = (wgid % nig) / gsz; return true;
    }
    __device__ __forceinline__ void a_ready(const Unit&) const {}
    __device__ __forceinline__ void done(const Unit&) const {}
    static constexpr bool GATHER = false;
    __device__ __forceinline__ unsigned a_off(const Gemm& g, const Unit& u, int r) const { return 0u; }
    __device__ __forceinline__ size_t b_off(const Gemm& g, const Unit& u) const { return (size_t)u.pn * BM * g.ldb * 2; }
    __device__ __forceinline__ long b_delta(const Gemm&, const Unit&) const { return 0; }
};
__device__ __forceinline__ unsigned cvt_pk_bf16(float lo, float hi) { unsigned r; asm volatile("v_cvt_pk_bf16_f32 %0, %1, %2" : "=v"(r) : "v"(lo), "v"(hi)); return r; }
template <class Epi, class Sched, bool ALIGN_EPI = false>
__device__ __forceinline__ void gemm_phase(PG8_LAS unsigned char* lds, const Gemm g, const Sched& S, const Epi& E) {
    int tid_ = threadIdx.x; asm volatile("" : "+v"(tid_));
    const int tid = tid_, wid = __builtin_amdgcn_readfirstlane(tid >> 6), lane = tid & 63, wr = wid >> 2, wc = wid & 3, fr = lane & 15, fq = lane >> 4;
    const int K = g.K, nt = K / BK;
    int Rst[2], Cst[2]; unsigned voffB[2];
#pragma unroll
    for (int i = 0; i < 2; ++i) { int R, C; stage_rc(tid * 16 + i * 8192, R, C); const int Rb = Epi::PERM ? ((R & ~31) + perm32(R & 31)) : R;
        Rst[i] = R; Cst[i] = C * 2; voffB[i] = (unsigned)(Rb * g.ldb + C) * 2u; }
    const unsigned kstep = (unsigned)(BK * 2);
    const size_t hstepB = (size_t)HALF * g.ldb * 2;
    const unsigned ldsw = (unsigned)wid * 1024u;
    const int aoff = lds_byte(wr * 64 + fr, fq * 8), boff = lds_byte(wc * 32 + fr, fq * 8);
#define PG8_SA(b, h) (((b) * 2 + (h)) * HTB)
#define PG8_SB(b, h) ((4 + (b) * 2 + (h)) * HTB)
#define PG8_STAGE_B(bufoff, gbase) do { _Pragma("unroll") for (int _i = 0; _i < 2; ++_i) \
        __builtin_amdgcn_global_load_lds((const unsigned*)((const char*)(gbase) + voffB[_i]), (PG8_LAS unsigned*)(lds + (bufoff) + ldsw + _i * 8192), 16, 0, 0); } while (0)
#define PG8_STAGE_A(bufoff, so, o0, o1) do { const char* _ab = (const char*)g.A + (so); \
        __builtin_amdgcn_global_load_lds((const unsigned*)(_ab + (o0)), (PG8_LAS unsigned*)(lds + (bufoff) + ldsw), 16, 0, 0); \
        __builtin_amdgcn_global_load_lds((const unsigned*)(_ab + (o1)), (PG8_LAS unsigned*)(lds + (bufoff) + ldsw + 8192), 16, 0, 0); } while (0)
#define PG8_LDA(dst, b, h) do { _Pragma("unroll") for (int m = 0; m < 4; ++m) _Pragma("unroll") for (int k = 0; k < 2; ++k) dst[m][k] = *(const PG8_LAS bf16x8*)(lds + PG8_SA(b, h) + aoff + m * 2048 + k * 1024); } while (0)
#define PG8_LDB(dst, b, h) do { _Pragma("unroll") for (int n = 0; n < 2; ++n) _Pragma("unroll") for (int k = 0; k < 2; ++k) dst[n][k] = *(const PG8_LAS bf16x8*)(lds + PG8_SB(b, h) + boff + n * 2048 + k * 1024); } while (0)
#define PG8_MMA(ai, bj, At, Bt) do { __builtin_amdgcn_s_setprio(1); _Pragma("unroll") for (int m = 0; m < 4; ++m) _Pragma("unroll") for (int n = 0; n < 2; ++n) _Pragma("unroll") for (int k = 0; k < 2; ++k) \
        acc[ai][bj][m][n] = __builtin_amdgcn_mfma_f32_16x16x32_bf16(Bt[n][k], At[m][k], acc[ai][bj][m][n], 0, 0, 0); __builtin_amdgcn_s_setprio(0); } while (0)
#define PG8_WAIT_V(n) asm volatile("s_waitcnt vmcnt(" #n ")" ::: "memory")
#define PG8_WAIT_L(n) asm volatile("s_waitcnt lgkmcnt(" #n ")" ::: "memory")
#define PG8_BAR __builtin_amdgcn_s_barrier()
#define PG8_SCHED __builtin_amdgcn_sched_barrier(0)
    Unit cur, nxt; int ui = 0;
    if (!S.next(0, cur)) return;
    f32x4 acc[2][2][4][2];
#pragma unroll
    for (int a = 0; a < 2; ++a)
#pragma unroll
        for (int b = 0; b < 2; ++b)
#pragma unroll
            for (int m = 0; m < 4; ++m)
#pragma unroll
                for (int n = 0; n < 2; ++n) acc[a][b][m][n] = (f32x4){0.f, 0.f, 0.f, 0.f};
    bf16x8 At[4][2], B0[2][2], B1[2][2];
    S.a_ready(cur);
    constexpr bool GA = Sched::GATHER;
    const unsigned voffA0 = (unsigned)(Rst[0] * g.lda) * 2u + Cst[0], voffA1 = (unsigned)(Rst[1] * g.lda) * 2u + Cst[1];
    const size_t hstepA = (size_t)HALF * g.lda * 2;
    unsigned vc00 = voffA0, vc01 = voffA1, vc10 = voffA0, vc11 = voffA1; size_t sc0 = 0, sc1 = 0;
    if constexpr (GA) { vc00 = S.a_off(g, cur, Rst[0]) + Cst[0]; vc01 = S.a_off(g, cur, Rst[1]) + Cst[1]; vc10 = S.a_off(g, cur, HALF + Rst[0]) + Cst[0]; vc11 = S.a_off(g, cur, HALF + Rst[1]) + Cst[1]; }
    else { sc0 = (size_t)cur.pm * 2 * hstepA; sc1 = sc0 + hstepA; }
    const char* cB = (const char*)g.Bt + S.b_off(g, cur); long cD = S.b_delta(g, cur);
    PG8_STAGE_B(PG8_SB(0, 0), cB); PG8_STAGE_B(PG8_SB(0, 1), cB + hstepB); PG8_STAGE_A(PG8_SA(0, 0), sc0, vc00, vc01); PG8_STAGE_A(PG8_SA(0, 1), sc1, vc10, vc11);
    if (wr == 1) PG8_BAR;
    PG8_WAIT_V(2); PG8_BAR;
    PG8_STAGE_B(PG8_SB(1, 0), cB + kstep); PG8_STAGE_A(PG8_SA(1, 0), sc0 + kstep, vc00, vc01); PG8_STAGE_B(PG8_SB(1, 1), cB + hstepB + kstep);
    PG8_WAIT_V(6); PG8_BAR;
    for (;;) {
        const bool has_next = S.next(ui + 1, nxt);
        unsigned vn00 = vc00, vn01 = vc01, vn10 = vc10, vn11 = vc11; size_t sn0 = sc0, sn1 = sc1; const char* nB = cB; long nD = cD;
        if (has_next) {
            if constexpr (GA) { vn00 = S.a_off(g, nxt, Rst[0]) + Cst[0]; vn01 = S.a_off(g, nxt, Rst[1]) + Cst[1]; vn10 = S.a_off(g, nxt, HALF + Rst[0]) + Cst[0]; vn11 = S.a_off(g, nxt, HALF + Rst[1]) + Cst[1]; }
            else { sn0 = (size_t)nxt.pm * 2 * hstepA; sn1 = sn0 + hstepA; }
            nB = (const char*)g.Bt + S.b_off(g, nxt); nD = S.b_delta(g, nxt); }
#pragma nounroll
        for (int t = 0; t < nt; t += 2) {
            const bool last = (t == nt - 2);
            const unsigned k1 = (unsigned)(t + 1) * kstep, k2 = (unsigned)(t + 2) * kstep;
            unsigned o00 = vc00, o01 = vc01, o10 = vc10, o11 = vc11;
            if constexpr (GA) { o00 = last ? vn00 : vc00; o01 = last ? vn01 : vc01; o10 = last ? vn10 : vc10; o11 = last ? vn11 : vc11; }
            const size_t s20 = last ? sn0 : sc0 + k2, s21 = last ? sn1 : sc1 + k2;
            const char* b2 = last ? nB : cB + k2 + ((t + 2) >= nt / 2 ? cD : 0); const char* b3 = b2 + kstep;
            if (last && has_next) S.a_ready(nxt);
            PG8_LDB(B0, 0, 0); PG8_LDB(B1, 0, 1); PG8_SCHED; PG8_LDA(At, 0, 0); PG8_STAGE_A(PG8_SA(1, 1), sc1 + k1, vc10, vc11);
            PG8_WAIT_V(8); PG8_WAIT_L(0); PG8_BAR; PG8_MMA(0, 0, At, B0); PG8_MMA(0, 1, At, B1); PG8_BAR; PG8_SCHED;
            PG8_LDA(At, 0, 1); PG8_STAGE_B(PG8_SB(0, 0), b2); PG8_STAGE_B(PG8_SB(0, 1), b2 + hstepB); PG8_STAGE_A(PG8_SA(0, 0), s20, o00, o01);
            PG8_WAIT_V(8); PG8_WAIT_L(0); PG8_BAR; PG8_MMA(1, 0, At, B0); PG8_MMA(1, 1, At, B1); PG8_BAR; PG8_SCHED;
            PG8_LDB(B0, 1, 0); PG8_LDB(B1, 1, 1); PG8_SCHED; PG8_LDA(At, 1, 0); PG8_STAGE_A(PG8_SA(0, 1), s21, o10, o11);
            PG8_WAIT_V(8); PG8_WAIT_L(0); PG8_BAR; PG8_MMA(0, 0, At, B0); PG8_MMA(0, 1, At, B1); PG8_BAR; PG8_SCHED;
            PG8_LDA(At, 1, 1); PG8_STAGE_B(PG8_SB(1, 0), b3); PG8_STAGE_B(PG8_SB(1, 1), b3 + hstepB); PG8_STAGE_A(PG8_SA(1, 0), s20 + kstep, o00, o01);
            PG8_WAIT_V(8); PG8_WAIT_L(0); PG8_BAR; PG8_MMA(1, 0, At, B0); PG8_MMA(1, 1, At, B1); PG8_BAR; PG8_SCHED;
        }
        if constexpr (ALIGN_EPI) { if (wr == 0) PG8_BAR; }
        if constexpr (!Epi::AFTER_DRAIN) { E(acc, cur, wr, wc, fr, fq); S.done(cur); }
        if (!has_next) break;
#pragma unroll
        for (int a = 0; a < 2; ++a)
#pragma unroll
            for (int b = 0; b < 2; ++b)
#pragma unroll
                for (int m = 0; m < 4; ++m)
#pragma unroll
                    for (int n = 0; n < 2; ++n) acc[a][b][m][n] = (f32x4){0.f, 0.f, 0.f, 0.f};
        cur = nxt; vc00 = vn00; vc01 = vn01; vc10 = vn10; vc11 = vn11; sc0 = sn0; sc1 = sn1; cB = nB; cD = nD; ++ui;
        if constexpr (ALIGN_EPI) { if (wr == 1) PG8_BAR; }
    }
    PG8_WAIT_V(0);
    if constexpr (!ALIGN_EPI) { if (wr == 0) PG8_BAR; }
    PG8_BAR;
    if constexpr (Epi::AFTER_DRAIN) { E.fused(acc, cur, wr, wc, fr, fq, lds, wid, lane); S.done(cur); }
#undef PG8_SA
#undef PG8_SB
#undef PG8_STAGE_A
#undef PG8_STAGE_B
#undef PG8_LDA
#undef PG8_LDB
#undef PG8_MMA
#undef PG8_WAIT_V
#undef PG8_WAIT_L
#undef PG8_BAR
#undef PG8_SCHED
}
}
#define XB_TMO      128
#define XB_XCNT(j)  (256  + 64 * (j))
#define XB_XSUB(j)  (1280 + 64 * (j))
#define XB_XGEN(j)  (2304 + 64 * (j))
#define XB_TOP      3328
#define XB_TOPGEN   3392
#define XCD_BAR_WORDS 3456
#define XB_SPIN_CAP (1u << 18)

__device__ __forceinline__ unsigned xb_ld(unsigned* p)              { return __hip_atomic_load(p, __ATOMIC_RELAXED, __HIP_MEMORY_SCOPE_AGENT); }
__device__ __forceinline__ unsigned xb_add(unsigned* p, unsigned v) { return __hip_atomic_fetch_add(p, v, __ATOMIC_RELAXED, __HIP_MEMORY_SCOPE_AGENT); }
__device__ __forceinline__ unsigned xb_xcc_id() { return (unsigned)__builtin_amdgcn_s_getreg((3 << 11) | 20) & 0xFu; }
#define XB_SPIN(cond, bar) do { unsigned _sp = 0; while (cond) { __builtin_amdgcn_s_sleep(1); \
    if ((++_sp & 255u) == 0u) { if (xb_ld(&(bar)[XB_TMO])) break; if (_sp > XB_SPIN_CAP) { atomicAdd(&(bar)[XB_TMO], 1u); break; } } } } while (0)

struct XcdBarrier {
    unsigned* bar; unsigned x;
    volatile LAS unsigned* st;
};

__device__ __forceinline__ XcdBarrier xcd_barrier_post(unsigned* bar, volatile LAS unsigned* st) {
    XcdBarrier b; b.bar = bar; b.x = xb_xcc_id(); b.st = st;
    if (threadIdx.x == 0) (void)xb_add(&bar[XB_XCNT(b.x)], 1u);
    return b;
}
__device__ __forceinline__ void xcd_barrier_complete(unsigned* bar, unsigned x, unsigned& nloc, unsigned& nx) {
    const unsigned G = gridDim.x * gridDim.y * gridDim.z;
    unsigned sum, cnt, mine, sp = 0u;
    for (;;) {
        sum = 0u; cnt = 0u; mine = 0u;
#pragma unroll
        for (unsigned j = 0; j < 16; ++j) { const unsigned c = xb_ld(&bar[XB_XCNT(j)]); sum += c; cnt += (c > 0u) ? 1u : 0u; mine = (j == x) ? c : mine; }
        if (sum == G) break;
        __builtin_amdgcn_s_sleep(1);
        if ((++sp & 255u) == 0u) { if (xb_ld(&bar[XB_TMO])) break; if (sp > XB_SPIN_CAP) { atomicAdd(&bar[XB_TMO], 1u); break; } }
    }
    nloc = mine > 0u ? mine : 1u; nx = cnt > 0u ? cnt : 1u;
}

__device__ __forceinline__ void xcd_barrier(const XcdBarrier& b) {
    asm volatile("s_waitcnt vmcnt(0)" ::: "memory");
    __syncthreads();
    if (threadIdx.x == 0) {
        unsigned* bar = b.bar;
        __builtin_amdgcn_s_waitcnt(0);
        unsigned nloc = b.st[0], nx = b.st[1];
        if (nloc == 0u) { xcd_barrier_complete(bar, b.x, nloc, nx); b.st[0] = nloc; b.st[1] = nx; }
        const unsigned old = xb_add(&bar[XB_XSUB(b.x)], 1u);
        const unsigned gen = old / nloc;
        if (old + 1u == (gen + 1u) * nloc) {
            __builtin_amdgcn_fence(__ATOMIC_RELEASE, "agent");
            asm volatile("s_waitcnt vmcnt(0)" ::: "memory");
            const unsigned og = xb_add(&bar[XB_TOP], 1u);
            const unsigned tg = og / nx;
            if (og + 1u == (tg + 1u) * nx) xb_add(&bar[XB_TOPGEN], 1u);
            else XB_SPIN(xb_ld(&bar[XB_TOPGEN]) == tg, bar);
            __builtin_amdgcn_fence(__ATOMIC_ACQUIRE, "agent");
            xb_add(&bar[XB_XGEN(b.x)], 1u);
            asm volatile("s_waitcnt vmcnt(0)" ::: "memory");
        } else {
            XB_SPIN(xb_ld(&bar[XB_XGEN(b.x)]) == gen, bar);
            __builtin_amdgcn_fence(__ATOMIC_ACQUIRE, "agent");
            asm volatile("s_waitcnt vmcnt(0)" ::: "memory");
        }
    }
    __syncthreads();
}
constexpr size_t MiB = 1u << 20;
constexpr size_t WS_CTL = 0, CTL_ZERO_BYTES = 1 * MiB;
constexpr size_t WS_W0 = 1 * MiB;
constexpr size_t REL_WIN = 0;
constexpr size_t REL_WOUT = REL_WIN + 13 * MiB / 2;
constexpr size_t REL_WKV = REL_WOUT + 2 * MiB;
constexpr size_t REL_WUP = REL_WKV + 1 * MiB;
constexpr size_t REL_WDN = REL_WUP + 16 * MiB;
constexpr size_t REL_WEND = REL_WDN + 8 * MiB;
constexpr size_t WS_HBF = 35 * MiB;
constexpr size_t WS_MEMBF = WS_HBF + 32 * MiB;
constexpr size_t WS_PROJ = 69 * MiB;
constexpr size_t WS_STATE = 173 * MiB;
constexpr size_t WS_MISC = 250 * MiB;
constexpr size_t WS_RINV = WS_MISC;
constexpr size_t WS_RINVM = WS_RINV + 64 * 1024;
constexpr size_t WS_KVMEM = WS_RINVM + 4096;
constexpr size_t WS_DECAY = WS_KVMEM + 2 * MiB;
constexpr size_t WS_DUMMY = WS_DECAY + 1 * MiB;
constexpr size_t WS_ROWSS = WS_DUMMY + 4096;
constexpr size_t WS_END_OPT = WS_ROWSS + 1 * MiB;
static_assert(WS_W0 + REL_WEND <= WS_HBF && REL_WEND <= (size_t)M * D * 4 && WS_END_OPT <= 256 * MiB, "ws map");
constexpr int CW_ROWSS = 16384;
constexpr int CW_BAR = 4096;

constexpr int RING_BYTES = 131072;
constexpr int LDSCTL_OFF = RING_BYTES, MISC_OFF = LDSCTL_OFF + 320;
constexpr int LDS_BYTES = 147456;
constexpr int NWAVES = 8, NTHREADS = 512;
constexpr int NPH = 8;

struct Args {
    const float* in[21]; float* out; unsigned char* ws;
    int ph_lo, ph_hi, use_bar, pad;
};

namespace pg8 {
struct EpiRowScale {
    static constexpr bool PERM = true, AFTER_DRAIN = false;
    bf16_t* O; int ldc; const float* rs; int ssmode;
    __device__ __forceinline__ void operator()(const f32x4 (&acc)[2][2][4][2], const Unit& u, int wr, int wc, int fr, int fq) const {
        const int row0 = u.pm * BM + wr * 64 + fr, col0 = u.pn * BM + wc * 32 + 8 * fq;
#pragma unroll
        for (int ai = 0; ai < 2; ++ai)
#pragma unroll
            for (int m = 0; m < 4; ++m) { const int row = row0 + ai * HALF + m * 16; float s;
                if (ssmode) { const f32x4* pp = (const f32x4*)(rs + (size_t)row * 16); const f32x4 p0 = pp[0], p1 = pp[1], p2 = pp[2], p3 = pp[3];
                    s = rsqrtf((((p0.x + p0.y) + (p0.z + p0.w)) + ((p1.x + p1.y) + (p1.z + p1.w)) + ((p2.x + p2.y) + (p2.z + p2.w)) + ((p3.x + p3.y) + (p3.z + p3.w))) * (1.f / D) + EPS); }
                else s = rs[row]; bf16_t* rowp = O + (size_t)row * ldc + col0;
#pragma unroll
                for (int bj = 0; bj < 2; ++bj) { const f32x4 v0 = acc[ai][bj][m][0] * s, v1 = acc[ai][bj][m][1] * s;
                    u32x4 w; w.x = cvt_pk_bf16(v0[0], v0[1]); w.y = cvt_pk_bf16(v0[2], v0[3]); w.z = cvt_pk_bf16(v1[0], v1[1]); w.w = cvt_pk_bf16(v1[2], v1[3]);
                    *(u32x4*)(rowp + bj * HALF) = w; } }
    }
};
}

__device__ __forceinline__ int win_dst_row(int layer, int n, float& sc) {
    sc = 1.f;
    if (layer == 0) {
        if (n < 512) { sc = 0.08838834764831845f; return GLA_CQ + n; }
        if (n < 1024) return GLA_CK + (n - 512);
        if (n < 1792) return GLA_CV + (n - 1024);
        if (n < 2560) return GLA_CG + (n - 1792);
        if (n < 2576) return GLA_CR + (n - 2560);
        return GLA_CMQ + (n - 2576);
    } else {
        if (n < 768) return HG_CQ + n;
        if (n < 1536) return HG_CF + (n - 768);
        if (n < 2304) return HG_CV + (n - 1536);
        if (n < 3072) return HG_CG + (n - 2304);
        return HG_CMQ + (n - 3072);
    }
}
__device__ __forceinline__ void row_to_bf16(const float* xrow, bf16* orow, float* rinv, int lane) {
    const GAS f32x4* xr = (const GAS f32x4*)xrow + lane;
    f32x4 v[4]; float s = 0.f;
#pragma unroll
    for (int j = 0; j < 4; ++j) { v[j] = xr[64 * j]; s += (v[j].x * v[j].x + v[j].y * v[j].y) + (v[j].z * v[j].z + v[j].w * v[j].w); }
    s = wave_sum(s);
    GAS unsigned long long* o8 = (GAS unsigned long long*)orow + lane;
#pragma unroll
    for (int j = 0; j < 4; ++j) o8[64 * j] = (unsigned long long)pk2(v[j].x, v[j].y) | ((unsigned long long)pk2(v[j].z, v[j].w) << 32);
    if (lane == 0) *rinv = rsqrtf(s * (1.f / D) + EPS);
}
struct P0Item { const float* W; const float* gain; bf16* WT; int K, N, mode, item; };
__device__ __forceinline__ P0Item p0_decode(const Args& a, int layer, int r) {
    unsigned char* wb = layer == 0 ? a.ws + WS_W0 : (unsigned char*)a.out;
    const int NIN = layer == 0 ? GLA_IN : HG_IN;
    const int I_IN = 16 * ((NIN + 31) / 32), I_OUT = 16 * 32, I_KV = 16 * 16, I_UP = 16 * 16 * 16;
    P0Item it;
    if (r < I_IN) { it.W = layer == 0 ? a.in[6] : a.in[10]; it.gain = a.in[2] + layer * D; it.WT = (bf16*)(wb + REL_WIN); it.K = D; it.N = NIN; it.mode = 1; it.item = r; return it; } r -= I_IN;
    if (r < I_OUT) { it.W = a.in[14] + (size_t)layer * D * D; it.gain = nullptr; it.WT = (bf16*)(wb + REL_WOUT); it.K = D; it.N = D; it.mode = 0; it.item = r; return it; } r -= I_OUT;
    if (r < I_KV) { it.W = a.in[13] + (size_t)layer * D * 512; it.gain = a.in[4] + layer * D; it.WT = (bf16*)(wb + REL_WKV); it.K = D; it.N = 512; it.mode = 0; it.item = r; return it; } r -= I_KV;
    if (r < I_UP) { const int e = r / 256; it.W = a.in[19] + ((size_t)layer * NE + e) * D * 512; it.gain = a.in[3] + layer * D; it.WT = (bf16*)(wb + REL_WUP) + (size_t)e * 512 * D; it.K = D; it.N = 512; it.mode = 2; it.item = r % 256; return it; } r -= I_UP;
    { const int e = r / 128; it.W = a.in[20] + ((size_t)layer * NE + e) * FF * D; it.gain = nullptr; it.WT = (bf16*)(wb + REL_WDN) + (size_t)e * D * FF; it.K = FF; it.N = D; it.mode = 0; it.item = r % 128; return it; }
}
__device__ __forceinline__ int p0_nitems(int layer) { const int NIN = layer == 0 ? GLA_IN : HG_IN; return 16 * ((NIN + 31) / 32) + 16 * 32 + 16 * 16 + 16 * 16 * 16 + 16 * 4 * 32; }
__device__ __forceinline__ void p0_load(const P0Item& it, int lane, f32x4 (&v)[8]) {
    const int nblk = (it.N + 31) / 32, kb = it.item / nblk, nb = it.item % nblk, k0 = 64 * kb, n0 = 32 * nb, nn = lane & 7, kq = lane >> 3;
    const int n = min(n0 + 4 * nn, it.N - 4); const float* gp = it.gain ? it.gain : it.W; const bool ug = it.gain != nullptr;
    float gk[8];
#pragma unroll
    for (int i = 0; i < 8; ++i) { const int kk = 8 * i + kq; v[i] = *(const GAS f32x4*)(it.W + (size_t)(k0 + kk) * it.N + n); gk[i] = gp[k0 + kk]; }
#pragma unroll
    for (int i = 0; i < 8; ++i) v[i] = v[i] * (ug ? gk[i] : 1.f);
}
__device__ __forceinline__ void p0_store(const P0Item& it, int layer, int lane, const f32x4 (&v)[8], LAS float* scr) {
    const int nblk = (it.N + 31) / 32, kb = it.item / nblk, nb = it.item % nblk, k0 = 64 * kb, n0 = 32 * nb, nn = lane & 7, kq = lane >> 3;
#pragma unroll
    for (int i = 0; i < 8; ++i) { const int kk = 8 * i + kq;
        scr[(4 * nn + 0) * 65 + kk] = v[i].x; scr[(4 * nn + 1) * 65 + kk] = v[i].y; scr[(4 * nn + 2) * 65 + kk] = v[i].z; scr[(4 * nn + 3) * 65 + kk] = v[i].w; }
    LDS_WAIT(); asm volatile("" ::: "memory");
    const int c = lane & 7;
#pragma unroll
    for (int j = 0; j < 4; ++j) {
        const int nl = (lane >> 3) + 8 * j, n = n0 + nl;
        float sc = 1.f; int dr = n;
        if (it.mode == 1) dr = win_dst_row(layer, n, sc);
        if (it.mode == 2) { const int f = n & 255, isb = n >> 8; dr = (f >> 7) * 256 + isb * 128 + (f & 127); }
        const LAS float* s = scr + nl * 65 + 8 * c;
        v4u o; o.x = pk2(s[0] * sc, s[1] * sc); o.y = pk2(s[2] * sc, s[3] * sc); o.z = pk2(s[4] * sc, s[5] * sc); o.w = pk2(s[6] * sc, s[7] * sc);
        if (n < it.N) *(GAS v4u*)(it.WT + (size_t)dr * it.K + k0 + 8 * c) = o;
    }
    LDS_WAIT(); asm volatile("" ::: "memory");
}
__device__ __forceinline__ void p0_prologue(const Args& a, LAS unsigned char* lds, int gw, int NGW, int wave, int lane) {
    unsigned char* ws = a.ws;
    LAS float* scr = (LAS float*)(lds + wave * 8448);
    for (int m = gw; m < M; m += 2 * NGW) {
        const int m2 = m + NGW;
        const GAS f32x4* x0 = (const GAS f32x4*)(a.in[0] + (size_t)m * D) + lane; const GAS f32x4* x1 = (const GAS f32x4*)(a.in[0] + (size_t)(m2 < M ? m2 : m) * D) + lane;
        f32x4 v0[4], v1[4]; float s0 = 0.f, s1 = 0.f;
#pragma unroll
        for (int j = 0; j < 4; ++j) { v0[j] = x0[64 * j]; v1[j] = x1[64 * j]; }
#pragma unroll
        for (int j = 0; j < 4; ++j) { s0 += (v0[j].x * v0[j].x + v0[j].y * v0[j].y) + (v0[j].z * v0[j].z + v0[j].w * v0[j].w); s1 += (v1[j].x * v1[j].x + v1[j].y * v1[j].y) + (v1[j].z * v1[j].z + v1[j].w * v1[j].w); }
        s0 = wave_sum(s0); s1 = wave_sum(s1);
        GAS unsigned long long* o0 = (GAS unsigned long long*)((bf16*)(ws + WS_HBF) + (size_t)m * D) + lane;
#pragma unroll
        for (int j = 0; j < 4; ++j) o0[64 * j] = (unsigned long long)pk2(v0[j].x, v0[j].y) | ((unsigned long long)pk2(v0[j].z, v0[j].w) << 32);
        if (lane == 0) ((float*)(ws + WS_RINV))[m] = rsqrtf(s0 * (1.f / D) + EPS);
        if (m2 < M) { GAS unsigned long long* o1 = (GAS unsigned long long*)((bf16*)(ws + WS_HBF) + (size_t)m2 * D) + lane;
#pragma unroll
            for (int j = 0; j < 4; ++j) o1[64 * j] = (unsigned long long)pk2(v1[j].x, v1[j].y) | ((unsigned long long)pk2(v1[j].z, v1[j].w) << 32);
            if (lane == 0) ((float*)(ws + WS_RINV))[m2] = rsqrtf(s1 * (1.f / D) + EPS); }
    }
    for (int m = gw; m < MROWS; m += NGW) row_to_bf16(a.in[1] + (size_t)m * D, (bf16*)(ws + WS_MEMBF) + (size_t)m * D, (float*)(ws + WS_RINVM) + m, lane);
    const int n0 = p0_nitems(0), ntot = n0 + p0_nitems(1);
    f32x4 va[8], vb[8], vc[8]; P0Item ia, ib, ic; int la = 0, lb = 0, lc = 0; bool ha, hb, hc;
#define P0_FETCH(j, it, l, v, h) do { const int _idx = gw + (j) * NGW; h = _idx < ntot; if (h) { l = _idx < n0 ? 0 : 1; it = p0_decode(a, l, l ? _idx - n0 : _idx); p0_load(it, lane, v); } } while (0)
    P0_FETCH(0, ia, la, va, ha); P0_FETCH(1, ib, lb, vb, hb);
    for (int j = 0;; j += 3) {
        P0_FETCH(j + 2, ic, lc, vc, hc); if (!ha) break; p0_store(ia, la, lane, va, scr);
        P0_FETCH(j + 3, ia, la, va, ha); if (!hb) break; p0_store(ib, lb, lane, vb, scr);
        P0_FETCH(j + 4, ib, lb, vb, hb); if (!hc) break; p0_store(ic, lc, lane, vc, scr);
    }
#undef P0_FETCH
}
template <int MIX> struct MixCfg;
template <> struct MixCfg<0> { static constexpr int H = GLA_H, DV = GLA_DV, LDP = GLA_LDP, CQ = GLA_CQ, CK = GLA_CK, CV = GLA_CV, CG = GLA_CG, CMQ = GLA_CMQ, VSTR = 416; };
template <> struct MixCfg<1> { static constexpr int H = HG_H, DV = HG_DV, LDP = HG_LDP, CQ = HG_CQ, CK = HG_CF, CV = HG_CV, CG = HG_CG, CMQ = HG_CMQ, VSTR = 288; };
constexpr int ISTR = 288;
constexpr int MX_G = 0, MX_T = 32768, MX_BL = 34816, MX_WG = 35328, MX_PREP_END = 43520;
constexpr int MXA_KD = 43520, MXA_V = 61952;
constexpr int MXB_ST = 0, MXB_QD = 55296, MXB_KD = 73728, MXB_V = 92160, MXB_RS = 118784;

__device__ __forceinline__ bf16x8 ld_row8(LAS unsigned char* base, int row, int col, int stride) { return *(const LAS bf16x8*)(base + row * stride + col * 2); }
__device__ __forceinline__ s16x4 ld_tr4(LAS unsigned char* p) { return __builtin_amdgcn_ds_read_tr16_b64_v4i16((LAS s16x4*)p); }
__device__ __forceinline__ bf16x8 ld_trfrag(LAS unsigned char* base, int row0, int col0, int stride, int lane) {
    const int g = lane >> 4, q = (lane & 15) >> 2, p = lane & 3;
    LAS unsigned char* a = base + (row0 + 4 * g + q) * stride + (col0 + 4 * p) * 2;
    const s16x4 lo = ld_tr4(a), hi = ld_tr4(a + 16 * stride);
    return __builtin_shufflevector(lo, hi, 0, 1, 2, 3, 4, 5, 6, 7);
}
__device__ __forceinline__ void unpack8(const v4u w, float (&f)[8]) {
    f[0] = __uint_as_float(w.x << 16); f[1] = __uint_as_float(w.x & 0xffff0000u); f[2] = __uint_as_float(w.y << 16); f[3] = __uint_as_float(w.y & 0xffff0000u);
    f[4] = __uint_as_float(w.z << 16); f[5] = __uint_as_float(w.z & 0xffff0000u); f[6] = __uint_as_float(w.w << 16); f[7] = __uint_as_float(w.w & 0xffff0000u);
}
__device__ __forceinline__ v4u pack8(const float (&f)[8]) { v4u w; w.x = pk2(f[0], f[1]); w.y = pk2(f[2], f[3]); w.z = pk2(f[4], f[5]); w.w = pk2(f[6], f[7]); return w; }

template <int MIX>
__device__ __forceinline__ void mixer_gates(const Args& a, const bf16* proj, LAS unsigned char* lds, int tid, int h, size_t tok0, float (&kx)[2][8]) {
    typedef MixCfg<MIX> C;
    const int co = tid & 15, tg = tid >> 4;
    LAS float* G = (LAS float*)(lds + MX_G); LAS float* T = (LAS float*)(lds + MX_T); LAS float* BL = (LAS float*)(lds + MX_BL);
    float gv[2][8];
    if (MIX == 0) {
        LAS float* WG = (LAS float*)(lds + MX_WG);
        { const int r = tid >> 5, c4 = (tid & 31) * 4; *(LAS f32x4*)(WG + r * 128 + c4) = *(const GAS f32x4*)(a.in[7] + r * GLA_KW + h * 128 + c4); }
        float rr[2][16];
#pragma unroll
        for (int s = 0; s < 2; ++s) {
            const bf16* rowp = proj + (tok0 + 2 * tg + s) * C::LDP;
            const v4u kw = *(const GAS v4u*)(rowp + C::CK + h * 128 + 8 * co); unpack8(kw, kx[s]);
            const v4u r0 = *(const GAS v4u*)(rowp + GLA_CR), r1 = *(const GAS v4u*)(rowp + GLA_CR + 8);
            float t0[8], t1[8]; unpack8(r0, t0); unpack8(r1, t1);
#pragma unroll
            for (int e = 0; e < 8; ++e) { rr[s][e] = t0[e]; rr[s][8 + e] = t1[e]; }
        }
        float bgv[8];
        { const f32x4 b0 = *(const GAS f32x4*)(a.in[8] + h * 128 + 8 * co), b1 = *(const GAS f32x4*)(a.in[8] + h * 128 + 8 * co + 4);
          bgv[0] = b0.x; bgv[1] = b0.y; bgv[2] = b0.z; bgv[3] = b0.w; bgv[4] = b1.x; bgv[5] = b1.y; bgv[6] = b1.z; bgv[7] = b1.w; }
        __syncthreads();
#pragma unroll
        for (int s = 0; s < 2; ++s)
#pragma unroll
            for (int e = 0; e < 8; ++e) gv[s][e] = bgv[e];
#pragma unroll
        for (int r = 0; r < 16; ++r) {
            const f32x4 w0 = *(const LAS f32x4*)(WG + r * 128 + 8 * co), w1 = *(const LAS f32x4*)(WG + r * 128 + 8 * co + 4);
            const float wv[8] = {w0.x, w0.y, w0.z, w0.w, w1.x, w1.y, w1.z, w1.w};
#pragma unroll
            for (int s = 0; s < 2; ++s)
#pragma unroll
                for (int e = 0; e < 8; ++e) gv[s][e] = fmaf(rr[s][r], wv[e], gv[s][e]);
        }
#pragma unroll
        for (int s = 0; s < 2; ++s)
#pragma unroll
            for (int e = 0; e < 8; ++e) { const float xg = gv[s][e]; gv[s][e] = (fminf(xg, 0.f) - __logf(1.f + __expf(-fabsf(xg)))) * (1.f / 16.f); }
    } else {
        float oml[8];
#pragma unroll
        for (int e = 0; e < 8; ++e) { const int c = h * 128 + 8 * co + e; const float dlt = a.in[11][MIXW + c] - a.in[11][c]; oml[e] = 1.f - __builtin_amdgcn_rcpf(1.f + __expf(-dlt)); }
#pragma unroll
        for (int s = 0; s < 2; ++s) {
            const bf16* rowp = proj + (tok0 + 2 * tg + s) * C::LDP;
            const v4u zw = *(const GAS v4u*)(rowp + C::CK + h * 128 + 8 * co); float z[8]; unpack8(zw, z);
#pragma unroll
            for (int e = 0; e < 8; ++e) { const float omf = oml[e] * __builtin_amdgcn_rcpf(1.f + __expf(z[e])); kx[s][e] = omf; gv[s][e] = __logf(1.f - omf); }
        }
    }
#pragma unroll
    for (int s = 0; s < 2; ++s) {
        LAS float* gp = G + (2 * tg + s) * 128 + 8 * co;
        *(LAS f32x4*)gp = (f32x4){gv[s][0], gv[s][1], gv[s][2], gv[s][3]}; *(LAS f32x4*)(gp + 4) = (f32x4){gv[s][4], gv[s][5], gv[s][6], gv[s][7]};
    }
    __syncthreads();
    {
        const int kk = tid & 127, seg = tid >> 7;
        float c[16]; float run = 0.f;
#pragma unroll
        for (int i = 0; i < 16; ++i) { run += G[(16 * seg + i) * 128 + kk]; c[i] = run; }
        T[seg * 128 + kk] = run;
        __syncthreads();
        float offs = 0.f, tot = 0.f;
#pragma unroll
        for (int s = 0; s < 4; ++s) { const float ts = T[s * 128 + kk]; tot += ts; if (s < seg) offs += ts; }
#pragma unroll
        for (int i = 0; i < 16; ++i) G[(16 * seg + i) * 128 + kk] = c[i] + offs;
        if (seg == 0) BL[kk] = tot;
    }
    __syncthreads();
}

template <int MIX>
__device__ __forceinline__ void mixer_phase_a(const Args& a, LAS unsigned char* lds, int vcu, int G_) {
    typedef MixCfg<MIX> C;
    int tid = threadIdx.x; asm volatile("" : "+v"(tid));
    const int lane = tid & 63, wave = __builtin_amdgcn_readfirstlane(tid >> 6);
    const bf16* proj = (const bf16*)(a.ws + WS_PROJ);
    constexpr int NIT = BATCH * C::H * NCH, NDT = C::DV / 16, VCH = C::DV / 8;
    for (int item = vcu; item < NIT; item += G_) {
        const int c = item % NCH, h = (item / NCH) % C::H, b = item / (NCH * C::H);
        const size_t tok0 = (size_t)b * SEQ + (size_t)c * CH;
#pragma unroll
        for (int i = 0; i < VCH * 64 / NTHREADS; ++i) { const int id = tid + NTHREADS * i, j = id / VCH, cv = id % VCH;
            *(LAS v4u*)(lds + MXA_V + j * C::VSTR + cv * 16) = *(const GAS v4u*)(proj + (tok0 + j) * C::LDP + C::CV + h * C::DV + 8 * cv); }
        float kx[2][8];
        mixer_gates<MIX>(a, proj, lds, tid, h, tok0, kx);
        {
            const int co = tid & 15, tg = tid >> 4;
            const LAS float* G = (const LAS float*)(lds + MX_G); const LAS float* BL = (const LAS float*)(lds + MX_BL);
            const f32x4 l0 = *(const LAS f32x4*)(BL + 8 * co), l1 = *(const LAS f32x4*)(BL + 8 * co + 4);
            const float bl[8] = {l0.x, l0.y, l0.z, l0.w, l1.x, l1.y, l1.z, l1.w};
#pragma unroll
            for (int s = 0; s < 2; ++s) { const int j = 2 * tg + s;
                const f32x4 b0 = *(const LAS f32x4*)(G + j * 128 + 8 * co), b1 = *(const LAS f32x4*)(G + j * 128 + 8 * co + 4);
                const float bb[8] = {b0.x, b0.y, b0.z, b0.w, b1.x, b1.y, b1.z, b1.w}; float o[8];
#pragma unroll
                for (int e = 0; e < 8; ++e) o[e] = kx[s][e] * __expf(bl[e] - bb[e]);
                *(LAS v4u*)(lds + MXA_KD + j * ISTR + 16 * co) = pack8(o); }
            if (tid < 128) ((float*)(a.ws + WS_DECAY))[(size_t)item * 128 + tid] = __expf(BL[tid]);
        }
        __syncthreads();
        f32x4 acc[NDT];
#pragma unroll
        for (int d = 0; d < NDT; ++d) acc[d] = (f32x4){0.f, 0.f, 0.f, 0.f};
#pragma unroll
        for (int ks = 0; ks < 2; ++ks) {
            const bf16x8 bfrag = ld_trfrag(lds + MXA_KD, 32 * ks, 16 * wave, ISTR, lane);
#pragma unroll
            for (int d = 0; d < NDT; ++d) { const bf16x8 afrag = ld_trfrag(lds + MXA_V, 32 * ks, 16 * d, C::VSTR, lane);
                acc[d] = __builtin_amdgcn_mfma_f32_16x16x32_bf16(afrag, bfrag, acc[d], 0, 0, 0); }
        }
        __syncthreads();
        {   const int g = lane >> 4, kk = 16 * wave + (lane & 15);
#pragma unroll
            for (int d = 0; d < NDT; ++d)
#pragma unroll
                for (int r = 0; r < 4; ++r) *(LAS bf16*)(lds + (16 * d + 4 * g + r) * 256 + kk * 2) = f2bf(acc[d][r]); }
        __syncthreads();
        {   bf16* st = (bf16*)(a.ws + WS_STATE) + (size_t)item * C::DV * 128;
#pragma unroll
            for (int i = 0; i < C::DV * 256 / 16 / NTHREADS; ++i) { const int id = tid + NTHREADS * i; *(GAS v4u*)(st + id * 8) = *(const LAS v4u*)(lds + id * 16); } }
        __syncthreads();
    }
}

template <int MIX>
__device__ __forceinline__ void mixer_scan(const Args& a, int vcu, int G_) {
    typedef MixCfg<MIX> C;
    int tid = threadIdx.x; asm volatile("" : "+v"(tid));
    constexpr int EPB = C::DV * 128 / 4;
    constexpr int NTASK = BATCH * C::H * EPB;
    const float* dec = (const float*)(a.ws + WS_DECAY);
    for (int task = vcu * NTHREADS + tid; task < NTASK; task += G_ * NTHREADS) {
        const int bh = task / EPB, e4 = task % EPB, kk = (4 * e4) & 127;
        v2u* sp = (v2u*)(a.ws + WS_STATE) + (size_t)bh * NCH * EPB + e4;
        const float* dp = dec + (size_t)bh * NCH * 128 + kk;
        float s0 = 0.f, s1 = 0.f, s2 = 0.f, s3 = 0.f;
#pragma unroll 16
        for (int c = 0; c < NCH; ++c) {
            const v2u lw = *(const GAS v2u*)(sp + (size_t)c * EPB);
            const f32x4 d = *(const GAS f32x4*)(dp + c * 128);
            v2u o; o.x = pk2(s0, s1); o.y = pk2(s2, s3);
            *(GAS v2u*)(sp + (size_t)c * EPB) = o;
            s0 = fmaf(s0, d.x, __uint_as_float(lw.x << 16)); s1 = fmaf(s1, d.y, __uint_as_float(lw.x & 0xffff0000u));
            s2 = fmaf(s2, d.z, __uint_as_float(lw.y << 16)); s3 = fmaf(s3, d.w, __uint_as_float(lw.y & 0xffff0000u));
        }
    }
}

template <int MIX>
__device__ __forceinline__ void mixer_phase_b(const Args& a, LAS unsigned char* lds, int vcu, int G_) {
    typedef MixCfg<MIX> C;
    int tid = threadIdx.x; asm volatile("" : "+v"(tid));
    const int lane = tid & 63, wave = __builtin_amdgcn_readfirstlane(tid >> 6);
    bf16* proj = (bf16*)(a.ws + WS_PROJ);
    constexpr int NIT = BATCH * C::H * NCH, NDT = C::DV / 16, NDH = NDT / 2, VCH = C::DV / 8, SCH = C::DV * 16 / NTHREADS;
    const float* onorm = MIX == 0 ? a.in[9] : a.in[12];
    for (int item = vcu; item < NIT; item += G_) {
        const int c = item % NCH, h = (item / NCH) % C::H, b = item / (NCH * C::H);
        const size_t tok0 = (size_t)b * SEQ + (size_t)c * CH;
        const int co = tid & 15, tg = tid >> 4;
        v4u sreg[SCH];
        { const bf16* st = (const bf16*)(a.ws + WS_STATE) + (size_t)item * C::DV * 128;
#pragma unroll
          for (int i = 0; i < SCH; ++i) sreg[i] = *(const GAS v4u*)(st + (tid + NTHREADS * i) * 8); }
#pragma unroll
        for (int i = 0; i < VCH * 64 / NTHREADS; ++i) { const int id = tid + NTHREADS * i, j = id / VCH, cv = id % VCH;
            *(LAS v4u*)(lds + MXB_V + j * C::VSTR + cv * 16) = *(const GAS v4u*)(proj + (tok0 + j) * C::LDP + C::CV + h * C::DV + 8 * cv); }
        float qx[2][8];
#pragma unroll
        for (int s = 0; s < 2; ++s) { const v4u qw = *(const GAS v4u*)(proj + (tok0 + 2 * tg + s) * C::LDP + C::CQ + h * 128 + 8 * co); unpack8(qw, qx[s]);
            if (MIX == 1) {
#pragma unroll
                for (int e = 0; e < 8; ++e) qx[s][e] = qx[s][e] * __builtin_amdgcn_rcpf(1.f + __expf(-qx[s][e])); } }
        float kx[2][8];
        mixer_gates<MIX>(a, proj, lds, tid, h, tok0, kx);
        {
            const LAS float* G = (const LAS float*)(lds + MX_G);
            float bb[2][8];
#pragma unroll
            for (int s = 0; s < 2; ++s) { const int j = 2 * tg + s;
                const f32x4 b0 = *(const LAS f32x4*)(G + j * 128 + 8 * co), b1 = *(const LAS f32x4*)(G + j * 128 + 8 * co + 4);
                bb[s][0] = b0.x; bb[s][1] = b0.y; bb[s][2] = b0.z; bb[s][3] = b0.w; bb[s][4] = b1.x; bb[s][5] = b1.y; bb[s][6] = b1.z; bb[s][7] = b1.w; }
            __syncthreads();
#pragma unroll
            for (int s = 0; s < 2; ++s) { const int j = 2 * tg + s; float oq[8], ok[8];
#pragma unroll
                for (int e = 0; e < 8; ++e) { const float ex = __expf(bb[s][e]); oq[e] = qx[s][e] * ex; ok[e] = kx[s][e] * __builtin_amdgcn_rcpf(ex); }
                *(LAS v4u*)(lds + MXB_QD + j * ISTR + 16 * co) = pack8(oq); *(LAS v4u*)(lds + MXB_KD + j * ISTR + 16 * co) = pack8(ok); }
#pragma unroll
            for (int i = 0; i < SCH; ++i) { const int id = tid + NTHREADS * i, row = id >> 4, ch = id & 15; *(LAS v4u*)(lds + MXB_ST + row * ISTR + ch * 16) = sreg[i]; }
        }
        __syncthreads();
        const int it = wave & 3, dh = wave >> 2, g = lane >> 4, li = lane & 15;
        bf16x8 qf[4];
#pragma unroll
        for (int ks = 0; ks < 4; ++ks) qf[ks] = ld_row8(lds + MXB_QD, 16 * it + li, 32 * ks + 8 * g, ISTR);
        f32x4 X[4];
#pragma unroll
        for (int jt = 0; jt < 4; ++jt) { X[jt] = (f32x4){0.f, 0.f, 0.f, 0.f};
            if (jt <= it) {
#pragma unroll
                for (int ks = 0; ks < 4; ++ks) { const bf16x8 kf = ld_row8(lds + MXB_KD, 16 * jt + li, 32 * ks + 8 * g, ISTR);
                    X[jt] = __builtin_amdgcn_mfma_f32_16x16x32_bf16(kf, qf[ks], X[jt], 0, 0, 0); }
                if (jt == it) {
#pragma unroll
                    for (int r = 0; r < 4; ++r) if (4 * g + r > li) X[jt][r] = 0.f; } } }
        bf16x8 pf[2];
#pragma unroll
        for (int k2 = 0; k2 < 2; ++k2) { v4u w; w.x = pk2(X[2 * k2][0], X[2 * k2][1]); w.y = pk2(X[2 * k2][2], X[2 * k2][3]); w.z = pk2(X[2 * k2 + 1][0], X[2 * k2 + 1][1]); w.w = pk2(X[2 * k2 + 1][2], X[2 * k2 + 1][3]);
            pf[k2] = __builtin_bit_cast(bf16x8, w); }
        f32x4 acc[NDH];
        float ssq = 0.f;
#pragma unroll
        for (int d = 0; d < NDH; ++d) { const int dt = dh * NDH + d; acc[d] = (f32x4){0.f, 0.f, 0.f, 0.f};
#pragma unroll
            for (int k2 = 0; k2 < 2; ++k2) if (2 * k2 <= it) { const bf16x8 vf = ld_trfrag(lds + MXB_V, 32 * k2, 16 * dt, C::VSTR, lane);
                acc[d] = __builtin_amdgcn_mfma_f32_16x16x32_bf16(vf, pf[k2], acc[d], 0, 0, 0); }
#pragma unroll
            for (int ks = 0; ks < 4; ++ks) { const bf16x8 sf = ld_row8(lds + MXB_ST, 16 * dt + li, 32 * ks + 8 * g, ISTR);
                acc[d] = __builtin_amdgcn_mfma_f32_16x16x32_bf16(sf, qf[ks], acc[d], 0, 0, 0); }
            ssq += (acc[d][0] * acc[d][0] + acc[d][1] * acc[d][1]) + (acc[d][2] * acc[d][2] + acc[d][3] * acc[d][3]); }
        ssq += __shfl_xor(ssq, 16); ssq += __shfl_xor(ssq, 32);
        LAS float* RS = (LAS float*)(lds + MXB_RS);
        if (g == 0) RS[dh * 64 + 16 * it + li] = ssq;
        __syncthreads();
        {   const float tot = RS[16 * it + li] + RS[64 + 16 * it + li];
            const float ri = rsqrtf(tot * (1.f / C::DV) + EPS);
            bf16* rowp = proj + (tok0 + 16 * it + li) * C::LDP;
#pragma unroll
            for (int d = 0; d < NDH; ++d) { const int dv = 16 * (dh * NDH + d) + 4 * g;
                const v2u gw = *(const GAS v2u*)(rowp + C::CG + h * C::DV + dv);
                const f32x4 gn = *(const GAS f32x4*)(onorm + dv);
                const float g0 = __uint_as_float(gw.x << 16), g1 = __uint_as_float(gw.x & 0xffff0000u), g2 = __uint_as_float(gw.y << 16), g3 = __uint_as_float(gw.y & 0xffff0000u);
                v2u o; o.x = pk2(acc[d][0] * ri * gn.x * (g0 * __builtin_amdgcn_rcpf(1.f + __expf(-g0))), acc[d][1] * ri * gn.y * (g1 * __builtin_amdgcn_rcpf(1.f + __expf(-g1))));
                o.y = pk2(acc[d][2] * ri * gn.z * (g2 * __builtin_amdgcn_rcpf(1.f + __expf(-g2))), acc[d][3] * ri * gn.w * (g3 * __builtin_amdgcn_rcpf(1.f + __expf(-g3))));
                *(GAS v2u*)(rowp + C::CV + h * C::DV + dv) = o; } }
        __syncthreads();
    }
}

constexpr int MA_STR = 160, MA_K = 0, MA_V = 40960, MA_Q = 81920;
template <int MIX>
__device__ __forceinline__ void memattn_phase(const Args& a, LAS unsigned char* lds, int vcu, int G_) {
    typedef MixCfg<MIX> C;
    int tid = threadIdx.x; asm volatile("" : "+v"(tid));
    const int lane = tid & 63, wave = __builtin_amdgcn_readfirstlane(tid >> 6), g = lane >> 4, li = lane & 15;
    bf16* proj = (bf16*)(a.ws + WS_PROJ);
    const bf16* kvm = (const bf16*)(a.ws + WS_KVMEM) + (size_t)MIX * MROWS * 512;
    constexpr int NIT = (M / 128) * 4;
    for (int item = vcu; item < NIT; item += G_) {
        const int hm = item & 3, tile = item >> 2; const size_t tok0 = (size_t)tile * 128; const int b = (int)(tok0 / SEQ);
#pragma unroll
        for (int i = 0; i < 4; ++i) { const int id = tid + NTHREADS * i, m = id >> 3, ch = id & 7;
            *(LAS v4u*)(lds + MA_K + m * MA_STR + ch * 16) = *(const GAS v4u*)(kvm + (size_t)(b * NMEM + m) * 512 + hm * 64 + 8 * ch);
            *(LAS v4u*)(lds + MA_V + m * MA_STR + ch * 16) = *(const GAS v4u*)(kvm + (size_t)(b * NMEM + m) * 512 + 256 + hm * 64 + 8 * ch); }
#pragma unroll
        for (int i = 0; i < 2; ++i) { const int id = tid + NTHREADS * i, t = id >> 3, ch = id & 7;
            *(LAS v4u*)(lds + MA_Q + t * MA_STR + ch * 16) = *(const GAS v4u*)(proj + (tok0 + t) * C::LDP + C::CMQ + hm * 64 + 8 * ch); }
        __syncthreads();
        bf16x8 qf[2];
#pragma unroll
        for (int ks = 0; ks < 2; ++ks) qf[ks] = ld_row8(lds + MA_Q, 16 * wave + li, 32 * ks + 8 * g, MA_STR);
        f32x4 X[16]; float mx = -3.0e38f;
#pragma unroll
        for (int kt = 0; kt < 16; ++kt) { X[kt] = (f32x4){0.f, 0.f, 0.f, 0.f};
#pragma unroll
            for (int ks = 0; ks < 2; ++ks) { const bf16x8 kf = ld_row8(lds + MA_K, 16 * kt + li, 32 * ks + 8 * g, MA_STR);
                X[kt] = __builtin_amdgcn_mfma_f32_16x16x32_bf16(kf, qf[ks], X[kt], 0, 0, 0); }
            mx = fmaxf(mx, fmaxf(fmaxf(X[kt][0], X[kt][1]), fmaxf(X[kt][2], X[kt][3]))); }
        mx = fmaxf(mx, __shfl_xor(mx, 16)); mx = fmaxf(mx, __shfl_xor(mx, 32));
        float sum = 0.f;
#pragma unroll
        for (int kt = 0; kt < 16; ++kt)
#pragma unroll
            for (int r = 0; r < 4; ++r) { const float p = __expf((X[kt][r] - mx) * 0.125f); X[kt][r] = p; sum += p; }
        sum += __shfl_xor(sum, 16); sum += __shfl_xor(sum, 32);
        const float inv = __builtin_amdgcn_rcpf(sum);
        f32x4 acc[4];
#pragma unroll
        for (int d = 0; d < 4; ++d) acc[d] = (f32x4){0.f, 0.f, 0.f, 0.f};
#pragma unroll
        for (int k2 = 0; k2 < 8; ++k2) {
            v4u w; w.x = pk2(X[2 * k2][0] * inv, X[2 * k2][1] * inv); w.y = pk2(X[2 * k2][2] * inv, X[2 * k2][3] * inv);
            w.z = pk2(X[2 * k2 + 1][0] * inv, X[2 * k2 + 1][1] * inv); w.w = pk2(X[2 * k2 + 1][2] * inv, X[2 * k2 + 1][3] * inv);
            const bf16x8 pf = __builtin_bit_cast(bf16x8, w);
#pragma unroll
            for (int d = 0; d < 4; ++d) { const bf16x8 vf = ld_trfrag(lds + MA_V, 32 * k2, 16 * d, MA_STR, lane);
                acc[d] = __builtin_amdgcn_mfma_f32_16x16x32_bf16(vf, pf, acc[d], 0, 0, 0); }
        }
        {   bf16* rowp = proj + (tok0 + 16 * wave + li) * C::LDP + C::CMQ + hm * 64;
#pragma unroll
            for (int d = 0; d < 4; ++d) { v2u o; o.x = pk2(acc[d][0], acc[d][1]); o.y = pk2(acc[d][2], acc[d][3]); *(GAS v2u*)(rowp + 16 * d + 4 * g) = o; } }
        __syncthreads();
    }
}

__device__ __forceinline__ void memkv_tiles(const Args& a, LAS unsigned char* lds, int vcu, int G_) {
    int tid = threadIdx.x; asm volatile("" : "+v"(tid));
    const int lane = tid & 63, wave = __builtin_amdgcn_readfirstlane(tid >> 6), g = lane >> 4, li = lane & 15;
    const bf16* membf = (const bf16*)(a.ws + WS_MEMBF); const float* rinvm = (const float*)(a.ws + WS_RINVM);
    for (int t = vcu; t < 256; t += G_) {
        const int l = t >> 7, rt = (t & 127) >> 3, ct = t & 7;
        const bf16* wkv = (const bf16*)((l == 0 ? a.ws + WS_W0 : (unsigned char*)a.out) + REL_WKV);
        const bf16* ap = membf + (size_t)(rt * 64 + li) * D + 128 * wave + 8 * g;
        const bf16* bp = wkv + (size_t)(ct * 64 + li) * D + 128 * wave + 8 * g;
        f32x4 acc[4][4];
#pragma unroll
        for (int j = 0; j < 4; ++j)
#pragma unroll
            for (int i = 0; i < 4; ++i) acc[j][i] = (f32x4){0.f, 0.f, 0.f, 0.f};
#pragma unroll
        for (int ks = 0; ks < 4; ++ks) {
            bf16x8 af[4], bf[4];
#pragma unroll
            for (int i = 0; i < 4; ++i) { af[i] = *(const GAS bf16x8*)(ap + (size_t)(16 * i) * D + 32 * ks); bf[i] = *(const GAS bf16x8*)(bp + (size_t)(16 * i) * D + 32 * ks); }
#pragma unroll
            for (int j = 0; j < 4; ++j)
#pragma unroll
                for (int i = 0; i < 4; ++i) acc[j][i] = __builtin_amdgcn_mfma_f32_16x16x32_bf16(bf[j], af[i], acc[j][i], 0, 0, 0);
        }
        LAS float* P = (LAS float*)lds + wave * 4096;
#pragma unroll
        for (int j = 0; j < 4; ++j)
#pragma unroll
            for (int i = 0; i < 4; ++i) *(LAS f32x4*)(P + (16 * i + li) * 64 + 16 * j + 4 * g) = acc[j][i];
        __syncthreads();
        {   const int row = tid >> 3, c8 = (tid & 7) * 8; f32x4 s0 = {0.f, 0.f, 0.f, 0.f}, s1 = {0.f, 0.f, 0.f, 0.f};
#pragma unroll
            for (int w = 0; w < 8; ++w) { const LAS float* pp = (const LAS float*)lds + w * 4096 + row * 64 + c8; s0 += *(const LAS f32x4*)pp; s1 += *(const LAS f32x4*)(pp + 4); }
            const float sc = rinvm[rt * 64 + row];
            v4u o; o.x = pk2(s0.x * sc, s0.y * sc); o.y = pk2(s0.z * sc, s0.w * sc); o.z = pk2(s1.x * sc, s1.y * sc); o.w = pk2(s1.z * sc, s1.w * sc);
            *(GAS v4u*)((bf16*)(a.ws + WS_KVMEM) + (size_t)l * MROWS * 512 + (size_t)(rt * 64 + row) * 512 + ct * 64 + c8) = o; }
        __syncthreads();
    }
}
constexpr size_t WS_SLOT = WS_STATE;
constexpr size_t WS_HACT = WS_PROJ;
constexpr int NBK = 24;
constexpr int CW_CNT = 8192;
constexpr int TT_OFF = LDSCTL_OFF + 1024;
struct SlotRec { int token; float rinv, glo, ghi; };

namespace pg8 {
struct EpiResid {
    static constexpr bool PERM = true, AFTER_DRAIN = false;
    bf16_t* hb; int ldc;
    __device__ __forceinline__ void operator()(const f32x4 (&acc)[2][2][4][2], const Unit& u, int wr, int wc, int fr, int fq) const {
        const int row0 = u.pm * BM + wr * 64 + fr, col0 = u.pn * BM + wc * 32 + 8 * fq;
#pragma unroll
        for (int ai = 0; ai < 2; ++ai)
#pragma unroll
            for (int m = 0; m < 4; ++m) { bf16_t* rowp = hb + (size_t)(row0 + ai * HALF + m * 16) * ldc + col0;
#pragma unroll
                for (int bj = 0; bj < 2; ++bj) { const u32x4 b = *(const u32x4*)(rowp + bj * HALF); const f32x4 a0 = acc[ai][bj][m][0], a1 = acc[ai][bj][m][1];
                    u32x4 w; w.x = cvt_pk_bf16(__uint_as_float(b.x << 16) + a0[0], __uint_as_float(b.x & 0xffff0000u) + a0[1]); w.y = cvt_pk_bf16(__uint_as_float(b.y << 16) + a0[2], __uint_as_float(b.y & 0xffff0000u) + a0[3]);
                    w.z = cvt_pk_bf16(__uint_as_float(b.z << 16) + a1[0], __uint_as_float(b.z & 0xffff0000u) + a1[1]); w.w = cvt_pk_bf16(__uint_as_float(b.w << 16) + a1[2], __uint_as_float(b.w & 0xffff0000u) + a1[3]);
                    *(u32x4*)(rowp + bj * HALF) = w; }
                asm volatile("" ::: "memory"); }
    }
};
template <int mode> struct MoeOrder {
    static constexpr bool GATHER = (mode == 0);
    const PG8_LAS int* tt; int G, c; const SlotRec* slots;
    __device__ __forceinline__ bool next(int i, Unit& u) const {
        const int L = i * G + c, NT = __builtin_amdgcn_readfirstlane(tt[NBK]);
        if (L >= NT * 4) return false;
        const int rt = L >> 2; int bk = 0;
        for (int b = 1; b < NBK; ++b) if (rt >= __builtin_amdgcn_readfirstlane(tt[b])) bk = b;
        const int tb = __builtin_amdgcn_readfirstlane(tt[bk]), cn = __builtin_amdgcn_readfirstlane(tt[25 + bk]);
        u.pm = rt; u.pn = L & 3; u.x0 = bk; const int first = (rt - tb) * BM; u.x1 = min(cn - first, BM); u.x2 = bk * M + first; u.x3 = 0;
        return true;
    }
    __device__ __forceinline__ void a_ready(const Unit&) const {}
    __device__ __forceinline__ void done(const Unit&) const {}
    __device__ __forceinline__ static void experts(int bk, int& ea, int& eb) { const int g = bk / 6, p = bk % 6; const int lo = p < 3 ? 0 : (p < 5 ? 1 : 2), hi = p < 3 ? p + 1 : (p < 5 ? p - 1 : 3); ea = 4 * g + lo; eb = 4 * g + hi; }
    __device__ __forceinline__ unsigned a_off(const Gemm& g, const Unit& u, int r) const {
        const int rr = r < u.x1 ? r : u.x1 - 1; const int tok = slots[u.x2 + rr].token; return (unsigned)(tok * g.lda) * 2u;
    }
    __device__ __forceinline__ size_t b_off(const Gemm& g, const Unit& u) const {
        int ea, eb; experts(u.x0, ea, eb);
        if (mode == 0) { const int e = (u.pn < 2) ? ea : eb; return ((size_t)e * 512 + (size_t)(u.pn & 1) * 256) * D * 2; }
        return ((size_t)ea * D + (size_t)u.pn * 256) * FF * 2;
    }
    __device__ __forceinline__ long b_delta(const Gemm& g, const Unit& u) const {
        if (mode == 0) return 0;
        int ea, eb; experts(u.x0, ea, eb); return (long)(eb - ea) * D * FF * 2 - (long)FF * 2;
    }
};
struct EpiMoeUp {
    static constexpr bool PERM = true, AFTER_DRAIN = false;
    bf16_t* hact; const SlotRec* slots;
    __device__ __forceinline__ void operator()(const f32x4 (&acc)[2][2][4][2], const Unit& u, int wr, int wc, int fr, int fq) const {
        const int colo = (u.pn >> 1) * 256 + (u.pn & 1) * 128 + wc * 32 + 8 * fq;
#pragma unroll
        for (int ai = 0; ai < 2; ++ai)
#pragma unroll
            for (int m = 0; m < 4; ++m) { const int r = ai * HALF + wr * 64 + m * 16 + fr;
                { const SlotRec sr = slots[u.x2 + (r < u.x1 ? r : u.x1 - 1)]; const float ri = sr.rinv, gt = (u.pn < 2) ? sr.glo : sr.ghi; asm volatile("" ::: "memory");
                    float o[8];
#pragma unroll
                    for (int n = 0; n < 2; ++n)
#pragma unroll
                        for (int j = 0; j < 4; ++j) { const float av = acc[ai][0][m][n][j] * ri, bv = acc[ai][1][m][n][j] * ri; o[4 * n + j] = av * __builtin_amdgcn_rcpf(1.f + __expf(-av)) * bv * gt; }
                    u32x4 w; w.x = cvt_pk_bf16(o[0], o[1]); w.y = cvt_pk_bf16(o[2], o[3]); w.z = cvt_pk_bf16(o[4], o[5]); w.w = cvt_pk_bf16(o[6], o[7]);
                    *(u32x4*)(hact + (size_t)(u.pm * BM + r) * 512 + colo) = w; } }
    }
};
struct EpiMoeDown {
    static constexpr bool PERM = true, AFTER_DRAIN = false;
    bf16_t* hb; const SlotRec* slots; bf16_t* dummy; float* rowss;
    __device__ __forceinline__ void operator()(const f32x4 (&acc)[2][2][4][2], const Unit& u, int wr, int wc, int fr, int fq) const {
        const int col0 = u.pn * BM + wc * 32 + 8 * fq;
#pragma unroll
        for (int ai = 0; ai < 2; ++ai)
#pragma unroll
            for (int m = 0; m < 4; ++m) { const int r = ai * HALF + wr * 64 + m * 16 + fr;
                { const int tok = slots[u.x2 + (r < u.x1 ? r : u.x1 - 1)].token; bf16_t* rowp = (r < u.x1 ? hb + (size_t)tok * D : dummy) + col0; float ss = 0.f;
#pragma unroll
                    for (int bj = 0; bj < 2; ++bj) { const u32x4 b = *(const u32x4*)(rowp + bj * HALF); const f32x4 a0 = acc[ai][bj][m][0], a1 = acc[ai][bj][m][1];
                        u32x4 w; w.x = cvt_pk_bf16(__uint_as_float(b.x << 16) + a0[0], __uint_as_float(b.x & 0xffff0000u) + a0[1]); w.y = cvt_pk_bf16(__uint_as_float(b.y << 16) + a0[2], __uint_as_float(b.y & 0xffff0000u) + a0[3]);
                        w.z = cvt_pk_bf16(__uint_as_float(b.z << 16) + a1[0], __uint_as_float(b.z & 0xffff0000u) + a1[1]); w.w = cvt_pk_bf16(__uint_as_float(b.w << 16) + a1[2], __uint_as_float(b.w & 0xffff0000u) + a1[3]);
                        *(u32x4*)(rowp + bj * HALF) = w;
                        if (rowss) { const unsigned ww[4] = {w.x, w.y, w.z, w.w};
#pragma unroll
                            for (int e = 0; e < 4; ++e) { const float lo = __uint_as_float(ww[e] << 16), hi = __uint_as_float(ww[e] & 0xffff0000u); ss = fmaf(lo, lo, ss); ss = fmaf(hi, hi, ss); } } }
                    if (rowss) { ss += __shfl_xor(ss, 16); ss += __shfl_xor(ss, 32); if (fq == 0 && r < u.x1) rowss[(size_t)tok * 16 + u.pn * 4 + wc] = ss; } }
                asm volatile("" ::: "memory"); }
    }
};
}

__device__ __forceinline__ void route_phase(const Args& a, int layer, LAS unsigned char* lds, int gw, int NGW) {
    int tid = threadIdx.x; asm volatile("" : "+v"(tid));
    const int lane = tid & 63;
    LAS float* WR = (LAS float*)lds;
    const float* gain = a.in[3] + layer * D; const float* wg = a.in[15] + (size_t)layer * D * NG; const float* wr = a.in[17] + (size_t)layer * D * NE;
#pragma unroll
    for (int i = 0; i < 8; ++i) { const int idx = tid + NTHREADS * i, k = idx >> 2, c4 = (idx & 3) * 4; const f32x4 w = *(const GAS f32x4*)(wr + (size_t)idx * 4); const float gk = gain[k];
        WR[(4 + c4) * D + k] = w.x * gk; WR[(5 + c4) * D + k] = w.y * gk; WR[(6 + c4) * D + k] = w.z * gk; WR[(7 + c4) * D + k] = w.w * gk; }
#pragma unroll
    for (int i = 0; i < 2; ++i) { const int k = tid + NTHREADS * i; const f32x4 w = *(const GAS f32x4*)(wg + (size_t)k * 4); const float gk = gain[k];
        WR[0 * D + k] = w.x * gk; WR[1 * D + k] = w.y * gk; WR[2 * D + k] = w.z * gk; WR[3 * D + k] = w.w * gk; }
    __syncthreads();
    const bf16* hbf = (const bf16*)(a.ws + WS_HBF); SlotRec* slots = (SlotRec*)(a.ws + WS_SLOT);
    unsigned* cnt = (unsigned*)(a.ws + WS_CTL) + CW_CNT + layer * 512;
    const float* bgp = a.in[16] + layer * NG; const float* brp = a.in[18] + layer * NE;
    for (int m = gw; m < M; m += NGW) {
        LAS float* WRl = WR + 8 * lane; asm volatile("" : "+v"(WRl));
        const GAS v4u* xr = (const GAS v4u*)(hbf + (size_t)m * D) + lane;
        float v[2][8]; float s = 0.f;
#pragma unroll
        for (int j = 0; j < 2; ++j) { unpack8(xr[64 * j], v[j]);
#pragma unroll
            for (int e = 0; e < 8; ++e) s = fmaf(v[j][e], v[j][e], s); }
        float lg[20];
#pragma unroll
        for (int c = 0; c < 20; ++c) { float acc = 0.f;
#pragma unroll
            for (int j = 0; j < 2; ++j) { const f32x4 w0 = *(const LAS f32x4*)(WRl + c * D + 512 * j), w1 = *(const LAS f32x4*)(WRl + c * D + 512 * j + 4);
                acc += (v[j][0] * w0.x + v[j][1] * w0.y) + (v[j][2] * w0.z + v[j][3] * w0.w) + (v[j][4] * w1.x + v[j][5] * w1.y) + (v[j][6] * w1.z + v[j][7] * w1.w); }
            lg[c] = acc; }
        s = wave_sum(s);
#pragma unroll
        for (int c = 0; c < 20; ++c) lg[c] = wave_sum(lg[c]);
        const float ri = rsqrtf(s * (1.f / D) + EPS);
#pragma unroll
        for (int c = 0; c < 4; ++c) lg[c] = lg[c] * ri + bgp[c];
#pragma unroll
        for (int c = 0; c < 16; ++c) lg[4 + c] = lg[4 + c] * ri + brp[c];
        int gi = 0; float gm = lg[0];
#pragma unroll
        for (int c = 1; c < 4; ++c) if (lg[c] > gm) { gm = lg[c]; gi = c; }
        float gs = 0.f;
#pragma unroll
        for (int c = 0; c < 4; ++c) gs += __expf(lg[c] - gm);
        const float gwt = 1.f / gs;
        float e[4];
#pragma unroll
        for (int c = 0; c < 4; ++c) e[c] = gi == 0 ? lg[4 + c] : (gi == 1 ? lg[8 + c] : (gi == 2 ? lg[12 + c] : lg[16 + c]));
        int i0 = 0;
#pragma unroll
        for (int c = 1; c < 4; ++c) if (e[c] > e[i0 == 0 ? 0 : (i0 == 1 ? 1 : (i0 == 2 ? 2 : 3))]) i0 = c;
        float e0 = i0 == 0 ? e[0] : (i0 == 1 ? e[1] : (i0 == 2 ? e[2] : e[3]));
        int i1 = -1; float e1 = -3.0e38f;
#pragma unroll
        for (int c = 0; c < 4; ++c) if (c != i0 && e[c] > e1) { e1 = e[c]; i1 = c; }
        const float p1 = __expf(e1 - e0), den = 1.f / (1.f + p1);
        const float w0 = gwt * den, w1 = gwt * p1 * den;
        const int lo = i0 < i1 ? i0 : i1, hi = i0 < i1 ? i1 : i0;
        const int pr = lo == 0 ? hi - 1 : (lo == 1 ? hi + 1 : 5);
        const int bk = gi * 6 + pr;
        if (lane == 0) {
            const unsigned pos = __hip_atomic_fetch_add(cnt + bk * 16, 1u, __ATOMIC_RELAXED, __HIP_MEMORY_SCOPE_AGENT);
            SlotRec sr; sr.token = m; sr.rinv = ri; sr.glo = i0 < i1 ? w0 : w1; sr.ghi = i0 < i1 ? w1 : w0;
            slots[(size_t)bk * M + pos] = sr;
        }
    }
}
__device__ __forceinline__ void moe_tile_table(const Args& a, int layer, LAS unsigned char* lds) {
    LAS int* tt = (LAS int*)(lds + TT_OFF);
    if (threadIdx.x == 0) {
        const unsigned* cnt = (const unsigned*)(a.ws + WS_CTL) + CW_CNT + layer * 512;
        int acc = 0;
        for (int b = 0; b < NBK; ++b) { const int c = (int)__hip_atomic_load(cnt + b * 16, __ATOMIC_RELAXED, __HIP_MEMORY_SCOPE_AGENT); tt[b] = acc; tt[25 + b] = c; acc += (c + 255) >> 8; }
        tt[NBK] = acc;
    }
    __syncthreads();
}
__device__ __forceinline__ void final_norm_phase(const Args& a, int gw, int NGW) {
    int tid = threadIdx.x; asm volatile("" : "+v"(tid));
    const int lane = tid & 63;
    const float* gain = a.in[5]; const bf16* hbf = (const bf16*)(a.ws + WS_HBF);
    for (int m = gw; m < M; m += NGW) {
        const GAS v4u* xr = (const GAS v4u*)(hbf + (size_t)m * D) + lane;
        float v[2][8]; float s = 0.f;
#pragma unroll
        for (int j = 0; j < 2; ++j) { unpack8(xr[64 * j], v[j]);
#pragma unroll
            for (int e = 0; e < 8; ++e) s = fmaf(v[j][e], v[j][e], s); }
        s = wave_sum(s);
        const float ri = rsqrtf(s * (1.f / D) + EPS);
        GAS f32x4* orow = (GAS f32x4*)(a.out + (size_t)m * D) + 2 * lane;
#pragma unroll
        for (int j = 0; j < 2; ++j) { const GAS f32x4* gp = (const GAS f32x4*)gain + 2 * lane + 128 * j;
            const f32x4 g0 = gp[0], g1 = gp[1];
            orow[128 * j] = (f32x4){v[j][0] * ri * g0.x, v[j][1] * ri * g0.y, v[j][2] * ri * g0.z, v[j][3] * ri * g0.w};
            orow[128 * j + 1] = (f32x4){v[j][4] * ri * g1.x, v[j][5] * ri * g1.y, v[j][6] * ri * g1.z, v[j][7] * ri * g1.w}; }
    }
}
__global__ void __launch_bounds__(NTHREADS, 2) fwd(Args args) {
    extern __shared__ __attribute__((aligned(16))) unsigned char lds_raw[];
    LAS unsigned char* lds = (LAS unsigned char*)lds_raw;
    const int tid = threadIdx.x, lane0 = tid & 63, wave = __builtin_amdgcn_readfirstlane(tid >> 6);
    const int G = gridDim.x; const int bx = blockIdx.x;
    const int vcu = (G % 8 == 0) ? (bx % 8) * (G / 8) + bx / 8 : bx;
    gu32* ctl = (gu32*)(args.ws + WS_CTL);
    volatile LAS unsigned* MISC = (volatile LAS unsigned*)(lds + MISC_OFF);
    for (int u = tid; u < (LDS_BYTES - LDSCTL_OFF) / 4; u += NTHREADS) ((LAS unsigned*)(lds + LDSCTL_OFF))[u] = 0u;
    __syncthreads();
    XcdBarrier bar; bar.bar = (unsigned*)(ctl + CW_BAR); bar.x = 0; bar.st = nullptr;
    if (args.use_bar) bar = xcd_barrier_post((unsigned*)(ctl + CW_BAR), MISC + 8);
    const int lo = args.ph_lo, hi = args.ph_hi;
#define IN(k) (lo <= (k) && (k) < hi)
#ifdef TIME_PHASE
#define STAMP(k) do { if (tid == 0) MISC[16 + (k)] = (unsigned)__builtin_amdgcn_s_memrealtime(); } while (0)
#else
#define STAMP(k) do { } while (0)
#endif
#define SEAM(k) do { if (IN(k) && IN((k) + 1)) xcd_barrier(bar); STAMP((k) + 1); } while (0)
    const int gw = vcu * NWAVES + wave, NGW = G * NWAVES;

    STAMP(0);
    if (IN(0)) p0_prologue(args, lds, gw, NGW, wave, lane0);
    SEAM(0);
    for (int layer = 0; layer < 2; ++layer) {
        const int pb = 1 + layer * NPH;
        int lane = lane0; asm volatile("" : "+v"(lane));
        unsigned char* ws = args.ws; asm volatile("" : "+s"(ws));
        unsigned char* wb = layer == 0 ? ws + WS_W0 : (unsigned char*)args.out;
        if (IN(pb + 0)) {
            const int ldp = layer == 0 ? GLA_LDP : HG_LDP;
            pg8::Gemm g{(const bf16*)(ws + WS_HBF), (const bf16*)(wb + REL_WIN), M, ldp, D, D, D}; pg8::StaticOrder S; S.init(M, ldp, G, bx);
            pg8::EpiRowScale E{(bf16*)(ws + WS_PROJ), ldp, layer == 0 ? (const float*)(ws + WS_RINV) : (const float*)(ws + WS_ROWSS), layer};
            pg8::gemm_phase<pg8::EpiRowScale, pg8::StaticOrder, true>(lds, g, S, E);
        }
        SEAM(pb + 0);
        if (IN(pb + 1)) { if (layer == 0) { mixer_phase_a<0>(args, lds, vcu, G); memkv_tiles(args, lds, vcu, G); } else mixer_phase_a<1>(args, lds, vcu, G); }
        SEAM(pb + 1);
        if (IN(pb + 2)) { if (layer == 0) mixer_scan<0>(args, vcu, G); else mixer_scan<1>(args, vcu, G); }
        SEAM(pb + 2);
        if (IN(pb + 3)) { if (layer == 0) { mixer_phase_b<0>(args, lds, vcu, G); memattn_phase<0>(args, lds, vcu, G); } else { mixer_phase_b<1>(args, lds, vcu, G); memattn_phase<1>(args, lds, vcu, G); } }
        SEAM(pb + 3);
        if (IN(pb + 4)) {
            const int ldp = layer == 0 ? GLA_LDP : HG_LDP, cv = layer == 0 ? GLA_CV : HG_CV;
            pg8::Gemm g{(const bf16*)(ws + WS_PROJ) + cv, (const bf16*)(wb + REL_WOUT), M, D, D, ldp, D}; pg8::StaticOrder S; S.init(M, D, G, bx);
            pg8::EpiResid E{(bf16*)(ws + WS_HBF), D};
            pg8::gemm_phase<pg8::EpiResid, pg8::StaticOrder, true>(lds, g, S, E);
        }
        SEAM(pb + 4);
        if (IN(pb + 5)) route_phase(args, layer, lds, gw, NGW);
        SEAM(pb + 5);
        if (IN(pb + 6)) {
            moe_tile_table(args, layer, lds);
            pg8::Gemm g{(const bf16*)(ws + WS_HBF), (const bf16*)(wb + REL_WUP), M, 1024, D, D, D};
            pg8::MoeOrder<0> S{(const LAS int*)(lds + TT_OFF), G, vcu, (const SlotRec*)(ws + WS_SLOT)};
            pg8::EpiMoeUp E{(bf16*)(ws + WS_HACT), (const SlotRec*)(ws + WS_SLOT)};
            pg8::gemm_phase<pg8::EpiMoeUp, pg8::MoeOrder<0>, true>(lds, g, S, E);
        }
        SEAM(pb + 6);
        if (IN(pb + 7)) {
            moe_tile_table(args, layer, lds);
            pg8::Gemm g{(const bf16*)(ws + WS_HACT), (const bf16*)(wb + REL_WDN), M, D, 2 * FF, 2 * FF, FF};
            pg8::MoeOrder<1> S{(const LAS int*)(lds + TT_OFF), G, vcu, (const SlotRec*)(ws + WS_SLOT)};
            pg8::EpiMoeDown E{(bf16*)(ws + WS_HBF), (const SlotRec*)(ws + WS_SLOT), (bf16*)(ws + WS_DUMMY), layer == 0 ? (float*)(ws + WS_ROWSS) : nullptr};
            pg8::gemm_phase<pg8::EpiMoeDown, pg8::MoeOrder<1>, true>(lds, g, S, E);
        }
        SEAM(pb + 7);
    }
    if (IN(1 + 2 * NPH)) final_norm_phase(args, gw, NGW);
#ifdef TIME_PHASE
    STAMP(2 * NPH + 2);
    if (bx == 0 && tid == 0) { const unsigned span = (MISC[16 + TIME_PHASE_END] - MISC[16 + TIME_PHASE]) * TIME_AMP; const unsigned t0 = (unsigned)__builtin_amdgcn_s_memrealtime();
        while ((unsigned)__builtin_amdgcn_s_memrealtime() - t0 < span) __builtin_amdgcn_s_sleep(8); }
#endif
#undef IN
#undef SEAM
}
#ifndef N_LAUNCHES
#define N_LAUNCHES 1
#endif
constexpr int NPHASES = 2 * NPH + 2;
extern "C" void kernel_launch(void* const* d_in, const int* in_sizes, int n_in, void* d_out, int out_size, void* d_ws, size_t ws_size, hipStream_t stream) {
    static int grid = 0;
    if (grid == 0) {
        int dev = 0, cus = 0, per_cu = 0;
        if (n_in != 21 || out_size != M * D || ws_size < 256 * MiB) { fprintf(stderr, "kernel_launch: unexpected problem shape (n_in %d, out %d, ws %zu)\n", n_in, out_size, ws_size); grid = -1; return; }
        if (hipGetDevice(&dev) != hipSuccess || hipDeviceGetAttribute(&cus, hipDeviceAttributeMultiprocessorCount, dev) != hipSuccess) { fprintf(stderr, "kernel_launch: device query failed\n"); grid = -1; return; }
        if (hipFuncSetAttribute((const void*)fwd, hipFuncAttributeMaxDynamicSharedMemorySize, LDS_BYTES) != hipSuccess) { fprintf(stderr, "kernel_launch: hipFuncSetAttribute failed\n"); grid = -1; return; }
        if (hipOccupancyMaxActiveBlocksPerMultiprocessor(&per_cu, (const void*)fwd, NTHREADS, LDS_BYTES) != hipSuccess || per_cu < 1) { fprintf(stderr, "kernel_launch: occupancy query reports %d workgroups per CU; nothing launched\n", per_cu); (void)hipGetLastError(); grid = -1; return; }
        (void)hipGetLastError();
        grid = cus;
    }
    if (grid < 0) return;
    (void)hipMemsetAsync((char*)d_ws + WS_CTL, 0, CTL_ZERO_BYTES, stream);
    Args a{};
    for (int i = 0; i < 21; ++i) a.in[i] = (const float*)d_in[i];
    a.out = (float*)d_out; a.ws = (unsigned char*)d_ws;
    if (N_LAUNCHES == 1) { a.ph_lo = 0; a.ph_hi = NPHASES; a.use_bar = 1; hipLaunchKernelGGL(fwd, dim3(grid), dim3(NTHREADS), LDS_BYTES, stream, a); }
    else for (int p = 0; p < NPHASES; ++p) { a.ph_lo = p; a.ph_hi = p + 1; a.use_bar = 0; hipLaunchKernelGGL(fwd, dim3(grid), dim3(NTHREADS), LDS_BYTES, stream, a); }
}
```

```cpp
#include <hip/hip_runtime.h>
#include <cstdio>
#include <cstdint>

#define GAS __attribute__((address_space(1)))
#define LAS __attribute__((address_space(3)))
typedef unsigned short bf16;
typedef unsigned v4u __attribute__((ext_vector_type(4)));
typedef unsigned v2u __attribute__((ext_vector_type(2)));
typedef float f32x4 __attribute__((ext_vector_type(4)));
typedef short bf16x8 __attribute__((ext_vector_type(8)));
typedef short s16x4 __attribute__((ext_vector_type(4)));
typedef GAS unsigned gu32;
typedef GAS unsigned long long gu64;
#define RLX_AGENT __ATOMIC_RELAXED, __HIP_MEMORY_SCOPE_AGENT
#define LDS_WAIT() asm volatile("s_waitcnt lgkmcnt(0)" ::: "memory")
#define VM_WAIT() asm volatile("s_waitcnt vmcnt(0)" ::: "memory")

constexpr int D = 1024, BATCH = 4, SEQ = 4096, M = BATCH * SEQ, NMEM = 256, MROWS = BATCH * NMEM;
constexpr int MIXW = 768, MEMW = 256, CH = 64, NCH = SEQ / CH;
constexpr int GLA_H = 4, GLA_KW = 512, GLA_DK = 128, GLA_DV = 192, GLA_IN = 2832, GLA_RANK = 16;
constexpr int HG_H = 6, HG_DK = 128, HG_DV = 128, HG_IN = 3328;
constexpr int NG = 4, EPG = 4, NE = 16, FF = 256;
constexpr float EPS = 1e-6f;
constexpr int GLA_LDP = 3072, GLA_CQ = 0, GLA_CK = 512, GLA_CG = 1024, GLA_CV = 1792, GLA_CMQ = 2560, GLA_CR = 2816;
constexpr int HG_LDP = 3328, HG_CQ = 0, HG_CF = 768, HG_CG = 1536, HG_CV = 2304, HG_CMQ = 3072;

__device__ __forceinline__ float bf2f(bf16 b) { return __uint_as_float(((unsigned)b) << 16); }
__device__ __forceinline__ bf16 f2bf(float f) { return __builtin_bit_cast(unsigned short, (__bf16)f); }
__device__ __forceinline__ unsigned pk2(float lo, float hi) { return (unsigned)f2bf(lo) | ((unsigned)f2bf(hi) << 16); }
__device__ __forceinline__ float wave_sum(float v) {
#pragma unroll
    for (int o = 32; o >= 1; o >>= 1) v += __shfl_xor(v, o);
    return v;
}
__device__ __forceinline__ float wave_max(float v) {
#pragma unroll
    for (int o = 32; o >= 1; o >>= 1) v = fmaxf(v, __shfl_xor(v, o));
    return v;
}
__device__ __forceinline__ float sigmoidf_(float x) { return 1.f / (1.f + __expf(-x)); }
__device__ __forceinline__ float siluf_(float x) { return x / (1.f + __expf(-x)); }
__device__ __forceinline__ float logsigmoidf_(float x) { return fminf(x, 0.f) - log1pf(__expf(-fabsf(x))); }

#define N_LAUNCHES 1
namespace pg8 {
#define PG8_LAS __attribute__((address_space(3)))
typedef unsigned short bf16_t;
typedef short bf16x8 __attribute__((ext_vector_type(8)));
typedef float f32x4 __attribute__((ext_vector_type(4)));
typedef unsigned u32x4 __attribute__((ext_vector_type(4)));
constexpr int BM = 256, BK = 64, HALF = 128, HTB = HALF * BK * 2  , STAGE_BYTES = 8 * HTB, NXCD = 8, WGM = 8;

__host__ __device__ __forceinline__ int lds_byte(int r, int c) { const int st = (r >> 4) * 2 + (c >> 5), rr = r & 15, cc = c & 31, ob = rr * 64 + cc * 2; return st * 1024 + (ob ^ (((ob >> 9) & 1) << 5)); }
__host__ __device__ __forceinline__ void stage_rc(int b, int& R, int& C) { const int st = b / 1024, sb = b % 1024, swz = sb ^ (((sb >> 9) & 1) << 5); R = (st >> 1) * 16 + swz / 64; C = (st & 1) * 32 + (swz % 64) / 2; }
__host__ __device__ __forceinline__ int perm32(int rho) { const int n = rho >> 4, i = rho & 15; return 8 * (i >> 2) + 4 * n + (i & 3); }

struct Unit { int pm, pn; int x0, x1, x2, x3; };
struct Gemm { const bf16_t* A; const bf16_t* Bt; int M, N, K, lda, ldb; };

struct StaticOrder {
    int nM, nN, nwg, G, c;
    __host__ __device__ void init(int M, int N, int G_, int c_) { nM = M / BM; nN = N / BM; nwg = nM * nN; G = G_; c = c_; }
    __host__ __device__ bool next(int i, Unit& u) const {
        const long L = (long)i * G + c; if (L >= nwg) return false;
        int wgid = (int)L; { const int q = nwg / NXCD, r = nwg % NXCD, xcd = wgid % NXCD, off = wgid / NXCD; wgid = (xcd < r ? xcd * (q + 1) : r * (q + 1) + (xcd - r) * q) + off; }
        const int nig = WGM * nN, gid = wgid / nig, fm = gid * WGM, gsz = (nM - fm) < WGM ? (nM - fm) : WGM;
        u.pm = fm + ((wgid % nig) % gsz); u.pn = (wgid % nig) / gsz; return true;
    }
    __device__ __forceinline__ void a_ready(const Unit&) const {}
    __device__ __forceinline__ void done(const Unit&) const {}
    static constexpr bool GATHER = false;
    __device__ __forceinline__ unsigned a_off(const Gemm& g, const Unit& u, int r) const { return 0u; }
    __device__ __forceinline__ size_t b_off(const Gemm& g, const Unit& u) const { return (size_t)u.pn * BM * g.ldb * 2; }
    __device__ __forceinline__ long b_delta(const Gemm&, const Unit&) const { return 0; }
};
__device__ __forceinline__ unsigned cvt_pk_bf16(float lo, float hi) { unsigned r; asm volatile("v_cvt_pk_bf16_f32 %0, %1, %2" : "=v"(r) : "v"(lo), "v"(hi)); return r; }
template <class Epi, class Sched, bool ALIGN_EPI = false>
__device__ __forceinline__ void gemm_phase(PG8_LAS unsigned char* lds, const Gemm g, const Sched& S, const Epi& E) {
    int tid_ = threadIdx.x; asm volatile("" : "+v"(tid_));
    const int tid = tid_, wid = __builtin_amdgcn_readfirstlane(tid >> 6), lane = tid & 63, wr = wid >> 2, wc = wid & 3, fr = lane & 15, fq = lane >> 4;
    const int K = g.K, nt = K / BK;
    int Rst[2], Cst[2]; unsigned voffB[2];
#pragma unroll
    for (int i = 0; i < 2; ++i) { int R, C; stage_rc(tid * 16 + i * 8192, R, C); const int Rb = Epi::PERM ? ((R & ~31) + perm32(R & 31)) : R;
        Rst[i] = R; Cst[i] = C * 2; voffB[i] = (unsigned)(Rb * g.ldb + C) * 2u; }
    const unsigned kstep = (unsigned)(BK * 2);
    const size_t hstepB = (size_t)HALF * g.ldb * 2;
    const unsigned ldsw = (unsigned)wid * 1024u;
    const int aoff = lds_byte(wr * 64 + fr, fq * 8), boff = lds_byte(wc * 32 + fr, fq * 8);
#define PG8_SA(b, h) (((b) * 2 + (h)) * HTB)
#define PG8_SB(b, h) ((4 + (b) * 2 + (h)) * HTB)
#define PG8_STAGE_B(bufoff, gbase) do { _Pragma("unroll") for (int _i = 0; _i < 2; ++_i) \
        __builtin_amdgcn_global_load_lds((const unsigned*)((const char*)(gbase) + voffB[_i]), (PG8_LAS unsigned*)(lds + (bufoff) + ldsw + _i * 8192), 16, 0, 0); } while (0)
#define PG8_STAGE_A(bufoff, so, o0, o1) do { const char* _ab = (const char*)g.A + (so); \
        __builtin_amdgcn_global_load_lds((const unsigned*)(_ab + (o0)), (PG8_LAS unsigned*)(lds + (bufoff) + ldsw), 16, 0, 0); \
        __builtin_amdgcn_global_load_lds((const unsigned*)(_ab + (o1)), (PG8_LAS unsigned*)(lds + (bufoff) + ldsw + 8192), 16, 0, 0); } while (0)
#define PG8_LDA(dst, b, h) do { _Pragma("unroll") for (int m = 0; m < 4; ++m) _Pragma("unroll") for (int k = 0; k < 2; ++k) dst[m][k] = *(const PG8_LAS bf16x8*)(lds + PG8_SA(b, h) + aoff + m * 2048 + k * 1024); } while (0)
#define PG8_LDB(dst, b, h) do { _Pragma("unroll") for (int n = 0; n < 2; ++n) _Pragma("unroll") for (int k = 0; k < 2; ++k) dst[n][k] = *(const PG8_LAS bf16x8*)(lds + PG8_SB(b, h) + boff + n * 2048 + k * 1024); } while (0)
#define PG8_MMA(ai, bj, At, Bt) do { __builtin_amdgcn_s_setprio(1); _Pragma("unroll") for (int m = 0; m < 4; ++m) _Pragma("unroll") for (int n = 0; n < 2; ++n) _Pragma("unroll") for (int k = 0; k < 2; ++k) \
        acc[ai][bj][m][n] = __builtin_amdgcn_mfma_f32_16x16x32_bf16(Bt[n][k], At[m][k], acc[ai][bj][m][n], 0, 0, 0); __builtin_amdgcn_s_setprio(0); } while (0)
#define PG8_WAIT_V(n) asm volatile("s_waitcnt vmcnt(" #n ")" ::: "memory")
#define PG8_WAIT_L(n) asm volatile("s_waitcnt lgkmcnt(" #n ")" ::: "memory")
#define PG8_BAR __builtin_amdgcn_s_barrier()
#define PG8_SCHED __builtin_amdgcn_sched_barrier(0)
    Unit cur, nxt; int ui = 0;
    if (!S.next(0, cur)) return;
    f32x4 acc[2][2][4][2];
#pragma unroll
    for (int a = 0; a < 2; ++a)
#pragma unroll
        for (int b = 0; b < 2; ++b)
#pragma unroll
            for (int m = 0; m < 4; ++m)
#pragma unroll
                for (int n = 0; n < 2; ++n) acc[a][b][m][n] = (f32x4){0.f, 0.f, 0.f, 0.f};
    bf16x8 At[4][2], B0[2][2], B1[2][2];
    S.a_ready(cur);
    constexpr bool GA = Sched::GATHER;
    const unsigned voffA0 = (unsigned)(Rst[0] * g.lda) * 2u + Cst[0], voffA1 = (unsigned)(Rst[1] * g.lda) * 2u + Cst[1];
    const size_t hstepA = (size_t)HALF * g.lda * 2;
    unsigned vc00 = voffA0, vc01 = voffA1, vc10 = voffA0, vc11 = voffA1; size_t sc0 = 0, sc1 = 0;
    if constexpr (GA) { vc00 = S.a_off(g, cur, Rst[0]) + Cst[0]; vc01 = S.a_off(g, cur, Rst[1]) + Cst[1]; vc10 = S.a_off(g, cur, HALF + Rst[0]) + Cst[0]; vc11 = S.a_off(g, cur, HALF + Rst[1]) + Cst[1]; }
    else { sc0 = (size_t)cur.pm * 2 * hstepA; sc1 = sc0 + hstepA; }
    const char* cB = (const char*)g.Bt + S.b_off(g, cur); long cD = S.b_delta(g, cur);
    PG8_STAGE_B(PG8_SB(0, 0), cB); PG8_STAGE_B(PG8_SB(0, 1), cB + hstepB); PG8_STAGE_A(PG8_SA(0, 0), sc0, vc00, vc01); PG8_STAGE_A(PG8_SA(0, 1), sc1, vc10, vc11);
    if (wr == 1) PG8_BAR;
    PG8_WAIT_V(2); PG8_BAR;
    PG8_STAGE_B(PG8_SB(1, 0), cB + kstep); PG8_STAGE_A(PG8_SA(1, 0), sc0 + kstep, vc00, vc01); PG8_STAGE_B(PG8_SB(1, 1), cB + hstepB + kstep);
    PG8_WAIT_V(6); PG8_BAR;
    for (;;) {
        const bool has_next = S.next(ui + 1, nxt);
        unsigned vn00 = vc00, vn01 = vc01, vn10 = vc10, vn11 = vc11; size_t sn0 = sc0, sn1 = sc1; const char* nB = cB; long nD = cD;
        if (has_next) {
            if constexpr (GA) { vn00 = S.a_off(g, nxt, Rst[0]) + Cst[0]; vn01 = S.a_off(g, nxt, Rst[1]) + Cst[1]; vn10 = S.a_off(g, nxt, HALF + Rst[0]) + Cst[0]; vn11 = S.a_off(g, nxt, HALF + Rst[1]) + Cst[1]; }
            else { sn0 = (size_t)nxt.pm * 2 * hstepA; sn1 = sn0 + hstepA; }
            nB = (const char*)g.Bt + S.b_off(g, nxt); nD = S.b_delta(g, nxt); }
#pragma nounroll
        for (int t = 0; t < nt; t += 2) {
            const bool last = (t == nt - 2);
            const unsigned k1 = (unsigned)(t + 1) * kstep, k2 = (unsigned)(t + 2) * kstep;
            unsigned o00 = vc00, o01 = vc01, o10 = vc10, o11 = vc11;
            if constexpr (GA) { o00 = last ? vn00 : vc00; o01 = last ? vn01 : vc01; o10 = last ? vn10 : vc10; o11 = last ? vn11 : vc11; }
            const size_t s20 = last ? sn0 : sc0 + k2, s21 = last ? sn1 : sc1 + k2;
            const char* b2 = last ? nB : cB + k2 + ((t + 2) >= nt / 2 ? cD : 0); const char* b3 = b2 + kstep;
            if (last && has_next) S.a_ready(nxt);
            PG8_LDB(B0, 0, 0); PG8_LDB(B1, 0, 1); PG8_SCHED; PG8_LDA(At, 0, 0); PG8_STAGE_A(PG8_SA(1, 1), sc1 + k1, vc10, vc11);
            PG8_WAIT_V(8); PG8_WAIT_L(0); PG8_BAR; PG8_MMA(0, 0, At, B0); PG8_MMA(0, 1, At, B1); PG8_BAR; PG8_SCHED;
            PG8_LDA(At, 0, 1); PG8_STAGE_B(PG8_SB(0, 0), b2); PG8_STAGE_B(PG8_SB(0, 1), b2 + hstepB); PG8_STAGE_A(PG8_SA(0, 0), s20, o00, o01);
            PG8_WAIT_V(8); PG8_WAIT_L(0); PG8_BAR; PG8_MMA(1, 0, At, B0); PG8_MMA(1, 1, At, B1); PG8_BAR; PG8_SCHED;
            PG8_LDB(B0, 1, 0); PG8_LDB(B1, 1, 1); PG8_SCHED; PG8_LDA(At, 1, 0); PG8_STAGE_A(PG8_SA(0, 1), s21, o10, o11);
            PG8_WAIT_V(8); PG8_WAIT_L(0); PG8_BAR; PG8_MMA(0, 0, At, B0); PG8_MMA(0, 1, At, B1); PG8_BAR; PG8_SCHED;
            PG8_LDA(At, 1, 1); PG8_STAGE_B(PG8_SB(1, 0), b3); PG8_STAGE_B(PG8_SB(1, 1), b3 + hstepB); PG8_STAGE_A(PG8_SA(1, 0), s20 + kstep, o00, o01);
            PG8_WAIT_V(8); PG8_WAIT_L(0); PG8_BAR; PG8_MMA(1, 0, At, B0); PG8_MMA(1, 1, At, B1); PG8_BAR; PG8_SCHED;
        }
        if constexpr (ALIGN_EPI) { if (wr == 0) PG8_BAR; }
        if constexpr (!Epi::AFTER_DRAIN) { E(acc, cur, wr, wc, fr, fq); S.done(cur); }
        if (!has_next) break;
#pragma unroll
        for (int a = 0; a < 2; ++a)
#pragma unroll
            for (int b = 0; b < 2; ++b)
#pragma unroll
                for (int m = 0; m < 4; ++m)
#pragma unroll
                    for (int n = 0; n < 2; ++n) acc[a][b][m][n] = (f32x4){0.f, 0.f, 0.f, 0.f};
        cur = nxt; vc00 = vn00; vc01 = vn01; vc10 = vn10; vc11 = vn11; sc0 = sn0; sc1 = sn1; cB = nB; cD = nD; ++ui;
        if constexpr (ALIGN_EPI) { if (wr == 1) PG8_BAR; }
    }
    PG8_WAIT_V(0);
    if constexpr (!ALIGN_EPI) { if (wr == 0) PG8_BAR; }
    PG8_BAR;
    if constexpr (Epi::AFTER_DRAIN) { E.fused(acc, cur, wr, wc, fr, fq, lds, wid, lane); S.done(cur); }
#undef PG8_SA
#undef PG8_SB
#undef PG8_STAGE_A
#undef PG8_STAGE_B
#undef PG8_LDA
#undef PG8_LDB
#undef PG8_MMA
#undef PG8_WAIT_V
#undef PG8_WAIT_L
#undef PG8_BAR
#undef PG8_SCHED
}
}
#define XB_TMO      128
#define XB_XCNT(j)  (256  + 64 * (j))
#define XB_XSUB(j)  (1280 + 64 * (j))
#define XB_XGEN(j)  (2304 + 64 * (j))
#define XB_TOP      3328
#define XB_TOPGEN   3392
#define XCD_BAR_WORDS 3456
#define XB_SPIN_CAP (1u << 18)

__device__ __forceinline__ unsigned xb_ld(unsigned* p)              { return __hip_atomic_load(p, __ATOMIC_RELAXED, __HIP_MEMORY_SCOPE_AGENT); }
__device__ __forceinline__ unsigned xb_add(unsigned* p, unsigned v) { return __hip_atomic_fetch_add(p, v, __ATOMIC_RELAXED, __HIP_MEMORY_SCOPE_AGENT); }
__device__ __forceinline__ unsigned xb_xcc_id() { return (unsigned)__builtin_amdgcn_s_getreg((3 << 11) | 20) & 0xFu; }
#define XB_SPIN(cond, bar) do { unsigned _sp = 0; while (cond) { __builtin_amdgcn_s_sleep(1); \
    if ((++_sp & 255u) == 0u) { if (xb_ld(&(bar)[XB_TMO])) break; if (_sp > XB_SPIN_CAP) { atomicAdd(&(bar)[XB_TMO], 1u); break; } } } } while (0)

struct XcdBarrier {
    unsigned* bar; unsigned x;
    volatile LAS unsigned* st;
};

__device__ __forceinline__ XcdBarrier xcd_barrier_post(unsigned* bar, volatile LAS unsigned* st) {
    XcdBarrier b; b.bar = bar; b.x = xb_xcc_id(); b.st = st;
    if (threadIdx.x == 0) (void)xb_add(&bar[XB_XCNT(b.x)], 1u);
    return b;
}
__device__ __forceinline__ void xcd_barrier_complete(unsigned* bar, unsigned x, unsigned& nloc, unsigned& nx) {
    const unsigned G = gridDim.x * gridDim.y * gridDim.z;
    unsigned sum, cnt, mine, sp = 0u;
    for (;;) {
        sum = 0u; cnt = 0u; mine = 0u;
#pragma unroll
        for (unsigned j = 0; j < 16; ++j) { const unsigned c = xb_ld(&bar[XB_XCNT(j)]); sum += c; cnt += (c > 0u) ? 1u : 0u; mine = (j == x) ? c : mine; }
        if (sum == G) break;
        __builtin_amdgcn_s_sleep(1);
        if ((++sp & 255u) == 0u) { if (xb_ld(&bar[XB_TMO])) break; if (sp > XB_SPIN_CAP) { atomicAdd(&bar[XB_TMO], 1u); break; } }
    }
    nloc = mine > 0u ? mine : 1u; nx = cnt > 0u ? cnt : 1u;
}

__device__ __forceinline__ void xcd_barrier(const XcdBarrier& b) {
    asm volatile("s_waitcnt vmcnt(0)" ::: "memory");
    __syncthreads();
    if (threadIdx.x == 0) {
        unsigned* bar = b.bar;
        __builtin_amdgcn_s_waitcnt(0);
        unsigned nloc = b.st[0], nx = b.st[1];
        if (nloc == 0u) { xcd_barrier_complete(bar, b.x, nloc, nx); b.st[0] = nloc; b.st[1] = nx; }
        const unsigned old = xb_add(&bar[XB_XSUB(b.x)], 1u);
        const unsigned gen = old / nloc;
        if (old + 1u == (gen + 1u) * nloc) {
            __builtin_amdgcn_fence(__ATOMIC_RELEASE, "agent");
            asm volatile("s_waitcnt vmcnt(0)" ::: "memory");
            const unsigned og = xb_add(&bar[XB_TOP], 1u);
            const unsigned tg = og / nx;
            if (og + 1u == (tg + 1u) * nx) xb_add(&bar[XB_TOPGEN], 1u);
            else XB_SPIN(xb_ld(&bar[XB_TOPGEN]) == tg, bar);
            __builtin_amdgcn_fence(__ATOMIC_ACQUIRE, "agent");
            xb_add(&bar[XB_XGEN(b.x)], 1u);
            asm volatile("s_waitcnt vmcnt(0)" ::: "memory");
        } else {
            XB_SPIN(xb_ld(&bar[XB_XGEN(b.x)]) == gen, bar);
            __builtin_amdgcn_fence(__ATOMIC_ACQUIRE, "agent");
            asm volatile("s_waitcnt vmcnt(0)" ::: "memory");
        }
    }
    __syncthreads();
}
constexpr size_t MiB = 1u << 20;
constexpr size_t WS_CTL = 0, CTL_ZERO_BYTES = 1 * MiB;
constexpr size_t WS_W0 = 1 * MiB;
constexpr size_t REL_WIN = 0;
constexpr size_t REL_WOUT = REL_WIN + 13 * MiB / 2;
constexpr size_t REL_WKV = REL_WOUT + 2 * MiB;
constexpr size_t REL_WUP = REL_WKV + 1 * MiB;
constexpr size_t REL_WDN = REL_WUP + 16 * MiB;
constexpr size_t REL_WEND = REL_WDN + 8 * MiB;
constexpr size_t WS_HBF = 35 * MiB;
constexpr size_t WS_MEMBF = WS_HBF + 32 * MiB;
constexpr size_t WS_PROJ = 69 * MiB;
constexpr size_t WS_STATE = 173 * MiB;
constexpr size_t WS_MISC = 250 * MiB;
constexpr size_t WS_RINV = WS_MISC;
constexpr size_t WS_RINVM = WS_RINV + 64 * 1024;
constexpr size_t WS_KVMEM = WS_RINVM + 4096;
constexpr size_t WS_DECAY = WS_KVMEM + 2 * MiB;
constexpr size_t WS_DUMMY = WS_DECAY + 1 * MiB;
constexpr size_t WS_ROWSS = WS_DUMMY + 4096;
constexpr size_t WS_END_OPT = WS_ROWSS + 1 * MiB;
static_assert(WS_W0 + REL_WEND <= WS_HBF && REL_WEND <= (size_t)M * D * 4 && WS_END_OPT <= 256 * MiB, "ws map");
constexpr int CW_ROWSS = 16384;
constexpr int CW_BAR = 4096;

constexpr int RING_BYTES = 131072;
constexpr int LDSCTL_OFF = RING_BYTES, MISC_OFF = LDSCTL_OFF + 320;
constexpr int LDS_BYTES = 147456;
constexpr int NWAVES = 8, NTHREADS = 512;
constexpr int NPH = 8;

struct Args {
    const float* in[21]; float* out; unsigned char* ws;
    int ph_lo, ph_hi, use_bar, pad;
};

namespace pg8 {
struct EpiRowScale {
    static constexpr bool PERM = true, AFTER_DRAIN = false;
    bf16_t* O; int ldc; const float* rs; int ssmode;
    __device__ __forceinline__ void operator()(const f32x4 (&acc)[2][2][4][2], const Unit& u, int wr, int wc, int fr, int fq) const {
        const int row0 = u.pm * BM + wr * 64 + fr, col0 = u.pn * BM + wc * 32 + 8 * fq;
#pragma unroll
        for (int ai = 0; ai < 2; ++ai)
#pragma unroll
            for (int m = 0; m < 4; ++m) { const int row = row0 + ai * HALF + m * 16; float s;
                if (ssmode) { const f32x4* pp = (const f32x4*)(rs + (size_t)row * 16); const f32x4 p0 = pp[0], p1 = pp[1], p2 = pp[2], p3 = pp[3];
                    s = rsqrtf((((p0.x + p0.y) + (p0.z + p0.w)) + ((p1.x + p1.y) + (p1.z + p1.w)) + ((p2.x + p2.y) + (p2.z + p2.w)) + ((p3.x + p3.y) + (p3.z + p3.w))) * (1.f / D) + EPS); }
                else s = rs[row]; bf16_t* rowp = O + (size_t)row * ldc + col0;
#pragma unroll
                for (int bj = 0; bj < 2; ++bj) { const f32x4 v0 = acc[ai][bj][m][0] * s, v1 = acc[ai][bj][m][1] * s;
                    u32x4 w; w.x = cvt_pk_bf16(v0[0], v0[1]); w.y = cvt_pk_bf16(v0[2], v0[3]); w.z = cvt_pk_bf16(v1[0], v1[1]); w.w = cvt_pk_bf16(v1[2], v1[3]);
                    *(u32x4*)(rowp + bj * HALF) = w; } }
    }
};
}

__device__ __forceinline__ int win_dst_row(int layer, int n, float& sc) {
    sc = 1.f;
    if (layer == 0) {
        if (n < 512) { sc = 0.08838834764831845f; return GLA_CQ + n; }
        if (n < 1024) return GLA_CK + (n - 512);
        if (n < 1792) return GLA_CV + (n - 1024);
        if (n < 2560) return GLA_CG + (n - 1792);
        if (n < 2576) return GLA_CR + (n - 2560);
        return GLA_CMQ + (n - 2576);
    } else {
        if (n < 768) return HG_CQ + n;
        if (n < 1536) return HG_CF + (n - 768);
        if (n < 2304) return HG_CV + (n - 1536);
        if (n < 3072) return HG_CG + (n - 2304);
        return HG_CMQ + (n - 3072);
    }
}
__device__ __forceinline__ void row_to_bf16(const float* xrow, bf16* orow, float* rinv, int lane) {
    const GAS f32x4* xr = (const GAS f32x4*)xrow + lane;
    f32x4 v[4]; float s = 0.f;
#pragma unroll
    for (int j = 0; j < 4; ++j) { v[j] = xr[64 * j]; s += (v[j].x * v[j].x + v[j].y * v[j].y) + (v[j].z * v[j].z + v[j].w * v[j].w); }
    s = wave_sum(s);
    GAS unsigned long long* o8 = (GAS unsigned long long*)orow + lane;
#pragma unroll
    for (int j = 0; j < 4; ++j) o8[64 * j] = (unsigned long long)pk2(v[j].x, v[j].y) | ((unsigned long long)pk2(v[j].z, v[j].w) << 32);
    if (lane == 0) *rinv = rsqrtf(s * (1.f / D) + EPS);
}
struct P0Item { const float* W; const float* gain; bf16* WT; int K, N, mode, item; };
__device__ __forceinline__ P0Item p0_decode(const Args& a, int layer, int r) {
    unsigned char* wb = layer == 0 ? a.ws + WS_W0 : (unsigned char*)a.out;
    const int NIN = layer == 0 ? GLA_IN : HG_IN;
    const int I_IN = 16 * ((NIN + 31) / 32), I_OUT = 16 * 32, I_KV = 16 * 16, I_UP = 16 * 16 * 16;
    P0Item it;
    if (r < I_IN) { it.W = layer == 0 ? a.in[6] : a.in[10]; it.gain = a.in[2] + layer * D; it.WT = (bf16*)(wb + REL_WIN); it.K = D; it.N = NIN; it.mode = 1; it.item = r; return it; } r -= I_IN;
    if (r < I_OUT) { it.W = a.in[14] + (size_t)layer * D * D; it.gain = nullptr; it.WT = (bf16*)(wb + REL_WOUT); it.K = D; it.N = D; it.mode = 0; it.item = r; return it; } r -= I_OUT;
    if (r < I_KV) { it.W = a.in[13] + (size_t)layer * D * 512; it.gain = a.in[4] + layer * D; it.WT = (bf16*)(wb + REL_WKV); it.K = D; it.N = 512; it.mode = 0; it.item = r; return it; } r -= I_KV;
    if (r < I_UP) { const int e = r / 256; it.W = a.in[19] + ((size_t)layer * NE + e) * D * 512; it.gain = a.in[3] + layer * D; it.WT = (bf16*)(wb + REL_WUP) + (size_t)e * 512 * D; it.K = D; it.N = 512; it.mode = 2; it.item = r % 256; return it; } r -= I_UP;
    { const int e = r / 128; it.W = a.in[20] + ((size_t)layer * NE + e) * FF * D; it.gain = nullptr; it.WT = (bf16*)(wb + REL_WDN) + (size_t)e * D * FF; it.K = FF; it.N = D; it.mode = 0; it.item = r % 128; return it; }
}
__device__ __forceinline__ int p0_nitems(int layer) { const int NIN = layer == 0 ? GLA_IN : HG_IN; return 16 * ((NIN + 31) / 32) + 16 * 32 + 16 * 16 + 16 * 16 * 16 + 16 * 4 * 32; }
__device__ __forceinline__ void p0_load(const P0Item& it, int lane, f32x4 (&v)[8]) {
    const int nblk = (it.N + 31) / 32, kb = it.item / nblk, nb = it.item % nblk, k0 = 64 * kb, n0 = 32 * nb, nn = lane & 7, kq = lane >> 3;
    const int n = min(n0 + 4 * nn, it.N - 4); const float* gp = it.gain ? it.gain : it.W; const bool ug = it.gain != nullptr;
    float gk[8];
#pragma unroll
    for (int i = 0; i < 8; ++i) { const int kk = 8 * i + kq; v[i] = *(const GAS f32x4*)(it.W + (size_t)(k0 + kk) * it.N + n); gk[i] = gp[k0 + kk]; }
#pragma unroll
    for (int i = 0; i < 8; ++i) v[i] = v[i] * (ug ? gk[i] : 1.f);
}
__device__ __forceinline__ void p0_store(const P0Item& it, int layer, int lane, const f32x4 (&v)[8], LAS float* scr) {
    const int nblk = (it.N + 31) / 32, kb = it.item / nblk, nb = it.item % nblk, k0 = 64 * kb, n0 = 32 * nb, nn = lane & 7, kq = lane >> 3;
#pragma unroll
    for (int i = 0; i < 8; ++i) { const int kk = 8 * i + kq;
        scr[(4 * nn + 0) * 65 + kk] = v[i].x; scr[(4 * nn + 1) * 65 + kk] = v[i].y; scr[(4 * nn + 2) * 65 + kk] = v[i].z; scr[(4 * nn + 3) * 65 + kk] = v[i].w; }
    LDS_WAIT(); asm volatile("" ::: "memory");
    const int c = lane & 7;
#pragma unroll
    for (int j = 0; j < 4; ++j) {
        const int nl = (lane >> 3) + 8 * j, n = n0 + nl;
        float sc = 1.f; int dr = n;
        if (it.mode == 1) dr = win_dst_row(layer, n, sc);
        if (it.mode == 2) { const int f = n & 255, isb = n >> 8; dr = (f >> 7) * 256 + isb * 128 + (f & 127); }
        const LAS float* s = scr + nl * 65 + 8 * c;
        v4u o; o.x = pk2(s[0] * sc, s[1] * sc); o.y = pk2(s[2] * sc, s[3] * sc); o.z = pk2(s[4] * sc, s[5] * sc); o.w = pk2(s[6] * sc, s[7] * sc);
        if (n < it.N) *(GAS v4u*)(it.WT + (size_t)dr * it.K + k0 + 8 * c) = o;
    }
    LDS_WAIT(); asm volatile("" ::: "memory");
}
__device__ __forceinline__ void p0_prologue(const Args& a, LAS unsigned char* lds, int gw, int NGW, int wave, int lane) {
    unsigned char* ws = a.ws;
    LAS float* scr = (LAS float*)(lds + wave * 8448);
    for (int m = gw; m < M; m += 2 * NGW) {
        const int m2 = m + NGW;
        const GAS f32x4* x0 = (const GAS f32x4*)(a.in[0] + (size_t)m * D) + lane; const GAS f32x4* x1 = (const GAS f32x4*)(a.in[0] + (size_t)(m2 < M ? m2 : m) * D) + lane;
        f32x4 v0[4], v1[4]; float s0 = 0.f, s1 = 0.f;
#pragma unroll
        for (int j = 0; j < 4; ++j) { v0[j] = x0[64 * j]; v1[j] = x1[64 * j]; }
#pragma unroll
        for (int j = 0; j < 4; ++j) { s0 += (v0[j].x * v0[j].x + v0[j].y * v0[j].y) + (v0[j].z * v0[j].z + v0[j].w * v0[j].w); s1 += (v1[j].x * v1[j].x + v1[j].y * v1[j].y) + (v1[j].z * v1[j].z + v1[j].w * v1[j].w); }
        s0 = wave_sum(s0); s1 = wave_sum(s1);
        GAS unsigned long long* o0 = (GAS unsigned long long*)((bf16*)(ws + WS_HBF) + (size_t)m * D) + lane;
#pragma unroll
        for (int j = 0; j < 4; ++j) o0[64 * j] = (unsigned long long)pk2(v0[j].x, v0[j].y) | ((unsigned long long)pk2(v0[j].z, v0[j].w) << 32);
        if (lane == 0) ((float*)(ws + WS_RINV))[m] = rsqrtf(s0 * (1.f / D) + EPS);
        if (m2 < M) { GAS unsigned long long* o1 = (GAS unsigned long long*)((bf16*)(ws + WS_HBF) + (size_t)m2 * D) + lane;
#pragma unroll
            for (int j = 0; j < 4; ++j) o1[64 * j] = (unsigned long long)pk2(v1[j].x, v1[j].y) | ((unsigned long long)pk2(v1[j].z, v1[j].w) << 32);
            if (lane == 0) ((float*)(ws + WS_RINV))[m2] = rsqrtf(s1 * (1.f / D) + EPS); }
    }
    for (int m = gw; m < MROWS; m += NGW) row_to_bf16(a.in[1] + (size_t)m * D, (bf16*)(ws + WS_MEMBF) + (size_t)m * D, (float*)(ws + WS_RINVM) + m, lane);
    const int n0 = p0_nitems(0), ntot = n0 + p0_nitems(1);
    f32x4 va[8], vb[8], vc[8]; P0Item ia, ib, ic; int la = 0, lb = 0, lc = 0; bool ha, hb, hc;
#define P0_FETCH(j, it, l, v, h) do { const int _idx = gw + (j) * NGW; h = _idx < ntot; if (h) { l = _idx < n0 ? 0 : 1; it = p0_decode(a, l, l ? _idx - n0 : _idx); p0_load(it, lane, v); } } while (0)
    P0_FETCH(0, ia, la, va, ha); P0_FETCH(1, ib, lb, vb, hb);
    for (int j = 0;; j += 3) {
        P0_FETCH(j + 2, ic, lc, vc, hc); if (!ha) break; p0_store(ia, la, lane, va, scr);
        P0_FETCH(j + 3, ia, la, va, ha); if (!hb) break; p0_store(ib, lb, lane, vb, scr);
        P0_FETCH(j + 4, ib, lb, vb, hb); if (!hc) break; p0_store(ic, lc, lane, vc, scr);
    }
#undef P0_FETCH
}
template <int MIX> struct MixCfg;
template <> struct MixCfg<0> { static constexpr int H = GLA_H, DV = GLA_DV, LDP = GLA_LDP, CQ = GLA_CQ, CK = GLA_CK, CV = GLA_CV, CG = GLA_CG, CMQ = GLA_CMQ, VSTR = 416; };
template <> struct MixCfg<1> { static constexpr int H = HG_H, DV = HG_DV, LDP = HG_LDP, CQ = HG_CQ, CK = HG_CF, CV = HG_CV, CG = HG_CG, CMQ = HG_CMQ, VSTR = 288; };
constexpr int ISTR = 288;
constexpr int MX_G = 0, MX_T = 32768, MX_BL = 34816, MX_WG = 35328, MX_PREP_END = 43520;
constexpr int MXA_KD = 43520, MXA_V = 61952;
constexpr int MXB_ST = 0, MXB_QD = 55296, MXB_KD = 73728, MXB_V = 92160, MXB_RS = 118784;

__device__ __forceinline__ bf16x8 ld_row8(LAS unsigned char* base, int row, int col, int stride) { return *(const LAS bf16x8*)(base + row * stride + col * 2); }
__device__ __forceinline__ s16x4 ld_tr4(LAS unsigned char* p) { return __builtin_amdgcn_ds_read_tr16_b64_v4i16((LAS s16x4*)p); }
__device__ __forceinline__ bf16x8 ld_trfrag(LAS unsigned char* base, int row0, int col0, int stride, int lane) {
    const int g = lane >> 4, q = (lane & 15) >> 2, p = lane & 3;
    LAS unsigned char* a = base + (row0 + 4 * g + q) * stride + (col0 + 4 * p) * 2;
    const s16x4 lo = ld_tr4(a), hi = ld_tr4(a + 16 * stride);
    return __builtin_shufflevector(lo, hi, 0, 1, 2, 3, 4, 5, 6, 7);
}
__device__ __forceinline__ void unpack8(const v4u w, float (&f)[8]) {
    f[0] = __uint_as_float(w.x << 16); f[1] = __uint_as_float(w.x & 0xffff0000u); f[2] = __uint_as_float(w.y << 16); f[3] = __uint_as_float(w.y & 0xffff0000u);
    f[4] = __uint_as_float(w.z << 16); f[5] = __uint_as_float(w.z & 0xffff0000u); f[6] = __uint_as_float(w.w << 16); f[7] = __uint_as_float(w.w & 0xffff0000u);
}
__device__ __forceinline__ v4u pack8(const float (&f)[8]) { v4u w; w.x = pk2(f[0], f[1]); w.y = pk2(f[2], f[3]); w.z = pk2(f[4], f[5]); w.w = pk2(f[6], f[7]); return w; }

template <int MIX>
__device__ __forceinline__ void mixer_gates(const Args& a, const bf16* proj, LAS unsigned char* lds, int tid, int h, size_t tok0, float (&kx)[2][8]) {
    typedef MixCfg<MIX> C;
    const int co = tid & 15, tg = tid >> 4;
    LAS float* G = (LAS float*)(lds + MX_G); LAS float* T = (LAS float*)(lds + MX_T); LAS float* BL = (LAS float*)(lds + MX_BL);
    float gv[2][8];
    if (MIX == 0) {
        LAS float* WG = (LAS float*)(lds + MX_WG);
        { const int r = tid >> 5, c4 = (tid & 31) * 4; *(LAS f32x4*)(WG + r * 128 + c4) = *(const GAS f32x4*)(a.in[7] + r * GLA_KW + h * 128 + c4); }
        float rr[2][16];
#pragma unroll
        for (int s = 0; s < 2; ++s) {
            const bf16* rowp = proj + (tok0 + 2 * tg + s) * C::LDP;
            const v4u kw = *(const GAS v4u*)(rowp + C::CK + h * 128 + 8 * co); unpack8(kw, kx[s]);
            const v4u r0 = *(const GAS v4u*)(rowp + GLA_CR), r1 = *(const GAS v4u*)(rowp + GLA_CR + 8);
            float t0[8], t1[8]; unpack8(r0, t0); unpack8(r1, t1);
#pragma unroll
            for (int e = 0; e < 8; ++e) { rr[s][e] = t0[e]; rr[s][8 + e] = t1[e]; }
        }
        float bgv[8];
        { const f32x4 b0 = *(const GAS f32x4*)(a.in[8] + h * 128 + 8 * co), b1 = *(const GAS f32x4*)(a.in[8] + h * 128 + 8 * co + 4);
          bgv[0] = b0.x; bgv[1] = b0.y; bgv[2] = b0.z; bgv[3] = b0.w; bgv[4] = b1.x; bgv[5] = b1.y; bgv[6] = b1.z; bgv[7] = b1.w; }
        __syncthreads();
#pragma unroll
        for (int s = 0; s < 2; ++s)
#pragma unroll
            for (int e = 0; e < 8; ++e) gv[s][e] = bgv[e];
#pragma unroll
        for (int r = 0; r < 16; ++r) {
            const f32x4 w0 = *(const LAS f32x4*)(WG + r * 128 + 8 * co), w1 = *(const LAS f32x4*)(WG + r * 128 + 8 * co + 4);
            const float wv[8] = {w0.x, w0.y, w0.z, w0.w, w1.x, w1.y, w1.z, w1.w};
#pragma unroll
            for (int s = 0; s < 2; ++s)
#pragma unroll
                for (int e = 0; e < 8; ++e) gv[s][e] = fmaf(rr[s][r], wv[e], gv[s][e]);
        }
#pragma unroll
        for (int s = 0; s < 2; ++s)
#pragma unroll
            for (int e = 0; e < 8; ++e) { const float xg = gv[s][e]; gv[s][e] = (fminf(xg, 0.f) - __logf(1.f + __expf(-fabsf(xg)))) * (1.f / 16.f); }
    } else {
        float oml[8];
#pragma unroll
        for (int e = 0; e < 8; ++e) { const int c = h * 128 + 8 * co + e; const float dlt = a.in[11][MIXW + c] - a.in[11][c]; oml[e] = 1.f - __builtin_amdgcn_rcpf(1.f + __expf(-dlt)); }
#pragma unroll
        for (int s = 0; s < 2; ++s) {
            const bf16* rowp = proj + (tok0 + 2 * tg + s) * C::LDP;
            const v4u zw = *(const GAS v4u*)(rowp + C::CK + h * 128 + 8 * co); float z[8]; unpack8(zw, z);
#pragma unroll
            for (int e = 0; e < 8; ++e) { const float omf = oml[e] * __builtin_amdgcn_rcpf(1.f + __expf(z[e])); kx[s][e] = omf; gv[s][e] = __logf(1.f - omf); }
        }
    }
#pragma unroll
    for (int s = 0; s < 2; ++s) {
        LAS float* gp = G + (2 * tg + s) * 128 + 8 * co;
        *(LAS f32x4*)gp = (f32x4){gv[s][0], gv[s][1], gv[s][2], gv[s][3]}; *(LAS f32x4*)(gp + 4) = (f32x4){gv[s][4], gv[s][5], gv[s][6], gv[s][7]};
    }
    __syncthreads();
    {
        const int kk = tid & 127, seg = tid >> 7;
        float c[16]; float run = 0.f;
#pragma unroll
        for (int i = 0; i < 16; ++i) { run += G[(16 * seg + i) * 128 + kk]; c[i] = run; }
        T[seg * 128 + kk] = run;
        __syncthreads();
        float offs = 0.f, tot = 0.f;
#pragma unroll
        for (int s = 0; s < 4; ++s) { const float ts = T[s * 128 + kk]; tot += ts; if (s < seg) offs += ts; }
#pragma unroll
        for (int i = 0; i < 16; ++i) G[(16 * seg + i) * 128 + kk] = c[i] + offs;
        if (seg == 0) BL[kk] = tot;
    }
    __syncthreads();
}

template <int MIX>
__device__ __forceinline__ void mixer_phase_a(const Args& a, LAS unsigned char* lds, int vcu, int G_) {
    typedef MixCfg<MIX> C;
    int tid = threadIdx.x; asm volatile("" : "+v"(tid));
    const int lane = tid & 63, wave = __builtin_amdgcn_readfirstlane(tid >> 6);
    const bf16* proj = (const bf16*)(a.ws + WS_PROJ);
    constexpr int NIT = BATCH * C::H * NCH, NDT = C::DV / 16, VCH = C::DV / 8;
    for (int item = vcu; item < NIT; item += G_) {
        const int c = item % NCH, h = (item / NCH) % C::H, b = item / (NCH * C::H);
        const size_t tok0 = (size_t)b * SEQ + (size_t)c * CH;
#pragma unroll
        for (int i = 0; i < VCH * 64 / NTHREADS; ++i) { const int id = tid + NTHREADS * i, j = id / VCH, cv = id % VCH;
            *(LAS v4u*)(lds + MXA_V + j * C::VSTR + cv * 16) = *(const GAS v4u*)(proj + (tok0 + j) * C::LDP + C::CV + h * C::DV + 8 * cv); }
        float kx[2][8];
        mixer_gates<MIX>(a, proj, lds, tid, h, tok0, kx);
        {
            const int co = tid & 15, tg = tid >> 4;
            const LAS float* G = (const LAS float*)(lds + MX_G); const LAS float* BL = (const LAS float*)(lds + MX_BL);
            const f32x4 l0 = *(const LAS f32x4*)(BL + 8 * co), l1 = *(const LAS f32x4*)(BL + 8 * co + 4);
            const float bl[8] = {l0.x, l0.y, l0.z, l0.w, l1.x, l1.y, l1.z, l1.w};
#pragma unroll
            for (int s = 0; s < 2; ++s) { const int j = 2 * tg + s;
                const f32x4 b0 = *(const LAS f32x4*)(G + j * 128 + 8 * co), b1 = *(const LAS f32x4*)(G + j * 128 + 8 * co + 4);
                const float bb[8] = {b0.x, b0.y, b0.z, b0.w, b1.x, b1.y, b1.z, b1.w}; float o[8];
#pragma unroll
                for (int e = 0; e < 8; ++e) o[e] = kx[s][e] * __expf(bl[e] - bb[e]);
                *(LAS v4u*)(lds + MXA_KD + j * ISTR + 16 * co) = pack8(o); }
            if (tid < 128) ((float*)(a.ws + WS_DECAY))[(size_t)item * 128 + tid] = __expf(BL[tid]);
        }
        __syncthreads();
        f32x4 acc[NDT];
#pragma unroll
        for (int d = 0; d < NDT; ++d) acc[d] = (f32x4){0.f, 0.f, 0.f, 0.f};
#pragma unroll
        for (int ks = 0; ks < 2; ++ks) {
            const bf16x8 bfrag = ld_trfrag(lds + MXA_KD, 32 * ks, 16 * wave, ISTR, lane);
#pragma unroll
            for (int d = 0; d < NDT; ++d) { const bf16x8 afrag = ld_trfrag(lds + MXA_V, 32 * ks, 16 * d, C::VSTR, lane);
                acc[d] = __builtin_amdgcn_mfma_f32_16x16x32_bf16(afrag, bfrag, acc[d], 0, 0, 0); }
        }
        __syncthreads();
        {   const int g = lane >> 4, kk = 16 * wave + (lane & 15);
#pragma unroll
            for (int d = 0; d < NDT; ++d)
#pragma unroll
                for (int r = 0; r < 4; ++r) *(LAS bf16*)(lds + (16 * d + 4 * g + r) * 256 + kk * 2) = f2bf(acc[d][r]); }
        __syncthreads();
        {   bf16* st = (bf16*)(a.ws + WS_STATE) + (size_t)item * C::DV * 128;
#pragma unroll
            for (int i = 0; i < C::DV * 256 / 16 / NTHREADS; ++i) { const int id = tid + NTHREADS * i; *(GAS v4u*)(st + id * 8) = *(const LAS v4u*)(lds + id * 16); } }
        __syncthreads();
    }
}

template <int MIX>
__device__ __forceinline__ void mixer_scan(const Args& a, int vcu, int G_) {
    typedef MixCfg<MIX> C;
    int tid = threadIdx.x; asm volatile("" : "+v"(tid));
    constexpr int EPB = C::DV * 128 / 4;
    constexpr int NTASK = BATCH * C::H * EPB;
    const float* dec = (const float*)(a.ws + WS_DECAY);
    for (int task = vcu * NTHREADS + tid; task < NTASK; task += G_ * NTHREADS) {
        const int bh = task / EPB, e4 = task % EPB, kk = (4 * e4) & 127;
        v2u* sp = (v2u*)(a.ws + WS_STATE) + (size_t)bh * NCH * EPB + e4;
        const float* dp = dec + (size_t)bh * NCH * 128 + kk;
        float s0 = 0.f, s1 = 0.f, s2 = 0.f, s3 = 0.f;
#pragma unroll 16
        for (int c = 0; c < NCH; ++c) {
            const v2u lw = *(const GAS v2u*)(sp + (size_t)c * EPB);
            const f32x4 d = *(const GAS f32x4*)(dp + c * 128);
            v2u o; o.x = pk2(s0, s1); o.y = pk2(s2, s3);
            *(GAS v2u*)(sp + (size_t)c * EPB) = o;
            s0 = fmaf(s0, d.x, __uint_as_float(lw.x << 16)); s1 = fmaf(s1, d.y, __uint_as_float(lw.x & 0xffff0000u));
            s2 = fmaf(s2, d.z, __uint_as_float(lw.y << 16)); s3 = fmaf(s3, d.w, __uint_as_float(lw.y & 0xffff0000u));
        }
    }
}

template <int MIX>
__device__ __forceinline__ void mixer_phase_b(const Args& a, LAS unsigned char* lds, int vcu, int G_) {
    typedef MixCfg<MIX> C;
    int tid = threadIdx.x; asm volatile("" : "+v"(tid));
    const int lane = tid & 63, wave = __builtin_amdgcn_readfirstlane(tid >> 6);
    bf16* proj = (bf16*)(a.ws + WS_PROJ);
    constexpr int NIT = BATCH * C::H * NCH, NDT = C::DV / 16, NDH = NDT / 2, VCH = C::DV / 8, SCH = C::DV * 16 / NTHREADS;
    const float* onorm = MIX == 0 ? a.in[9] : a.in[12];
    for (int item = vcu; item < NIT; item += G_) {
        const int c = item % NCH, h = (item / NCH) % C::H, b = item / (NCH * C::H);
        const size_t tok0 = (size_t)b * SEQ + (size_t)c * CH;
        const int co = tid & 15, tg = tid >> 4;
        v4u sreg[SCH];
        { const bf16* st = (const bf16*)(a.ws + WS_STATE) + (size_t)item * C::DV * 128;
#pragma unroll
          for (int i = 0; i < SCH; ++i) sreg[i] = *(const GAS v4u*)(st + (tid + NTHREADS * i) * 8); }
#pragma unroll
        for (int i = 0; i < VCH * 64 / NTHREADS; ++i) { const int id = tid + NTHREADS * i, j = id / VCH, cv = id % VCH;
            *(LAS v4u*)(lds + MXB_V + j * C::VSTR + cv * 16) = *(const GAS v4u*)(proj + (tok0 + j) * C::LDP + C::CV + h * C::DV + 8 * cv); }
        float qx[2][8];
#pragma unroll
        for (int s = 0; s < 2; ++s) { const v4u qw = *(const GAS v4u*)(proj + (tok0 + 2 * tg + s) * C::LDP + C::CQ + h * 128 + 8 * co); unpack8(qw, qx[s]);
            if (MIX == 1) {
#pragma unroll
                for (int e = 0; e < 8; ++e) qx[s][e] = qx[s][e] * __builtin_amdgcn_rcpf(1.f + __expf(-qx[s][e])); } }
        float kx[2][8];
        mixer_gates<MIX>(a, proj, lds, tid, h, tok0, kx);
        {
            const LAS float* G = (const LAS float*)(lds + MX_G);
            float bb[2][8];
#pragma unroll
            for (int s = 0; s < 2; ++s) { const int j = 2 * tg + s;
                const f32x4 b0 = *(const LAS f32x4*)(G + j * 128 + 8 * co), b1 = *(const LAS f32x4*)(G + j * 128 + 8 * co + 4);
                bb[s][0] = b0.x; bb[s][1] = b0.y; bb[s][2] = b0.z; bb[s][3] = b0.w; bb[s][4] = b1.x; bb[s][5] = b1.y; bb[s][6] = b1.z; bb[s][7] = b1.w; }
            __syncthreads();
#pragma unroll
            for (int s = 0; s < 2; ++s) { const int j = 2 * tg + s; float oq[8], ok[8];
#pragma unroll
                for (int e = 0; e < 8; ++e) { const float ex = __expf(bb[s][e]); oq[e] = qx[s][e] * ex; ok[e] = kx[s][e] * __builtin_amdgcn_rcpf(ex); }
                *(LAS v4u*)(lds + MXB_QD + j * ISTR + 16 * co) = pack8(oq); *(LAS v4u*)(lds + MXB_KD + j * ISTR + 16 * co) = pack8(ok); }
#pragma unroll
            for (int i = 0; i < SCH; ++i) { const int id = tid + NTHREADS * i, row = id >> 4, ch = id & 15; *(LAS v4u*)(lds + MXB_ST + row * ISTR + ch * 16) = sreg[i]; }
        }
        __syncthreads();
        const int it = wave & 3, dh = wave >> 2, g = lane >> 4, li = lane & 15;
        bf16x8 qf[4];
#pragma unroll
        for (int ks = 0; ks < 4; ++ks) qf[ks] = ld_row8(lds + MXB_QD, 16 * it + li, 32 * ks + 8 * g, ISTR);
        f32x4 X[4];
#pragma unroll
        for (int jt = 0; jt < 4; ++jt) { X[jt] = (f32x4){0.f, 0.f, 0.f, 0.f};
            if (jt <= it) {
#pragma unroll
                for (int ks = 0; ks < 4; ++ks) { const bf16x8 kf = ld_row8(lds + MXB_KD, 16 * jt + li, 32 * ks + 8 * g, ISTR);
                    X[jt] = __builtin_amdgcn_mfma_f32_16x16x32_bf16(kf, qf[ks], X[jt], 0, 0, 0); }
                if (jt == it) {
#pragma unroll
                    for (int r = 0; r < 4; ++r) if (4 * g + r > li) X[jt][r] = 0.f; } } }
        bf16x8 pf[2];
#pragma unroll
        for (int k2 = 0; k2 < 2; ++k2) { v4u w; w.x = pk2(X[2 * k2][0], X[2 * k2][1]); w.y = pk2(X[2 * k2][2], X[2 * k2][3]); w.z = pk2(X[2 * k2 + 1][0], X[2 * k2 + 1][1]); w.w = pk2(X[2 * k2 + 1][2], X[2 * k2 + 1][3]);
            pf[k2] = __builtin_bit_cast(bf16x8, w); }
        f32x4 acc[NDH];
        float ssq = 0.f;
#pragma unroll
        for (int d = 0; d < NDH; ++d) { const int dt = dh * NDH + d; acc[d] = (f32x4){0.f, 0.f, 0.f, 0.f};
#pragma unroll
            for (int k2 = 0; k2 < 2; ++k2) if (2 * k2 <= it) { const bf16x8 vf = ld_trfrag(lds + MXB_V, 32 * k2, 16 * dt, C::VSTR, lane);
                acc[d] = __builtin_amdgcn_mfma_f32_16x16x32_bf16(vf, pf[k2], acc[d], 0, 0, 0); }
#pragma unroll
            for (int ks = 0; ks < 4; ++ks) { const bf16x8 sf = ld_row8(lds + MXB_ST, 16 * dt + li, 32 * ks + 8 * g, ISTR);
                acc[d] = __builtin_amdgcn_mfma_f32_16x16x32_bf16(sf, qf[ks], acc[d], 0, 0, 0); }
            ssq += (acc[d][0] * acc[d][0] + acc[d][1] * acc[d][1]) + (acc[d][2] * acc[d][2] + acc[d][3] * acc[d][3]); }
        ssq += __shfl_xor(ssq, 16); ssq += __shfl_xor(ssq, 32);
        LAS float* RS = (LAS float*)(lds + MXB_RS);
        if (g == 0) RS[dh * 64 + 16 * it + li] = ssq;
        __syncthreads();
        {   const float tot = RS[16 * it + li] + RS[64 + 16 * it + li];
            const float ri = rsqrtf(tot * (1.f / C::DV) + EPS);
            bf16* rowp = proj + (tok0 + 16 * it + li) * C::LDP;
#pragma unroll
            for (int d = 0; d < NDH; ++d) { const int dv = 16 * (dh * NDH + d) + 4 * g;
                const v2u gw = *(const GAS v2u*)(rowp + C::CG + h * C::DV + dv);
                const f32x4 gn = *(const GAS f32x4*)(onorm + dv);
                const float g0 = __uint_as_float(gw.x << 16), g1 = __uint_as_float(gw.x & 0xffff0000u), g2 = __uint_as_float(gw.y << 16), g3 = __uint_as_float(gw.y & 0xffff0000u);
                v2u o; o.x = pk2(acc[d][0] * ri * gn.x * (g0 * __builtin_amdgcn_rcpf(1.f + __expf(-g0))), acc[d][1] * ri * gn.y * (g1 * __builtin_amdgcn_rcpf(1.f + __expf(-g1))));
                o.y = pk2(acc[d][2] * ri * gn.z * (g2 * __builtin_amdgcn_rcpf(1.f + __expf(-g2))), acc[d][3] * ri * gn.w * (g3 * __builtin_amdgcn_rcpf(1.f + __expf(-g3))));
                *(GAS v2u*)(rowp + C::CV + h * C::DV + dv) = o; } }
        __syncthreads();
    }
}

constexpr int MA_STR = 160, MA_K = 0, MA_V = 40960, MA_Q = 81920;
template <int MIX>
__device__ __forceinline__ void memattn_phase(const Args& a, LAS unsigned char* lds, int vcu, int G_) {
    typedef MixCfg<MIX> C;
    int tid = threadIdx.x; asm volatile("" : "+v"(tid));
    const int lane = tid & 63, wave = __builtin_amdgcn_readfirstlane(tid >> 6), g = lane >> 4, li = lane & 15;
    bf16* proj = (bf16*)(a.ws + WS_PROJ);
    const bf16* kvm = (const bf16*)(a.ws + WS_KVMEM) + (size_t)MIX * MROWS * 512;
    constexpr int NIT = (M / 128) * 4;
    for (int item = vcu; item < NIT; item += G_) {
        const int hm = item & 3, tile = item >> 2; const size_t tok0 = (size_t)tile * 128; const int b = (int)(tok0 / SEQ);
#pragma unroll
        for (int i = 0; i < 4; ++i) { const int id = tid + NTHREADS * i, m = id >> 3, ch = id & 7;
            *(LAS v4u*)(lds + MA_K + m * MA_STR + ch * 16) = *(const GAS v4u*)(kvm + (size_t)(b * NMEM + m) * 512 + hm * 64 + 8 * ch);
            *(LAS v4u*)(lds + MA_V + m * MA_STR + ch * 16) = *(const GAS v4u*)(kvm + (size_t)(b * NMEM + m) * 512 + 256 + hm * 64 + 8 * ch); }
#pragma unroll
        for (int i = 0; i < 2; ++i) { const int id = tid + NTHREADS * i, t = id >> 3, ch = id & 7;
            *(LAS v4u*)(lds + MA_Q + t * MA_STR + ch * 16) = *(const GAS v4u*)(proj + (tok0 + t) * C::LDP + C::CMQ + hm * 64 + 8 * ch); }
        __syncthreads();
        bf16x8 qf[2];
#pragma unroll
        for (int ks = 0; ks < 2; ++ks) qf[ks] = ld_row8(lds + MA_Q, 16 * wave + li, 32 * ks + 8 * g, MA_STR);
        f32x4 X[16]; float mx = -3.0e38f;
#pragma unroll
        for (int kt = 0; kt < 16; ++kt) { X[kt] = (f32x4){0.f, 0.f, 0.f, 0.f};
#pragma unroll
            for (int ks = 0; ks < 2; ++ks) { const bf16x8 kf = ld_row8(lds + MA_K, 16 * kt + li, 32 * ks + 8 * g, MA_STR);
                X[kt] = __builtin_amdgcn_mfma_f32_16x16x32_bf16(kf, qf[ks], X[kt], 0, 0, 0); }
            mx = fmaxf(mx, fmaxf(fmaxf(X[kt][0], X[kt][1]), fmaxf(X[kt][2], X[kt][3]))); }
        mx = fmaxf(mx, __shfl_xor(mx, 16)); mx = fmaxf(mx, __shfl_xor(mx, 32));
        float sum = 0.f;
#pragma unroll
        for (int kt = 0; kt < 16; ++kt)
#pragma unroll
            for (int r = 0; r < 4; ++r) { const float p = __expf((X[kt][r] - mx) * 0.125f); X[kt][r] = p; sum += p; }
        sum += __shfl_xor(sum, 16); sum += __shfl_xor(sum, 32);
        const float inv = __builtin_amdgcn_rcpf(sum);
        f32x4 acc[4];
#pragma unroll
        for (int d = 0; d < 4; ++d) acc[d] = (f32x4){0.f, 0.f, 0.f, 0.f};
#pragma unroll
        for (int k2 = 0; k2 < 8; ++k2) {
            v4u w; w.x = pk2(X[2 * k2][0] * inv, X[2 * k2][1] * inv); w.y = pk2(X[2 * k2][2] * inv, X[2 * k2][3] * inv);
            w.z = pk2(X[2 * k2 + 1][0] * inv, X[2 * k2 + 1][1] * inv); w.w = pk2(X[2 * k2 + 1][2] * inv, X[2 * k2 + 1][3] * inv);
            const bf16x8 pf = __builtin_bit_cast(bf16x8, w);
#pragma unroll
            for (int d = 0; d < 4; ++d) { const bf16x8 vf = ld_trfrag(lds + MA_V, 32 * k2, 16 * d, MA_STR, lane);
                acc[d] = __builtin_amdgcn_mfma_f32_16x16x32_bf16(vf, pf, acc[d], 0, 0, 0); }
        }
        {   bf16* rowp = proj + (tok0 + 16 * wave + li) * C::LDP + C::CMQ + hm * 64;
#pragma unroll
            for (int d = 0; d < 4; ++d) { v2u o; o.x = pk2(acc[d][0], acc[d][1]); o.y = pk2(acc[d][2], acc[d][3]); *(GAS v2u*)(rowp + 16 * d + 4 * g) = o; } }
        __syncthreads();
    }
}

__device__ __forceinline__ void memkv_tiles(const Args& a, LAS unsigned char* lds, int vcu, int G_) {
    int tid = threadIdx.x; asm volatile("" : "+v"(tid));
    const int lane = tid & 63, wave = __builtin_amdgcn_readfirstlane(tid >> 6), g = lane >> 4, li = lane & 15;
    const bf16* membf = (const bf16*)(a.ws + WS_MEMBF); const float* rinvm = (const float*)(a.ws + WS_RINVM);
    for (int t = vcu; t < 256; t += G_) {
        const int l = t >> 7, rt = (t & 127) >> 3, ct = t & 7;
        const bf16* wkv = (const bf16*)((l == 0 ? a.ws + WS_W0 : (unsigned char*)a.out) + REL_WKV);
        const bf16* ap = membf + (size_t)(rt * 64 + li) * D + 128 * wave + 8 * g;
        const bf16* bp = wkv + (size_t)(ct * 64 + li) * D + 128 * wave + 8 * g;
        f32x4 acc[4][4];
#pragma unroll
        for (int j = 0; j < 4; ++j)
#pragma unroll
            for (int i = 0; i < 4; ++i) acc[j][i] = (f32x4){0.f, 0.f, 0.f, 0.f};
#pragma unroll
        for (int ks = 0; ks < 4; ++ks) {
            bf16x8 af[4], bf[4];
#pragma unroll
            for (int i = 0; i < 4; ++i) { af[i] = *(const GAS bf16x8*)(ap + (size_t)(16 * i) * D + 32 * ks); bf[i] = *(const GAS bf16x8*)(bp + (size_t)(16 * i) * D + 32 * ks); }
#pragma unroll
            for (int j = 0; j < 4; ++j)
#pragma unroll
                for (int i = 0; i < 4; ++i) acc[j][i] = __builtin_amdgcn_mfma_f32_16x16x32_bf16(bf[j], af[i], acc[j][i], 0, 0, 0);
        }
        LAS float* P = (LAS float*)lds + wave * 4096;
#pragma unroll
        for (int j = 0; j < 4; ++j)
#pragma unroll
            for (int i = 0; i < 4; ++i) *(LAS f32x4*)(P + (16 * i + li) * 64 + 16 * j + 4 * g) = acc[j][i];
        __syncthreads();
        {   const int row = tid >> 3, c8 = (tid & 7) * 8; f32x4 s0 = {0.f, 0.f, 0.f, 0.f}, s1 = {0.f, 0.f, 0.f, 0.f};
#pragma unroll
            for (int w = 0; w < 8; ++w) { const LAS float* pp = (const LAS float*)lds + w * 4096 + row * 64 + c8; s0 += *(const LAS f32x4*)pp; s1 += *(const LAS f32x4*)(pp + 4); }
            const float sc = rinvm[rt * 64 + row];
            v4u o; o.x = pk2(s0.x * sc, s0.y * sc); o.y = pk2(s0.z * sc, s0.w * sc); o.z = pk2(s1.x * sc, s1.y * sc); o.w = pk2(s1.z * sc, s1.w * sc);
            *(GAS v4u*)((bf16*)(a.ws + WS_KVMEM) + (size_t)l * MROWS * 512 + (size_t)(rt * 64 + row) * 512 + ct * 64 + c8) = o; }
        __syncthreads();
    }
}
constexpr size_t WS_SLOT = WS_STATE;
constexpr size_t WS_HACT = WS_PROJ;
constexpr int NBK = 24;
constexpr int CW_CNT = 8192;
constexpr int TT_OFF = LDSCTL_OFF + 1024;
struct SlotRec { int token; float rinv, glo, ghi; };

namespace pg8 {
struct EpiResid {
    static constexpr bool PERM = true, AFTER_DRAIN = false;
    bf16_t* hb; int ldc;
    __device__ __forceinline__ void operator()(const f32x4 (&acc)[2][2][4][2], const Unit& u, int wr, int wc, int fr, int fq) const {
        const int row0 = u.pm * BM + wr * 64 + fr, col0 = u.pn * BM + wc * 32 + 8 * fq;
#pragma unroll
        for (int ai = 0; ai < 2; ++ai)
#pragma unroll
            for (int m = 0; m < 4; ++m) { bf16_t* rowp = hb + (size_t)(row0 + ai * HALF + m * 16) * ldc + col0;
#pragma unroll
                for (int bj = 0; bj < 2; ++bj) { const u32x4 b = *(const u32x4*)(rowp + bj * HALF); const f32x4 a0 = acc[ai][bj][m][0], a1 = acc[ai][bj][m][1];
                    u32x4 w; w.x = cvt_pk_bf16(__uint_as_float(b.x << 16) + a0[0], __uint_as_float(b.x & 0xffff0000u) + a0[1]); w.y = cvt_pk_bf16(__uint_as_float(b.y << 16) + a0[2], __uint_as_float(b.y & 0xffff0000u) + a0[3]);
                    w.z = cvt_pk_bf16(__uint_as_float(b.z << 16) + a1[0], __uint_as_float(b.z & 0xffff0000u) + a1[1]); w.w = cvt_pk_bf16(__uint_as_float(b.w << 16) + a1[2], __uint_as_float(b.w & 0xffff0000u) + a1[3]);
                    *(u32x4*)(rowp + bj * HALF) = w; }
                asm volatile("" ::: "memory"); }
    }
};
template <int mode> struct MoeOrder {
    static constexpr bool GATHER = (mode == 0);
    const PG8_LAS int* tt; int G, c; const SlotRec* slots;
    __device__ __forceinline__ bool next(int i, Unit& u) const {
        const int L = i * G + c, NT = __builtin_amdgcn_readfirstlane(tt[NBK]);
        if (L >= NT * 4) return false;
        const int rt = L >> 2; int bk = 0;
        for (int b = 1; b < NBK; ++b) if (rt >= __builtin_amdgcn_readfirstlane(tt[b])) bk = b;
        const int tb = __builtin_amdgcn_readfirstlane(tt[bk]), cn = __builtin_amdgcn_readfirstlane(tt[25 + bk]);
        u.pm = rt; u.pn = L & 3; u.x0 = bk; const int first = (rt - tb) * BM; u.x1 = min(cn - first, BM); u.x2 = bk * M + first; u.x3 = 0;
        return true;
    }
    __device__ __forceinline__ void a_ready(const Unit&) const {}
    __device__ __forceinline__ void done(const Unit&) const {}
    __device__ __forceinline__ static void experts(int bk, int& ea, int& eb) { const int g = bk / 6, p = bk % 6; const int lo = p < 3 ? 0 : (p < 5 ? 1 : 2), hi = p < 3 ? p + 1 : (p < 5 ? p - 1 : 3); ea = 4 * g + lo; eb = 4 * g + hi; }
    __device__ __forceinline__ unsigned a_off(const Gemm& g, const Unit& u, int r) const {
        const int rr = r < u.x1 ? r : u.x1 - 1; const int tok = slots[u.x2 + rr].token; return (unsigned)(tok * g.lda) * 2u;
    }
    __device__ __forceinline__ size_t b_off(const Gemm& g, const Unit& u) const {
        int ea, eb; experts(u.x0, ea, eb);
        if (mode == 0) { const int e = (u.pn < 2) ? ea : eb; return ((size_t)e * 512 + (size_t)(u.pn & 1) * 256) * D * 2; }
        return ((size_t)ea * D + (size_t)u.pn * 256) * FF * 2;
    }
    __device__ __forceinline__ long b_delta(const Gemm& g, const Unit& u) const {
        if (mode == 0) return 0;
        int ea, eb; experts(u.x0, ea, eb); return (long)(eb - ea) * D * FF * 2 - (long)FF * 2;
    }
};
struct EpiMoeUp {
    static constexpr bool PERM = true, AFTER_DRAIN = false;
    bf16_t* hact; const SlotRec* slots;
    __device__ __forceinline__ void operator()(const f32x4 (&acc)[2][2][4][2], const Unit& u, int wr, int wc, int fr, int fq) const {
        const int colo = (u.pn >> 1) * 256 + (u.pn & 1) * 128 + wc * 32 + 8 * fq;
#pragma unroll
        for (int ai = 0; ai < 2; ++ai)
#pragma unroll
            for (int m = 0; m < 4; ++m) { const int r = ai * HALF + wr * 64 + m * 16 + fr;
                { const SlotRec sr = slots[u.x2 + (r < u.x1 ? r : u.x1 - 1)]; const float ri = sr.rinv, gt = (u.pn < 2) ? sr.glo : sr.ghi; asm volatile("" ::: "memory");
                    float o[8];
#pragma unroll
                    for (int n = 0; n < 2; ++n)
#pragma unroll
                        for (int j = 0; j < 4; ++j) { const float av = acc[ai][0][m][n][j] * ri, bv = acc[ai][1][m][n][j] * ri; o[4 * n + j] = av * __builtin_amdgcn_rcpf(1.f + __expf(-av)) * bv * gt; }
                    u32x4 w; w.x = cvt_pk_bf16(o[0], o[1]); w.y = cvt_pk_bf16(o[2], o[3]); w.z = cvt_pk_bf16(o[4], o[5]); w.w = cvt_pk_bf16(o[6], o[7]);
                    *(u32x4*)(hact + (size_t)(u.pm * BM + r) * 512 + colo) = w; } }
    }
};
struct EpiMoeDown {
    static constexpr bool PERM = true, AFTER_DRAIN = false;
    bf16_t* hb; const SlotRec* slots; bf16_t* dummy; float* rowss;
    __device__ __forceinline__ void operator()(const f32x4 (&acc)[2][2][4][2], const Unit& u, int wr, int wc, int fr, int fq) const {
        const int col0 = u.pn * BM + wc * 32 + 8 * fq;
#pragma unroll
        for (int ai = 0; ai < 2; ++ai)
#pragma unroll
            for (int m = 0; m < 4; ++m) { const int r = ai * HALF + wr * 64 + m * 16 + fr;
                { const int tok = slots[u.x2 + (r < u.x1 ? r : u.x1 - 1)].token; bf16_t* rowp = (r < u.x1 ? hb + (size_t)tok * D : dummy) + col0; float ss = 0.f;
#pragma unroll
                    for (int bj = 0; bj < 2; ++bj) { const u32x4 b = *(const u32x4*)(rowp + bj * HALF); const f32x4 a0 = acc[ai][bj][m][0], a1 = acc[ai][bj][m][1];
                        u32x4 w; w.x = cvt_pk_bf16(__uint_as_float(b.x << 16) + a0[0], __uint_as_float(b.x & 0xffff0000u) + a0[1]); w.y = cvt_pk_bf16(__uint_as_float(b.y << 16) + a0[2], __uint_as_float(b.y & 0xffff0000u) + a0[3]);
                        w.z = cvt_pk_bf16(__uint_as_float(b.z << 16) + a1[0], __uint_as_float(b.z & 0xffff0000u) + a1[1]); w.w = cvt_pk_bf16(__uint_as_float(b.w << 16) + a1[2], __uint_as_float(b.w & 0xffff0000u) + a1[3]);
                        *(u32x4*)(rowp + bj * HALF) = w;
                        if (rowss) { const unsigned ww[4] = {w.x, w.y, w.z, w.w};
#pragma unroll
                            for (int e = 0; e < 4; ++e) { const float lo = __uint_as_float(ww[e] << 16), hi = __uint_as_float(ww[e] & 0xffff0000u); ss = fmaf(lo, lo, ss); ss = fmaf(hi, hi, ss); } } }
                    if (rowss) { ss += __shfl_xor(ss, 16); ss += __shfl_xor(ss, 32); if (fq == 0 && r < u.x1) rowss[(size_t)tok * 16 + u.pn * 4 + wc] = ss; } }
                asm volatile("" ::: "memory"); }
    }
};
}

constexpr int RT_STR = 2080, RT_HI = 0, RT_LO = 24 * RT_STR, RT_SCR = RT_LO + 32 * RT_STR;
__device__ __forceinline__ void route_phase(const Args& a, int layer, LAS unsigned char* lds, int vcu, int G_) {
    int tid = threadIdx.x; asm volatile("" : "+v"(tid));
    const int lane = tid & 63, wave = __builtin_amdgcn_readfirstlane(tid >> 6), g = lane >> 4, li = lane & 15;
    const float* gain = a.in[3] + layer * D; const float* wg = a.in[15] + (size_t)layer * D * NG; const float* wr = a.in[17] + (size_t)layer * D * NE;
#pragma unroll
    for (int i = 0; i < 8; ++i) { const int idx = tid + NTHREADS * i, k = idx >> 2, c4 = (idx & 3) * 4; const f32x4 w = *(const GAS f32x4*)(wr + (size_t)idx * 4); const float gk = gain[k];
        const float v[4] = {w.x * gk, w.y * gk, w.z * gk, w.w * gk};
#pragma unroll
        for (int e = 0; e < 4; ++e) { const bf16 hi = f2bf(v[e]); *(LAS bf16*)(lds + RT_HI + (4 + c4 + e) * RT_STR + 2 * k) = hi; *(LAS bf16*)(lds + RT_LO + (4 + c4 + e) * RT_STR + 2 * k) = f2bf(v[e] - bf2f(hi)); } }
#pragma unroll
    for (int i = 0; i < 2; ++i) { const int k = tid + NTHREADS * i; const f32x4 w = *(const GAS f32x4*)(wg + (size_t)k * 4); const float gk = gain[k];
        const float v[4] = {w.x * gk, w.y * gk, w.z * gk, w.w * gk};
#pragma unroll
        for (int e = 0; e < 4; ++e) { const bf16 hi = f2bf(v[e]); *(LAS bf16*)(lds + RT_HI + e * RT_STR + 2 * k) = hi; *(LAS bf16*)(lds + RT_LO + e * RT_STR + 2 * k) = f2bf(v[e] - bf2f(hi)); } }
    __syncthreads();
    const bf16* hbf = (const bf16*)(a.ws + WS_HBF); SlotRec* slots = (SlotRec*)(a.ws + WS_SLOT);
    unsigned* cnt = (unsigned*)(a.ws + WS_CTL) + CW_CNT + layer * 512;
    const float* bgp = a.in[16] + layer * NG; const float* brp = a.in[18] + layer * NE;
    LAS float* scr = (LAS float*)(lds + RT_SCR) + wave * (16 * 21);
    static_assert(RT_SCR + NWAVES * 16 * 21 * 4 <= RING_BYTES, "route LDS map");
    for (int item = wave * G_ + vcu; item < M / 16; item += NWAVES * G_) {
        const int m0 = item * 16;
        const bf16* ap = hbf + (size_t)(m0 + li) * D + 8 * g;
        f32x4 y0 = {0.f, 0.f, 0.f, 0.f}, y1 = {0.f, 0.f, 0.f, 0.f}; float ss = 0.f;
#pragma unroll 8
        for (int ks = 0; ks < 32; ++ks) {
            const v4u aw = *(const GAS v4u*)(ap + 32 * ks); const bf16x8 af = __builtin_bit_cast(bf16x8, aw);
            float fv[8]; unpack8(aw, fv);
#pragma unroll
            for (int e = 0; e < 8; ++e) ss = fmaf(fv[e], fv[e], ss);
            const int ro = li * RT_STR + (32 * ks + 8 * g) * 2;
            const bf16x8 h0 = *(const LAS bf16x8*)(lds + RT_HI + ro), h1 = *(const LAS bf16x8*)(lds + RT_HI + 16 * RT_STR + ro);
            const bf16x8 l0 = *(const LAS bf16x8*)(lds + RT_LO + ro), l1 = *(const LAS bf16x8*)(lds + RT_LO + 16 * RT_STR + ro);
            y0 = __builtin_amdgcn_mfma_f32_16x16x32_bf16(h0, af, y0, 0, 0, 0); y0 = __builtin_amdgcn_mfma_f32_16x16x32_bf16(l0, af, y0, 0, 0, 0);
            y1 = __builtin_amdgcn_mfma_f32_16x16x32_bf16(h1, af, y1, 0, 0, 0); y1 = __builtin_amdgcn_mfma_f32_16x16x32_bf16(l1, af, y1, 0, 0, 0);
        }
        ss += __shfl_xor(ss, 16); ss += __shfl_xor(ss, 32);
#pragma unroll
        for (int r = 0; r < 4; ++r) { scr[li * 21 + 4 * g + r] = y0[r]; if (g == 0) scr[li * 21 + 16 + r] = y1[r]; }
        asm volatile("s_waitcnt lgkmcnt(0)" ::: "memory");
        if (lane < 16) {
            const float ri = rsqrtf(ss * (1.f / D) + EPS);
            float lg[20];
#pragma unroll
            for (int c = 0; c < 20; ++c) lg[c] = scr[li * 21 + c] * ri + (c < 4 ? bgp[c] : brp[c - 4]);
            int gi = 0; float gm = lg[0];
#pragma unroll
            for (int c = 1; c < 4; ++c) if (lg[c] > gm) { gm = lg[c]; gi = c; }
            float gs = 0.f;
#pragma unroll
            for (int c = 0; c < 4; ++c) gs += __expf(lg[c] - gm);
            const float gwt = 1.f / gs;
            float e[4];
#pragma unroll
            for (int c = 0; c < 4; ++c) e[c] = gi == 0 ? lg[4 + c] : (gi == 1 ? lg[8 + c] : (gi == 2 ? lg[12 + c] : lg[16 + c]));
            int i0 = 0; float e0 = e[0];
#pragma unroll
            for (int c = 1; c < 4; ++c) if (e[c] > e0) { e0 = e[c]; i0 = c; }
            int i1 = -1; float e1 = -3.0e38f;
#pragma unroll
            for (int c = 0; c < 4; ++c) if (c != i0 && e[c] > e1) { e1 = e[c]; i1 = c; }
            const float p1 = __expf(e1 - e0), den = 1.f / (1.f + p1);
            const float w0 = gwt * den, w1 = gwt * p1 * den;
            const int lo = i0 < i1 ? i0 : i1, hi = i0 < i1 ? i1 : i0;
            const int pr = lo == 0 ? hi - 1 : (lo == 1 ? hi + 1 : 5);
            const int bk = gi * 6 + pr;
            const unsigned pos = __hip_atomic_fetch_add(cnt + bk * 16, 1u, __ATOMIC_RELAXED, __HIP_MEMORY_SCOPE_AGENT);
            SlotRec sr; sr.token = m0 + li; sr.rinv = ri; sr.glo = i0 < i1 ? w0 : w1; sr.ghi = i0 < i1 ? w1 : w0;
            slots[(size_t)bk * M + pos] = sr;
        }
    }
}
__device__ __forceinline__ void moe_tile_table(const Args& a, int layer, LAS unsigned char* lds) {
    LAS int* tt = (LAS int*)(lds + TT_OFF);
    if (threadIdx.x == 0) {
        const unsigned* cnt = (const unsigned*)(a.ws + WS_CTL) + CW_CNT + layer * 512;
        int acc = 0;
        for (int b = 0; b < NBK; ++b) { const int c = (int)__hip_atomic_load(cnt + b * 16, __ATOMIC_RELAXED, __HIP_MEMORY_SCOPE_AGENT); tt[b] = acc; tt[25 + b] = c; acc += (c + 255) >> 8; }
        tt[NBK] = acc;
    }
    __syncthreads();
}
__device__ __forceinline__ void final_norm_phase(const Args& a, int gw, int NGW) {
    int tid = threadIdx.x; asm volatile("" : "+v"(tid));
    const int lane = tid & 63;
    const float* gain = a.in[5]; const bf16* hbf = (const bf16*)(a.ws + WS_HBF);
    for (int m = gw; m < M; m += NGW) {
        const GAS v4u* xr = (const GAS v4u*)(hbf + (size_t)m * D) + lane;
        float v[2][8]; float s = 0.f;
#pragma unroll
        for (int j = 0; j < 2; ++j) { unpack8(xr[64 * j], v[j]);
#pragma unroll
            for (int e = 0; e < 8; ++e) s = fmaf(v[j][e], v[j][e], s); }
        s = wave_sum(s);
        const float ri = rsqrtf(s * (1.f / D) + EPS);
        GAS f32x4* orow = (GAS f32x4*)(a.out + (size_t)m * D) + 2 * lane;
#pragma unroll
        for (int j = 0; j < 2; ++j) { const GAS f32x4* gp = (const GAS f32x4*)gain + 2 * lane + 128 * j;
            const f32x4 g0 = gp[0], g1 = gp[1];
            orow[128 * j] = (f32x4){v[j][0] * ri * g0.x, v[j][1] * ri * g0.y, v[j][2] * ri * g0.z, v[j][3] * ri * g0.w};
            orow[128 * j + 1] = (f32x4){v[j][4] * ri * g1.x, v[j][5] * ri * g1.y, v[j][6] * ri * g1.z, v[j][7] * ri * g1.w}; }
    }
}
__global__ void __launch_bounds__(NTHREADS, 2) fwd(Args args) {
    extern __shared__ __attribute__((aligned(16))) unsigned char lds_raw[];
    LAS unsigned char* lds = (LAS unsigned char*)lds_raw;
    const int tid = threadIdx.x, lane0 = tid & 63, wave = __builtin_amdgcn_readfirstlane(tid >> 6);
    const int G = gridDim.x; const int bx = blockIdx.x;
    const int vcu = (G % 8 == 0) ? (bx % 8) * (G / 8) + bx / 8 : bx;
    gu32* ctl = (gu32*)(args.ws + WS_CTL);
    volatile LAS unsigned* MISC = (volatile LAS unsigned*)(lds + MISC_OFF);
    for (int u = tid; u < (LDS_BYTES - LDSCTL_OFF) / 4; u += NTHREADS) ((LAS unsigned*)(lds + LDSCTL_OFF))[u] = 0u;
    __syncthreads();
    XcdBarrier bar; bar.bar = (unsigned*)(ctl + CW_BAR); bar.x = 0; bar.st = nullptr;
    if (args.use_bar) bar = xcd_barrier_post((unsigned*)(ctl + CW_BAR), MISC + 8);
    const int lo = args.ph_lo, hi = args.ph_hi;
#define IN(k) (lo <= (k) && (k) < hi)
#ifdef TIME_PHASE
#define STAMP(k) do { if (tid == 0) MISC[16 + (k)] = (unsigned)__builtin_amdgcn_s_memrealtime(); } while (0)
#else
#define STAMP(k) do { } while (0)
#endif
#define SEAM(k) do { if (IN(k) && IN((k) + 1)) xcd_barrier(bar); STAMP((k) + 1); } while (0)
    const int gw = vcu * NWAVES + wave, NGW = G * NWAVES;

    STAMP(0);
    if (IN(0)) p0_prologue(args, lds, gw, NGW, wave, lane0);
    SEAM(0);
    for (int layer = 0; layer < 2; ++layer) {
        const int pb = 1 + layer * NPH;
        int lane = lane0; asm volatile("" : "+v"(lane));
        unsigned char* ws = args.ws; asm volatile("" : "+s"(ws));
        unsigned char* wb = layer == 0 ? ws + WS_W0 : (unsigned char*)args.out;
        if (IN(pb + 0)) {
            const int ldp = layer == 0 ? GLA_LDP : HG_LDP;
            pg8::Gemm g{(const bf16*)(ws + WS_HBF), (const bf16*)(wb + REL_WIN), M, ldp, D, D, D}; pg8::StaticOrder S; S.init(M, ldp, G, bx);
            pg8::EpiRowScale E{(bf16*)(ws + WS_PROJ), ldp, layer == 0 ? (const float*)(ws + WS_RINV) : (const float*)(ws + WS_ROWSS), layer};
            pg8::gemm_phase<pg8::EpiRowScale, pg8::StaticOrder, true>(lds, g, S, E);
        }
        SEAM(pb + 0);
        if (IN(pb + 1)) { if (layer == 0) { mixer_phase_a<0>(args, lds, vcu, G); memkv_tiles(args, lds, vcu, G); } else mixer_phase_a<1>(args, lds, vcu, G); }
        SEAM(pb + 1);
        if (IN(pb + 2)) { if (layer == 0) mixer_scan<0>(args, vcu, G); else mixer_scan<1>(args, vcu, G); }
        SEAM(pb + 2);
        if (IN(pb + 3)) { if (layer == 0) { mixer_phase_b<0>(args, lds, vcu, G); memattn_phase<0>(args, lds, vcu, G); } else { mixer_phase_b<1>(args, lds, vcu, G); memattn_phase<1>(args, lds, vcu, G); } }
        SEAM(pb + 3);
        if (IN(pb + 4)) {
            const int ldp = layer == 0 ? GLA_LDP : HG_LDP, cv = layer == 0 ? GLA_CV : HG_CV;
            pg8::Gemm g{(const bf16*)(ws + WS_PROJ) + cv, (const bf16*)(wb + REL_WOUT), M, D, D, ldp, D}; pg8::StaticOrder S; S.init(M, D, G, bx);
            pg8::EpiResid E{(bf16*)(ws + WS_HBF), D};
            pg8::gemm_phase<pg8::EpiResid, pg8::StaticOrder, true>(lds, g, S, E);
        }
        SEAM(pb + 4);
        if (IN(pb + 5)) route_phase(args, layer, lds, vcu, G);
        SEAM(pb + 5);
        if (IN(pb + 6)) {
            moe_tile_table(args, layer, lds);
            pg8::Gemm g{(const bf16*)(ws + WS_HBF), (const bf16*)(wb + REL_WUP), M, 1024, D, D, D};
            pg8::MoeOrder<0> S{(const LAS int*)(lds + TT_OFF), G, vcu, (const SlotRec*)(ws + WS_SLOT)};
            pg8::EpiMoeUp E{(bf16*)(ws + WS_HACT), (const SlotRec*)(ws + WS_SLOT)};
            pg8::gemm_phase<pg8::EpiMoeUp, pg8::MoeOrder<0>, true>(lds, g, S, E);
        }
        SEAM(pb + 6);
        if (IN(pb + 7)) {
            moe_tile_table(args, layer, lds);
            pg8::Gemm g{(const bf16*)(ws + WS_HACT), (const bf16*)(wb + REL_WDN), M, D, 2 * FF, 2 * FF, FF};
            pg8::MoeOrder<1> S{(const LAS int*)(lds + TT_OFF), G, vcu, (const SlotRec*)(ws + WS_SLOT)};
            pg8::EpiMoeDown E{(bf16*)(ws + WS_HBF), (const SlotRec*)(ws + WS_SLOT), (bf16*)(ws + WS_DUMMY), layer == 0 ? (float*)(ws + WS_ROWSS) : nullptr};
            pg8::gemm_phase<pg8::EpiMoeDown, pg8::MoeOrder<1>, true>(lds, g, S, E);
        }
        SEAM(pb + 7);
    }
    if (IN(1 + 2 * NPH)) final_norm_phase(args, gw, NGW);
#ifdef TIME_PHASE
    STAMP(2 * NPH + 2);
    if (bx == 0 && tid == 0) { const unsigned span = (MISC[16 + TIME_PHASE_END] - MISC[16 + TIME_PHASE]) * TIME_AMP; const unsigned t0 = (unsigned)__builtin_amdgcn_s_memrealtime();
        while ((unsigned)__builtin_amdgcn_s_memrealtime() - t0 < span) __builtin_amdgcn_s_sleep(8); }
#endif
#undef IN
#undef SEAM
}
#ifndef N_LAUNCHES
#define N_LAUNCHES 1
#endif
constexpr int NPHASES = 2 * NPH + 2;
extern "C" void kernel_launch(void* const* d_in, const int* in_sizes, int n_in, void* d_out, int out_size, void* d_ws, size_t ws_size, hipStream_t stream) {
    static int grid = 0;
    if (grid == 0) {
        int dev = 0, cus = 0, per_cu = 0;
        if (n_in != 21 || out_size != M * D || ws_size < 256 * MiB) { fprintf(stderr, "kernel_launch: unexpected problem shape (n_in %d, out %d, ws %zu)\n", n_in, out_size, ws_size); grid = -1; return; }
        if (hipGetDevice(&dev) != hipSuccess || hipDeviceGetAttribute(&cus, hipDeviceAttributeMultiprocessorCount, dev) != hipSuccess) { fprintf(stderr, "kernel_launch: device query failed\n"); grid = -1; return; }
        if (hipFuncSetAttribute((const void*)fwd, hipFuncAttributeMaxDynamicSharedMemorySize, LDS_BYTES) != hipSuccess) { fprintf(stderr, "kernel_launch: hipFuncSetAttribute failed\n"); grid = -1; return; }
        if (hipOccupancyMaxActiveBlocksPerMultiprocessor(&per_cu, (const void*)fwd, NTHREADS, LDS_BYTES) != hipSuccess || per_cu < 1) { fprintf(stderr, "kernel_launch: occupancy query reports %d workgroups per CU; nothing launched\n", per_cu); (void)hipGetLastError(); grid = -1; return; }
        (void)hipGetLastError();
        grid = cus;
    }
    if (grid < 0) return;
    (void)hipMemsetAsync((char*)d_ws + WS_CTL, 0, CTL_ZERO_BYTES, stream);
    Args a{};
    for (int i = 0; i < 21; ++i) a.in[i] = (const float*)d_in[i];
    a.out = (float*)d_out; a.ws = (unsigned char*)d_ws;
    if (N_LAUNCHES == 1) { a.ph_lo = 0; a.ph_hi = NPHASES; a.use_bar = 1; hipLaunchKernelGGL(fwd, dim3(grid), dim3(NTHREADS), LDS_BYTES, stream, a); }
    else for (int p = 0; p < NPHASES; ++p) { a.ph_lo = p; a.ph_hi = p + 1; a.use_bar = 0; hipLaunchKernelGGL(fwd, dim3(grid), dim3(NTHREADS), LDS_BYTES, stream, a); }
}
```
